# Optimizing an MI355X kernel written in HIP

```python
import math
import jax, jax.numpy as jnp
from jax import lax
import numpy as np

D_MODEL = 1024
BATCH = 2
SEQ = 8192
DEPTH = 2

HG_HEADS = 4
HG_DK = 128
HG_DV = 128
HG_WIDTH = HG_HEADS * HG_DK
HG_CHUNK = 16
HG_F_MIN = 1e-6
S5_WIDTH = 512
S5_GROUP = 16
S5_GROUPS = S5_WIDTH // S5_GROUP
S5_STATE = 64
RET_HEADS = 4
RET_DK = 128
RET_DV = 128
RET_WIDTH = RET_HEADS * RET_DK
RET_CHUNK = 128
ROPE_BASE = 10000.0
N_BRANCH = 3
MIX_WIDTH = HG_WIDTH + S5_WIDTH + RET_WIDTH
IN_COLS = 4 * HG_WIDTH + S5_WIDTH + 4 * RET_WIDTH + N_BRANCH * D_MODEL
MEM_LEN = 256
XA_HEADS = 4
XA_DH = D_MODEL // XA_HEADS
PEER_HEADS = 8
PEER_NKEYS = 128
PEER_EXPERTS = PEER_NKEYS * PEER_NKEYS
PEER_DQ = 256
PEER_DH = PEER_DQ // 2
PEER_TOPK = 16
PEER_BLOCK = 128
EPS = 1e-6
F32 = jnp.float32

kernel_name = 'hybrid_hgrn2_s5_retnet_peer_block'


def rmsnorm(x, gain):
    xf = x.astype(F32)
    y = xf * lax.rsqrt(jnp.mean(xf * xf, axis=-1, keepdims=True) + EPS)
    return (y * gain.astype(F32)).astype(x.dtype)


def _to_chunks(a, n_heads, chunk):
    b, length, width = a.shape
    return a.reshape(b, length // chunk, chunk, n_heads, width // n_heads).transpose(0, 3, 1, 2, 4)


def _from_chunks(a):
    b, h, n, c, d = a.shape
    return a.transpose(0, 2, 3, 1, 4).reshape(b, n * c, h, d)


def _inter_chunk(q_dec, k_dec, v, chunk_decay):
    bsz, h, _, _, dk = q_dec.shape
    dv = v.shape[-1]
    xs = (jnp.moveaxis(q_dec, 2, 0), jnp.moveaxis(k_dec, 2, 0), jnp.moveaxis(v, 2, 0), jnp.moveaxis(chunk_decay, 2, 0))

    def step(state, inp):
        qd, kd, vv, dec = inp
        out = jnp.einsum('bhck,bhkv->bhcv', qd, state)
        state = dec[..., None] * state + jnp.einsum('bhck,bhcv->bhkv', kd, vv)
        return state, out

    s0 = jnp.zeros((bsz, h, dk, dv), q_dec.dtype)
    _, out = lax.scan(step, s0, xs)
    return jnp.moveaxis(out, 0, 2)


def hgrn2(q, f_logit, inp, gate, lb, norm_g):
    bsz, length, _ = q.shape
    h, dk, dv, c = HG_HEADS, HG_DK, HG_DV, HG_CHUNK
    z = f_logit.astype(F32)
    lbf = lb.astype(F32)
    f = lbf + (1.0 - lbf) * jax.nn.sigmoid(z)
    log_f = jnp.log(jnp.clip(f, HG_F_MIN, 1.0))
    k = (1.0 - lbf) * jax.nn.sigmoid(-z)
    qc = _to_chunks(q.astype(F32) * dk ** -0.5, h, c)
    kc = _to_chunks(k, h, c)
    vc = _to_chunks(inp.astype(F32), h, c)
    b = jnp.cumsum(_to_chunks(log_f, h, c), axis=3)
    causal = jnp.tril(jnp.ones((c, c), bool))[:, :, None]
    diff = b[..., :, None, :] - b[..., None, :, :]
    decay = jnp.where(causal, jnp.exp(jnp.minimum(diff, 0.0)), 0.0)
    att = jnp.einsum('bhntk,bhntsk,bhnsk->bhnts', qc, decay, kc)
    o = jnp.einsum('bhnts,bhnsv->bhntv', att, vc)
    b_last = b[..., -1:, :]
    o = o + _inter_chunk(qc * jnp.exp(b), kc * jnp.exp(b_last - b), vc, jnp.exp(b_last[..., 0, :]))
    o = _from_chunks(o)
    o = o * lax.rsqrt(jnp.mean(o * o, axis=-1, keepdims=True) + EPS) * norm_g.astype(F32).reshape(h, dv)
    return o.reshape(bsz, length, h * dv) * jax.nn.silu(gate.astype(F32))


def s5(u, lam_re, lam_im, log_step, b_re, b_im, c_re, c_im, d, w_glu, b_glu):
    bsz, length, _ = u.shape
    uf = u.astype(F32).reshape(bsz, length, S5_GROUPS, S5_GROUP)
    lr = jnp.minimum(lam_re.astype(F32), -1e-4)
    li = lam_im.astype(F32)
    dt = jnp.exp(log_step.astype(F32))[:, None]
    mag = jnp.exp(lr * dt)
    a_re = mag * jnp.cos(li * dt)
    a_im = mag * jnp.sin(li * dt)
    den = lr * lr + li * li
    z_re = ((a_re - 1.0) * lr + a_im * li) / den
    z_im = (a_im * lr - (a_re - 1.0) * li) / den
    bb_re = z_re[..., None] * b_re.astype(F32) - z_im[..., None] * b_im.astype(F32)
    bb_im = z_re[..., None] * b_im.astype(F32) + z_im[..., None] * b_re.astype(F32)
    bu_re = jnp.einsum('blgc,gpc->blgp', uf, bb_re)
    bu_im = jnp.einsum('blgc,gpc->blgp', uf, bb_im)
    ar_full = jnp.broadcast_to(a_re, bu_re.shape)
    ai_full = jnp.broadcast_to(a_im, bu_re.shape)

    def combine(e1, e2):
        ar1, ai1, br1, bi1 = e1
        ar2, ai2, br2, bi2 = e2
        return (ar2 * ar1 - ai2 * ai1, ar2 * ai1 + ai2 * ar1,
                ar2 * br1 - ai2 * bi1 + br2, ar2 * bi1 + ai2 * br1 + bi2)

    _, _, x_re, x_im = lax.associative_scan(combine, (ar_full, ai_full, bu_re, bu_im), axis=1)
    y = (jnp.einsum('blgp,gcp->blgc', x_re, c_re.astype(F32))
         - jnp.einsum('blgp,gcp->blgc', x_im, c_im.astype(F32))
         + d.astype(F32).reshape(S5_GROUPS, S5_GROUP) * uf)
    y = jax.nn.gelu(y.reshape(bsz, length, S5_WIDTH))
    return y * jax.nn.sigmoid(y @ w_glu.astype(F32) + b_glu.astype(F32))


def rope(x, positions):
    half = x.shape[-1] // 2
    inv = ROPE_BASE ** (-jnp.arange(half, dtype=F32) / half)
    ang = positions.astype(F32)[:, :, None, None] * inv
    cos, sin = jnp.cos(ang), jnp.sin(ang)
    x1, x2 = x[..., :half], x[..., half:]
    return jnp.concatenate([x1 * cos - x2 * sin, x1 * sin + x2 * cos], axis=-1)


def retention(q, k, v, gate, positions):
    bsz, length, _ = q.shape
    h, dk, dv, c = RET_HEADS, RET_DK, RET_DV, RET_CHUNK
    n = length // c
    qh = rope(q.astype(F32).reshape(bsz, length, h, dk), positions).reshape(bsz, length, h * dk)
    kh = (rope(k.astype(F32).reshape(bsz, length, h, dk), positions) * dk ** -0.5).reshape(bsz, length, h * dk)
    qc = _to_chunks(qh, h, c)
    kc = _to_chunks(kh, h, c)
    vc = _to_chunks(v.astype(F32), h, c)
    log_g = jnp.log1p(-jnp.exp2(-5.0 - jnp.arange(h, dtype=F32)))
    idx = jnp.arange(c, dtype=F32)
    rel = idx[:, None] - idx[None, :]
    dmat = jnp.where(rel >= 0, jnp.exp(log_g[:, None, None] * jnp.maximum(rel, 0.0)), 0.0)
    scores = jnp.einsum('bhntd,bhnsd->bhnts', qc, kc) * dmat[None, :, None]
    o = jnp.einsum('bhnts,bhnsv->bhntv', scores, vc)
    q_dec = qc * jnp.exp(log_g[:, None] * (idx + 1.0))[None, :, None, :, None]
    k_dec = kc * jnp.exp(log_g[:, None] * (c - 1.0 - idx))[None, :, None, :, None]
    chunk_decay = jnp.broadcast_to(jnp.exp(log_g * c)[None, :, None, None], (bsz, h, n, dk))
    o = _from_chunks(o + _inter_chunk(q_dec, k_dec, vc, chunk_decay))
    mu = jnp.mean(o, axis=-1, keepdims=True)
    var = jnp.mean((o - mu) ** 2, axis=-1, keepdims=True)
    o = (o - mu) * lax.rsqrt(var + EPS)
    return o.reshape(bsz, length, h * dv) * jax.nn.silu(gate.astype(F32))


def cross_attn(h, mem_n, wq, wkv, wo):
    bsz, length, d = h.shape
    m = mem_n.shape[1]
    q = (h @ wq).reshape(bsz, length, XA_HEADS, XA_DH)
    k, v = jnp.split(mem_n @ wkv, 2, axis=-1)
    k = k.reshape(bsz, m, XA_HEADS, XA_DH)
    v = v.reshape(bsz, m, XA_HEADS, XA_DH)
    s = jnp.einsum('blhd,bmhd->bhlm', q, k).astype(F32) * XA_DH ** -0.5
    p = jax.nn.softmax(s, axis=-1).astype(h.dtype)
    o = jnp.einsum('bhlm,bmhd->blhd', p, v).reshape(bsz, length, d)
    return o @ wo


def peer(h, wq, keys, u_tab, v_tab):
    bsz, length, d = h.shape
    q = (h @ wq).astype(F32).reshape(bsz, length, PEER_HEADS, 2, PEER_DH)
    s = jnp.einsum('blhpd,hpkd->blhpk', q, keys.astype(F32))
    s_top, i_top = lax.top_k(s, PEER_TOPK)
    cand = (s_top[..., 0, :, None] + s_top[..., 1, None, :]).reshape(bsz, length, PEER_HEADS, PEER_TOPK * PEER_TOPK)
    cand_idx = (i_top[..., 0, :, None] * PEER_NKEYS + i_top[..., 1, None, :]).reshape(bsz, length, PEER_HEADS, PEER_TOPK * PEER_TOPK)
    best, pos = lax.top_k(cand, PEER_TOPK)
    idx = jnp.take_along_axis(cand_idx, pos, axis=-1)
    gates = jax.nn.softmax(best, axis=-1)
    nb = length // PEER_BLOCK
    hb = h.reshape(bsz, nb, PEER_BLOCK, d).swapaxes(0, 1)
    ib = idx.reshape(bsz, nb, PEER_BLOCK, PEER_HEADS, PEER_TOPK).swapaxes(0, 1)
    gb = gates.reshape(bsz, nb, PEER_BLOCK, PEER_HEADS, PEER_TOPK).swapaxes(0, 1)

    def block(args):
        hh, ii, gg = args
        u = u_tab[ii]
        act = jax.nn.gelu(jnp.einsum('bthkd,btd->bthk', u, hh).astype(F32)) * gg
        vv = v_tab[ii]
        return jnp.einsum('bthk,bthkd->btd', act.astype(h.dtype), vv)

    y = lax.map(block, (hb, ib, gb))
    return y.swapaxes(0, 1).reshape(bsz, length, d)


def setup_inputs(seed: int = 0) -> dict:
    key = jax.random.key(seed)
    keys = jax.random.split(key, 48)
    ctr = [0]

    def nk():
        k = keys[ctr[0]]
        ctr[0] += 1
        return k

    def nrm(shape, scale):
        return jax.random.normal(nk(), shape, F32) * scale

    def gain(shape):
        return 1.0 + nrm(shape, 0.02)

    L, D = DEPTH, D_MODEL
    x = nrm((BATCH, SEQ, D), 1.0)
    mem = nrm((BATCH, MEM_LEN, D), 1.0)
    offs = jax.random.randint(nk(), (BATCH, 1), 0, 4096, dtype=jnp.int32)
    positions = offs + jnp.arange(SEQ, dtype=jnp.int32)[None, :]
    n_idx = jnp.arange(S5_STATE, dtype=F32)
    return {
        'x': x,
        'mem': mem,
        'positions': positions,
        'norm_mix': gain((L, D)),
        'w_in': nrm((L, D, IN_COLS), D ** -0.5),
        'b_gate': nrm((L, N_BRANCH * D), 0.01),
        'hgrn_lb': nrm((L, HG_WIDTH), 0.1),
        'hgrn_norm': gain((L, HG_WIDTH)),
        's5_lambda_re': -0.5 + nrm((L, S5_GROUPS, S5_STATE), 0.01),
        's5_lambda_im': jnp.pi * n_idx + nrm((L, S5_GROUPS, S5_STATE), 0.01),
        's5_log_step': jax.random.uniform(nk(), (L, S5_GROUPS), F32, math.log(1e-3), math.log(1e-1)),
        's5_b_re': nrm((L, S5_GROUPS, S5_STATE, S5_GROUP), (2.0 * S5_GROUP) ** -0.5),
        's5_b_im': nrm((L, S5_GROUPS, S5_STATE, S5_GROUP), (2.0 * S5_GROUP) ** -0.5),
        's5_c_re': nrm((L, S5_GROUPS, S5_GROUP, S5_STATE), (2.0 * S5_STATE) ** -0.5),
        's5_c_im': nrm((L, S5_GROUPS, S5_GROUP, S5_STATE), (2.0 * S5_STATE) ** -0.5),
        's5_d': nrm((L, S5_WIDTH), 1.0),
        's5_w_glu': nrm((L, S5_WIDTH, S5_WIDTH), S5_WIDTH ** -0.5),
        's5_b_glu': nrm((L, S5_WIDTH), 0.01),
        'w_branch': nrm((L, MIX_WIDTH, D), HG_WIDTH ** -0.5),
        'w_out': nrm((L, D, D), D ** -0.5),
        'norm_cross': gain((L, D)),
        'norm_mem': gain((L, D)),
        'xa_wq': nrm((L, D, D), D ** -0.5),
        'xa_wkv': nrm((L, D, 2 * D), D ** -0.5),
        'xa_wo': nrm((L, D, D), D ** -0.5),
        'norm_ffn': gain((L, D)),
        'peer_wq': nrm((L, D, PEER_HEADS * PEER_DQ), D ** -0.5),
        'peer_keys': nrm((L, PEER_HEADS, 2, PEER_NKEYS, PEER_DH), PEER_DH ** -0.5),
        'peer_u': nrm((L, PEER_EXPERTS, D), D ** -0.5),
        'peer_v': nrm((L, PEER_EXPERTS, D), 0.25),
        'norm_final': gain((D,)),
    }


def reference(x, mem, positions, norm_mix, w_in, b_gate, hgrn_lb, hgrn_norm, s5_lambda_re, s5_lambda_im,
              s5_log_step, s5_b_re, s5_b_im, s5_c_re, s5_c_im, s5_d, s5_w_glu, s5_b_glu, w_branch, w_out,
              norm_cross, norm_mem, xa_wq, xa_wkv, xa_wo, norm_ffn, peer_wq, peer_keys, peer_u, peer_v,
              norm_final):
    bsz, length, d = x.shape
    sm = jax.nn.softmax(hgrn_lb.astype(F32), axis=0)
    lower_bounds = jnp.cumsum(sm, axis=0) - sm[0]
    split_at = np.cumsum([HG_WIDTH] * 4 + [S5_WIDTH] + [RET_WIDTH] * 4).tolist()
    e0, e1 = HG_WIDTH, HG_WIDTH + S5_WIDTH
    for l in range(DEPTH):
        h = rmsnorm(x, norm_mix[l])
        proj = h @ w_in[l]
        hg_q, hg_f, hg_i, hg_g, s5_u, rt_q, rt_k, rt_v, rt_g, gate_logits = jnp.split(proj, split_at, axis=-1)
        o_hg = hgrn2(hg_q, hg_f, hg_i, hg_g, lower_bounds[l], hgrn_norm[l]).astype(h.dtype)
        o_s5 = s5(s5_u, s5_lambda_re[l], s5_lambda_im[l], s5_log_step[l], s5_b_re[l], s5_b_im[l],
                  s5_c_re[l], s5_c_im[l], s5_d[l], s5_w_glu[l], s5_b_glu[l]).astype(h.dtype)
        o_rt = retention(rt_q, rt_k, rt_v, rt_g, positions).astype(h.dtype)
        gates = jax.nn.sigmoid((gate_logits + b_gate[l]).astype(F32)).reshape(bsz, length, N_BRANCH, d).astype(h.dtype)
        wb = w_branch[l]
        merged = (gates[:, :, 0] * (o_hg @ wb[:e0])
                  + gates[:, :, 1] * (o_s5 @ wb[e0:e1])
                  + gates[:, :, 2] * (o_rt @ wb[e1:]))
        x = x + merged @ w_out[l]
        x = x + cross_attn(rmsnorm(x, norm_cross[l]), rmsnorm(mem, norm_mem[l]), xa_wq[l], xa_wkv[l], xa_wo[l])
        x = x + peer(rmsnorm(x, norm_ffn[l]), peer_wq[l], peer_keys[l], peer_u[l], peer_v[l])
    return rmsnorm(x, norm_final)
```

```cpp
#include <hip/hip_runtime.h>
#include <stdint.h>
#include <stdio.h>

#ifndef LA_HG
#define LA_HG 1
#endif
#ifndef LA_RT
#define LA_RT 1
#endif
#ifndef PEER_LO
#define PEER_LO 0
#endif
#ifndef PROBE_MASK
#define PROBE_MASK 0ull
#endif
#ifndef PROBE_REP
#define PROBE_REP 1
#endif
#ifndef PROBE_BAR
#define PROBE_BAR 0
#endif
#ifndef PROBE_SEL
#define PROBE_SEL 0
#endif
#ifndef ONE_LAUNCH
#define ONE_LAUNCH 1
#endif

typedef unsigned short bf16_t;
typedef float f32x4 __attribute__((ext_vector_type(4)));
typedef unsigned u32x4 __attribute__((ext_vector_type(4)));
typedef unsigned u32x2 __attribute__((ext_vector_type(2)));
#define DI __device__ __forceinline__
#define LAS __attribute__((address_space(3)))

constexpr int NB = 2, SEQ = 8192, T = NB * SEQ, D = 1024, DEPTH = 2;
constexpr int INC = 7680;
constexpr int C_HGQ = 0, C_HGF = 512, C_HGI = 1024, C_HGG = 1536, C_S5U = 2048, C_RTQ = 2560, C_RTK = 3072, C_RTV = 3584, C_RTG = 4096, C_GATE = 4608;
constexpr int MEM = 256, NEXP = 16384;
constexpr float EPS = 1e-6f;

constexpr size_t MiB = 1u << 20;
constexpr size_t WS_CTL = 0, CTL_BYTES = 1 * MiB;
constexpr size_t WS_HN = 1 * MiB;
constexpr size_t WS_OB = 33 * MiB;
constexpr size_t WS_YS5 = 81 * MiB;
constexpr size_t WS_WIN_T = 97 * MiB;
constexpr size_t WS_WBR_T = 127 * MiB;
constexpr size_t WS_WOUT_T = 133 * MiB;
constexpr size_t WS_WGLU_T = 137 * MiB;
constexpr size_t WS_WPK_T = 138 * MiB;
constexpr size_t WS_WQK_T = 146 * MiB;
constexpr size_t WS_VWO_T = 154 * MiB;
constexpr size_t WS_R = 162 * MiB;
constexpr size_t WS_PROJ = WS_R;
constexpr size_t WS_OTMP = WS_R + 240 * MiB;
constexpr size_t WS_LAST = WS_OTMP;
constexpr size_t WS_LADEC = WS_R + 344 * MiB;
constexpr size_t WS_S5X = WS_R + 345 * MiB;
constexpr size_t WS_MF32 = WS_OTMP;
constexpr size_t WS_MRG = WS_OTMP + 64 * MiB;
constexpr size_t WS_RQ = WS_OTMP + 64 * MiB;
constexpr size_t WS_RK = WS_OTMP + 80 * MiB;
constexpr size_t WS_MEMN = WS_R;
constexpr size_t WS_WKV_T = WS_R + 2 * MiB;
constexpr size_t WS_WOT = WS_R + 10 * MiB;
constexpr size_t WS_WQB = WS_R + 14 * MiB;
constexpr size_t WS_PWQB = WS_R + 18 * MiB;
constexpr size_t WS_KBD = WS_R + 26 * MiB;
constexpr size_t WS_KVB = WS_R + 28 * MiB;
constexpr size_t WS_P = WS_R;
constexpr size_t WS_SC = WS_R;
constexpr size_t WS_PEERU = WS_R + 176 * MiB;
constexpr size_t WS_PEERV = WS_R + 192 * MiB;
constexpr size_t WS_PEERS = WS_R + 208 * MiB;
constexpr size_t WS_HQ = WS_R + 128 * MiB;
constexpr size_t WS_AQ = WS_R + 210 * MiB;
constexpr size_t WS_ASC = WS_R + 216 * MiB;
constexpr size_t WS_IDX16 = WS_R + 218 * MiB;
constexpr size_t WS_IDX = WS_R + 160 * MiB;
constexpr size_t WS_GATE = WS_R + 168 * MiB;
constexpr size_t WS_ROPE = WS_R + 336 * MiB;
constexpr size_t WS_TAB = WS_R + 347 * MiB;
constexpr size_t WS_END = WS_ROPE + 12 * MiB;

constexpr int LDS_BYTES = 147456;
constexpr int LDS_GD = 131072 + 8192;

DI float bf2f(bf16_t v) { return __uint_as_float((unsigned)v << 16); }
DI float bflo(unsigned w) { return __uint_as_float(w << 16); }
DI float bfhi(unsigned w) { return __uint_as_float(w & 0xffff0000u); }
DI unsigned f2bf(float f) { unsigned u = __float_as_uint(f); return (u + 0x7fffu + ((u >> 16) & 1u)) >> 16; }
typedef float f32x2_ __attribute__((ext_vector_type(2)));
typedef __bf16 bf16x2_ __attribute__((ext_vector_type(2)));
DI unsigned pk2(float lo, float hi) { const f32x2_ v = {lo, hi}; return __builtin_bit_cast(unsigned, __builtin_convertvector(v, bf16x2_)); }
template <int M> DI float sx(float v) { return __int_as_float(__builtin_amdgcn_ds_swizzle(__float_as_int(v), (M << 10) | 0x1f)); }
DI void halves(float v, float& lo, float& hi) { const auto r = __builtin_amdgcn_permlane32_swap(__float_as_uint(v), __float_as_uint(v), false, false); lo = __uint_as_float(r[0]); hi = __uint_as_float(r[1]); }
DI float wave_sum(float v) { v += sx<1>(v); v += sx<2>(v); v += sx<4>(v); v += sx<8>(v); v += sx<16>(v); float lo, hi; halves(v, lo, hi); return lo + hi; }
DI float wave_max(float v) { v = fmaxf(v, sx<1>(v)); v = fmaxf(v, sx<2>(v)); v = fmaxf(v, sx<4>(v)); v = fmaxf(v, sx<8>(v)); v = fmaxf(v, sx<16>(v)); float lo, hi; halves(v, lo, hi); return fmaxf(lo, hi); }
DI float fexp(float x) { return __builtin_amdgcn_exp2f(x * 1.4426950408889634f); }
DI float flog(float x) { return __builtin_amdgcn_logf(x) * 0.6931471805599453f; }
DI float frcp(float x) { return __builtin_amdgcn_rcpf(x); }
DI float frsq(float x) { return __builtin_amdgcn_rsqf(x); }
DI float sigmoidf_(float x) { return frcp(1.0f + fexp(-x)); }
DI float siluf_(float x) { return x * frcp(1.0f + fexp(-x)); }
DI float gelu_tanh(float x) { const float u = 0.7978845608028654f * (x + 0.044715f * x * x * x); return x - x * frcp(1.0f + fexp(2.0f * u)); }

#define XB_TMO      128
#define XB_XCNT(j)  (256  + 64 * (j))
#define XB_XSUB(j)  (1280 + 64 * (j))
#define XB_XGEN(j)  (2304 + 64 * (j))
#define XB_TOP      3328
#define XB_TOPGEN   3392
#define XCD_BAR_WORDS 3456
#define XB_SPIN_CAP (1u << 22)
DI unsigned xb_ld(unsigned* p) { return __hip_atomic_load(p, __ATOMIC_RELAXED, __HIP_MEMORY_SCOPE_AGENT); }
DI unsigned xb_add(unsigned* p, unsigned v) { return __hip_atomic_fetch_add(p, v, __ATOMIC_RELAXED, __HIP_MEMORY_SCOPE_AGENT); }
DI unsigned xb_xcc_id() { return (unsigned)__builtin_amdgcn_s_getreg((3 << 11) | 20) & 0xFu; }
#define XB_SPIN(cond, bar) do { unsigned _sp = 0; while (cond) { __builtin_amdgcn_s_sleep(1); \
    if ((++_sp & 255u) == 0u) { if (xb_ld(&(bar)[XB_TMO])) break; if (_sp > XB_SPIN_CAP) { atomicAdd(&(bar)[XB_TMO], 1u); break; } } } } while (0)
struct XcdBarrier { unsigned* bar; unsigned x; volatile LAS unsigned* st; };
DI XcdBarrier xcd_barrier_post(unsigned* bar, volatile LAS unsigned* st) {
    XcdBarrier b; b.bar = bar; b.x = xb_xcc_id(); b.st = st;
    if (threadIdx.x == 0) (void)xb_add(&bar[XB_XCNT(b.x)], 1u);
    return b;
}
DI void xcd_barrier_complete(unsigned* bar, unsigned x, unsigned& nloc, unsigned& nx) {
    const unsigned G = gridDim.x * gridDim.y * gridDim.z;
    unsigned sum, cnt, mine, sp = 0u;
    for (;;) {
        sum = 0u; cnt = 0u; mine = 0u;
#pragma unroll
        for (unsigned j = 0; j < 16; ++j) { const unsigned c = xb_ld(&bar[XB_XCNT(j)]); sum += c; cnt += (c > 0u) ? 1u : 0u; mine = (j == x) ? c : mine; }
        if (sum == G) break;
        __builtin_amdgcn_s_sleep(1);
        if ((++sp & 255u) == 0u) { if (xb_ld(&bar[XB_TMO])) break; if (sp > XB_SPIN_CAP) { atomicAdd(&bar[XB_TMO], 1u); break; } }
    }
    nloc = mine > 0u ? mine : 1u; nx = cnt > 0u ? cnt : 1u;
}
DI void xcd_barrier(const XcdBarrier& b) {
    asm volatile("s_waitcnt vmcnt(0)" ::: "memory");
    __syncthreads();
    if (threadIdx.x == 0) {
        unsigned* bar = b.bar;
        __builtin_amdgcn_s_waitcnt(0);
        unsigned nloc = b.st[0], nx = b.st[1];
        if (nloc == 0u) { xcd_barrier_complete(bar, b.x, nloc, nx); b.st[0] = nloc; b.st[1] = nx; }
        const unsigned old = xb_add(&bar[XB_XSUB(b.x)], 1u);
        const unsigned gen = old / nloc;
        if (old + 1u == (gen + 1u) * nloc) {
            __builtin_amdgcn_fence(__ATOMIC_RELEASE, "agent");
            asm volatile("s_waitcnt vmcnt(0)" ::: "memory");
            __builtin_amdgcn_fence(__ATOMIC_ACQUIRE, "agent");
            const unsigned og = xb_add(&bar[XB_TOP], 1u);
            const unsigned tg = og / nx;
            if (og + 1u == (tg + 1u) * nx) xb_add(&bar[XB_TOPGEN], 1u);
            else XB_SPIN(xb_ld(&bar[XB_TOPGEN]) == tg, bar);
            asm volatile("s_waitcnt vmcnt(0)" ::: "memory");
            xb_add(&bar[XB_XGEN(b.x)], 1u);
            asm volatile("s_waitcnt vmcnt(0)" ::: "memory");
        } else {
            __builtin_amdgcn_fence(__ATOMIC_ACQUIRE, "agent");
            XB_SPIN(xb_ld(&bar[XB_XGEN(b.x)]) == gen, bar);
            asm volatile("s_waitcnt vmcnt(0)" ::: "memory");
        }
    }
    __syncthreads();
}

struct Params { const void* in[31]; float* out; unsigned char* ws; int lo, hi; };
typedef const LAS Params& PRM;
DI unsigned long long rfl64(unsigned long long v) { const unsigned lo = __builtin_amdgcn_readfirstlane((unsigned)v), hi = __builtin_amdgcn_readfirstlane((unsigned)(v >> 32)); return ((unsigned long long)hi << 32) | lo; }
DI int rfl(int v) { return __builtin_amdgcn_readfirstlane(v); }
#define GLOBAL_AS __attribute__((address_space(1)))
DI const void* pin(PRM p, int i) { return (const void*)(const GLOBAL_AS char*)rfl64((unsigned long long)p.in[i]); }
DI unsigned char* pws(PRM p) { return (unsigned char*)(GLOBAL_AS unsigned char*)rfl64((unsigned long long)p.ws); }
DI float* pout(PRM p) { return (float*)(GLOBAL_AS float*)rfl64((unsigned long long)p.out); }

enum { I_X = 0, I_MEM, I_POS, I_NORM_MIX, I_W_IN, I_B_GATE, I_HG_LB, I_HG_NORM, I_S5_LRE, I_S5_LIM, I_S5_LOGSTEP, I_S5_BRE, I_S5_BIM, I_S5_CRE, I_S5_CIM,
       I_S5_D, I_S5_WGLU, I_S5_BGLU, I_W_BRANCH, I_W_OUT, I_NORM_CROSS, I_NORM_MEM, I_XA_WQ, I_XA_WKV, I_XA_WO, I_NORM_FFN, I_PEER_WQ, I_PEER_KEYS,
       I_PEER_U, I_PEER_V, I_NORM_FINAL };

struct TC { int tid, bid, nb, nostore; };
enum { E_BF16 = 0, E_F32, E_GLU, E_BR0, E_BR1, E_BR2, E_ADDX, E_SOFTMAX, E_BRZ, E_F16 };
enum { K_NONE = 0, K_GEMM, K_RMS, K_MIX1, K_MIX2, K_MIX3, K_ROUTE, K_EXPERTS, K_EXPERTS_V, K_INIT };
enum { B_OUT = 31, B_WS = 32 };
struct GemmDesc {
    int kind, epi, layer, alt;
    int bA, bB, bC, bE0, bE1, bE2, zinner, split;
    long oA, oB, oC, oE0, oE1, oE2;
    long zA_l, zA_hi, zA_lo, zB_l, zB_hi, zB_lo, zC_l, zC_hi, zC_lo;
    int lda, ldb, ldc, M, N, K, nz; float scale;
};
DI const void* base_ptr(PRM p, int id) { const unsigned long long v = rfl64(id < 31 ? (unsigned long long)p.in[id] : (id == 31 ? (unsigned long long)p.out : (unsigned long long)p.ws)); return (const void*)(const GLOBAL_AS char*)v; }
typedef const GemmDesc& GD;
#define GI(f) (g.f)
#define GL(f) (g.f)
#define GPTR(ty, bf, of) ((ty)((const char*)base_ptr(p, g.bf) + g.of))
#define ZOFF(g, X, zi) ((size_t)(((zi) >> 3) * GL(z##X##_l) + (((zi) >> 2) & 1) * GL(z##X##_hi) + ((zi) & 3) * GL(z##X##_lo)))
DI unsigned pkh2(float lo, float hi) { typedef float f32x2h __attribute__((ext_vector_type(2))); typedef _Float16 f16x2h __attribute__((ext_vector_type(2)));
    return __builtin_bit_cast(unsigned, __builtin_convertvector((f32x2h){lo, hi}, f16x2h)); }
DI float h2f(unsigned short h) { return (float)__builtin_bit_cast(_Float16, h); }
DI void store8_bf16(bf16_t* p, const float (&v)[8]) {
    u32x4 w; w.x = pk2(v[0], v[1]); w.y = pk2(v[2], v[3]); w.z = pk2(v[4], v[5]); w.w = pk2(v[6], v[7]);
    *(u32x4*)p = w;
}
DI void unpack8(const u32x4 w, float (&v)[8]) { v[0] = bflo(w.x); v[1] = bfhi(w.x); v[2] = bflo(w.y); v[3] = bfhi(w.y); v[4] = bflo(w.z); v[5] = bfhi(w.z); v[6] = bflo(w.w); v[7] = bfhi(w.w); }
DI void load8_bf16(const bf16_t* p, float (&v)[8]) {
    const u32x4 w = *(const u32x4*)p;
    v[0] = bflo(w.x); v[1] = bfhi(w.x); v[2] = bflo(w.y); v[3] = bfhi(w.y); v[4] = bflo(w.z); v[5] = bfhi(w.z); v[6] = bflo(w.w); v[7] = bfhi(w.w);
}
struct EpiU { int epi, ldc; size_t zo, zx; unsigned char* C; const unsigned char* A; const unsigned char* e0; const unsigned char* e1; unsigned char* e2; float scale; };
struct EpiL { u32x4 a, b; };
DI EpiU epi_unit(PRM p, GD g, int z) {
    EpiU u; u.ldc = GI(ldc); u.epi = GI(epi); u.zx = 0;
    if (u.epi == E_BRZ) { u.epi = E_BR0 + z; u.zx = (size_t)z * D; }
    u.zo = ZOFF(g, C, z); u.C = GPTR(unsigned char*, bC, oC); u.A = GPTR(const unsigned char*, bA, oA); u.e0 = GPTR(const unsigned char*, bE0, oE0); u.e1 = GPTR(const unsigned char*, bE1, oE1);
    u.e2 = GPTR(unsigned char*, bE2, oE2); u.scale = g.scale; return u;
}
DI void epi_load(const EpiU& u, int row, int col, EpiL& L) {
    const size_t co = u.zo + (size_t)row * u.ldc + col;
    switch (u.epi) {
    case E_GLU: L.a = *(const u32x4*)((const bf16_t*)u.A + (size_t)row * 512 + col); break;
    case E_BR0: L.a = *(const u32x4*)((const bf16_t*)u.e0 + u.zx + (size_t)row * INC + col); break;
    case E_BR1: case E_BR2: { L.a = *(const u32x4*)((const bf16_t*)u.e0 + u.zx + (size_t)row * INC + col); L.b = *(const u32x4*)((const bf16_t*)u.C + co); } break;
    case E_ADDX: { const float* x = (const float*)u.e0 + co; L.a = *(const u32x4*)x; L.b = *(const u32x4*)(x + 4); } break;
    default: break;
    }
}
DI void epi_finish(const int nostore, const EpiU& u, int row, int col, float (&v)[8], const EpiL& L) {
    const size_t co = u.zo + (size_t)row * u.ldc + col;
    switch (u.epi) {
    case E_BF16: {
#pragma unroll
        for (int j = 0; j < 8; ++j) v[j] *= u.scale;
        store8_bf16((bf16_t*)u.C + co, v); } break;
    case E_F32: { float* c = (float*)u.C + co; *(f32x4*)c = (f32x4){v[0], v[1], v[2], v[3]}; *(f32x4*)(c + 4) = (f32x4){v[4], v[5], v[6], v[7]}; } break;
    case E_F16: { u32x4 w; w.x = pkh2(v[0], v[1]); w.y = pkh2(v[2], v[3]); w.z = pkh2(v[4], v[5]); w.w = pkh2(v[6], v[7]); *(u32x4*)((unsigned short*)u.C + co) = w; } break;
    case E_GLU: {
        float y[8], o[8]; unpack8(L.a, y); const float* bias = (const float*)u.e0;
#pragma unroll
        for (int j = 0; j < 8; ++j) o[j] = y[j] * sigmoidf_(v[j] + bias[col + j]);
        store8_bf16((bf16_t*)u.C + co, o); } break;
    case E_BR0: case E_BR1: case E_BR2: {
        float lg[8], o[8]; unpack8(L.a, lg); const float* bg = (const float*)u.e1 + u.zx;
#pragma unroll
        for (int j = 0; j < 8; ++j) { o[j] = sigmoidf_(lg[j] + bg[col + j]) * v[j]; }
        if (u.epi != E_BR0) { float pr[8]; unpack8(L.b, pr);
#pragma unroll
            for (int j = 0; j < 8; ++j) o[j] += pr[j]; }
        if (nostore && o[0] != 12345.678f) break;
        store8_bf16((bf16_t*)u.C + co, o); } break;
    case E_ADDX: { float* x = (float*)u.C + co; f32x4 x0 = __builtin_bit_cast(f32x4, L.a), x1 = __builtin_bit_cast(f32x4, L.b);
        x0 += (f32x4){v[0], v[1], v[2], v[3]}; x1 += (f32x4){v[4], v[5], v[6], v[7]}; if (nostore && x0.x != 12345.678f) break; *(f32x4*)x = x0; *(f32x4*)(x + 4) = x1; } break;
    default: break;
    }
}
typedef short bf16x8 __attribute__((ext_vector_type(8)));
namespace mgk {
constexpr int BM = 256, BK = 64, HALF = 128, HTB = HALF * BK * 2, NXCD = 8, WGM = 8;
DI int lds_byte(int r, int c) { const int st = (r >> 4) * 2 + (c >> 5), rr = r & 15, cc = c & 31, ob = rr * 64 + cc * 2; return st * 1024 + (ob ^ (((ob >> 9) & 1) << 5)); }
DI void stage_rc(int b, int& R, int& C) { const int st = b / 1024, sb = b % 1024, swz = sb ^ (((sb >> 9) & 1) << 5); R = (st >> 1) * 16 + swz / 64; C = (st & 1) * 32 + (swz % 64) / 2; }
DI int perm32(int rho) { const int n = rho >> 4, i = rho & 15; return 8 * (i >> 2) + 4 * n + (i & 3); }
struct Unit { int pm, pn, z; };
DI bool next_unit(GD g, int i, int G, int c, Unit& u) {
    const int nM = GI(M) / BM, nN = GI(N) / BM, nwg = nM * nN;
    long L = (long)i * G + c; int zz;
    if (GI(zinner)) { const int nz = GI(nz); zz = i % nz; L = (long)(i / nz) * G + c; if (L >= nwg) return false; }
    else { if (L >= (long)nwg * GI(nz)) return false; zz = (int)(L / nwg); }
    u.z = zz; int wgid = (int)(L % nwg);
    { const int q = nwg / NXCD, r = nwg % NXCD, xcd = wgid % NXCD, off = wgid / NXCD; wgid = (xcd < r ? xcd * (q + 1) : r * (q + 1) + (xcd - r) * q) + off; }
    const int nig = WGM * nN, gid = wgid / nig, fm = gid * WGM, gsz = (nM - fm) < WGM ? (nM - fm) : WGM;
    u.pm = rfl(fm + ((wgid % nig) % gsz)); u.pn = rfl((wgid % nig) / gsz); u.z = rfl(u.z); return true;
}
}

DI void mgemm(const TC tc, PRM p, GD g, LAS unsigned char* lds, LAS unsigned char* lds_dma) {
    using namespace mgk;
    const int tid = tc.tid, wid = __builtin_amdgcn_readfirstlane(tid >> 6), lane = tid & 63, wr = wid >> 2, wc = wid & 3, fr = lane & 15, fq = lane >> 4;
    const int nt = (tc.nostore && PROBE_SEL == 6) ? 2 : GI(K) / BK, lda = GI(lda), ldb = GI(ldb);
    unsigned voffA[2], voffB[2];
#pragma unroll
    for (int i = 0; i < 2; ++i) { int R, C; stage_rc(tid * 16 + i * 8192, R, C); const int Rb = (R & ~31) + perm32(R & 31);
        voffA[i] = (unsigned)(R * lda + C) * 2u; voffB[i] = (unsigned)(Rb * ldb + C) * 2u; }
    const size_t kstep = (size_t)(BK * 2);
    const size_t hstepA = (size_t)HALF * lda * 2, hstepB = (size_t)HALF * ldb * 2;
    const unsigned ldsw = (unsigned)wid * 1024u;
    const unsigned ldsm0 = (unsigned)__builtin_amdgcn_readfirstlane((int)((unsigned)(size_t)lds_dma + ldsw));
    LAS unsigned char* aB = lds + lds_byte(wr * 64 + fr, fq * 8); LAS unsigned char* bB = lds + 4 * HTB + lds_byte(wc * 32 + fr, fq * 8);
    asm volatile("" : "+v"(aB), "+v"(bB));
#define MG_SA(b, h) (((b) * 2 + (h)) * HTB)
#define MG_SB(b, h) ((4 + (b) * 2 + (h)) * HTB)
#ifndef MG_ASM_DMA
#define MG_ASM_DMA 0
#endif
#if MG_ASM_DMA
#define MG_STAGE(bufoff, gbase, voff) do { _Pragma("unroll") for (int _i = 0; _i < 2; ++_i) \
        asm volatile("s_mov_b32 m0, %0\n\ts_nop 0\n\tglobal_load_lds_dwordx4 %1, %2" :: "s"(ldsm0 + (unsigned)((bufoff) + _i * 8192)), "v"((voff)[_i]), "s"((const char*)(gbase)) : "m0", "memory"); } while (0)
#else
#define MG_STAGE(bufoff, gbase, voff) do { _Pragma("unroll") for (int _i = 0; _i < 2; ++_i) \
        __builtin_amdgcn_global_load_lds((const unsigned*)((const char*)(gbase) + (voff)[_i]), (LAS unsigned*)(lds_dma + (bufoff) + ldsw + _i * 8192), 16, 0, 0); } while (0)
#endif
#define MG_LDA(dst, b, h) do { _Pragma("unroll") for (int m = 0; m < 4; ++m) _Pragma("unroll") for (int k = 0; k < 2; ++k) dst[m][k] = *(const LAS bf16x8*)(aB + MG_SA(b, h) + m * 2048 + k * 1024); } while (0)
#define MG_LDB(dst, b, h) do { _Pragma("unroll") for (int n = 0; n < 2; ++n) _Pragma("unroll") for (int k = 0; k < 2; ++k) dst[n][k] = *(const LAS bf16x8*)(bB + (MG_SB(b, h) - 4 * HTB) + n * 2048 + k * 1024); } while (0)
#define MG_MMA(ai, bj, At, Bt) do { __builtin_amdgcn_s_setprio(1); _Pragma("unroll") for (int m = 0; m < 4; ++m) _Pragma("unroll") for (int n = 0; n < 2; ++n) _Pragma("unroll") for (int k = 0; k < 2; ++k) \
        acc[ai][bj][m][n] = __builtin_amdgcn_mfma_f32_16x16x32_bf16(Bt[n][k], At[m][k], acc[ai][bj][m][n], 0, 0, 0); __builtin_amdgcn_s_setprio(0); } while (0)
#define MG_WAIT_V(n) asm volatile("s_waitcnt vmcnt(" #n ")" ::: "memory")
#define MG_WAIT_L(n) asm volatile("s_waitcnt lgkmcnt(" #n ")" ::: "memory")
#define MG_BAR __builtin_amdgcn_s_barrier()
#define MG_SCHED __builtin_amdgcn_sched_barrier(0)
    const int G = rfl(tc.nb), cidx = rfl(tc.bid);
    Unit cur, nxt; int ui = 0;
    if (!next_unit(g, 0, G, cidx, cur)) return;
    {
        const int nun = (GI(M) / BM) * (GI(N) / BM) * GI(nz), full = nun / G, rem = nun - full * G;
        if (rem != 0 && full >= 4 && cidx >= rem && !GI(zinner)) { const int steps = (cidx - rem) & 15; for (int k = 0; k < steps; ++k) __builtin_amdgcn_s_sleep(64); }
    }
    f32x4 acc[2][2][4][2];
#pragma unroll
    for (int a = 0; a < 2; ++a)
#pragma unroll
        for (int b = 0; b < 2; ++b)
#pragma unroll
            for (int m = 0; m < 4; ++m)
#pragma unroll
                for (int n = 0; n < 2; ++n) acc[a][b][m][n] = (f32x4){0.f, 0.f, 0.f, 0.f};
    bf16x8 At[4][2], B0[2][2], B1[2][2];
    const bf16_t* const Abase = GPTR(const bf16_t*, bA, oA); const bf16_t* const Bbase = GPTR(const bf16_t*, bB, oB);
    const char* cA = (const char*)(Abase + ZOFF(g, A, cur.z) + (size_t)cur.pm * BM * lda);
    const char* cB = (const char*)(Bbase + ZOFF(g, B, cur.z) + (size_t)cur.pn * BM * ldb);
    MG_STAGE(MG_SB(0, 0), cB, voffB); MG_STAGE(MG_SB(0, 1), cB + hstepB, voffB); MG_STAGE(MG_SA(0, 0), cA, voffA); MG_STAGE(MG_SA(0, 1), cA + hstepA, voffA);
    if (wr == 1) MG_BAR;
    MG_WAIT_V(2); MG_BAR;
    MG_STAGE(MG_SB(1, 0), cB + kstep, voffB); MG_STAGE(MG_SA(1, 0), cA + kstep, voffA); MG_STAGE(MG_SB(1, 1), cB + hstepB + kstep, voffB);
    MG_WAIT_V(6); MG_BAR;
    for (;;) {
        const bool has_next = next_unit(g, ui + 1, G, cidx, nxt);
        const char* nA = has_next ? (const char*)(Abase + ZOFF(g, A, nxt.z) + (size_t)nxt.pm * BM * GI(lda)) : cA;
        const char* nB = has_next ? (const char*)(Bbase + ZOFF(g, B, nxt.z) + (size_t)nxt.pn * BM * GI(ldb)) : cB;
        for (int t = 0; t < nt; t += 2) {
            const bool last = (t == nt - 2);
            const char* a1 = cA + (size_t)(t + 1) * kstep;
            const char* a2 = last ? nA : cA + (size_t)(t + 2) * kstep; const char* b2 = last ? nB : cB + (size_t)(t + 2) * kstep;
            const char* a3 = a2 + kstep; const char* b3 = b2 + kstep;
            MG_LDB(B0, 0, 0); MG_LDB(B1, 0, 1); MG_SCHED; MG_LDA(At, 0, 0); MG_STAGE(MG_SA(1, 1), a1 + hstepA, voffA);
            MG_WAIT_V(8); MG_WAIT_L(0); MG_BAR; MG_MMA(0, 0, At, B0); MG_MMA(0, 1, At, B1); MG_BAR; MG_SCHED;
            MG_LDA(At, 0, 1); MG_STAGE(MG_SB(0, 0), b2, voffB); MG_STAGE(MG_SB(0, 1), b2 + hstepB, voffB); MG_STAGE(MG_SA(0, 0), a2, voffA);
            MG_WAIT_V(8); MG_WAIT_L(0); MG_BAR; MG_MMA(1, 0, At, B0); MG_MMA(1, 1, At, B1); MG_BAR; MG_SCHED;
            MG_LDB(B0, 1, 0); MG_LDB(B1, 1, 1); MG_SCHED; MG_LDA(At, 1, 0); MG_STAGE(MG_SA(0, 1), a2 + hstepA, voffA);
            MG_WAIT_V(8); MG_WAIT_L(0); MG_BAR; MG_MMA(0, 0, At, B0); MG_MMA(0, 1, At, B1); MG_BAR; MG_SCHED;
            MG_LDA(At, 1, 1); MG_STAGE(MG_SB(1, 0), b3, voffB); MG_STAGE(MG_SB(1, 1), b3 + hstepB, voffB); MG_STAGE(MG_SA(1, 0), a3, voffA);
            MG_WAIT_V(8); MG_WAIT_L(0); MG_BAR; MG_MMA(1, 0, At, B0); MG_MMA(1, 1, At, B1); MG_BAR; MG_SCHED;
        }
        if (wr == 0) MG_BAR;
        int fr_e = fr, fq_e = fq, ez = 0;
        asm volatile("" : "+v"(fr_e), "+v"(fq_e), "+v"(ez));
        PRM pe = *(const LAS Params*)((const LAS unsigned char*)&p + ez);
#define p pe
#define fr fr_e
#define fq fq_e
        if (tc.nostore && PROBE_SEL == 5) {   }
        else if (GI(epi) == E_SOFTMAX) {
            LAS float* red = (LAS float*)(lds + 131072);
#pragma unroll
            for (int ai = 0; ai < 2; ++ai)
#pragma unroll
                for (int m = 0; m < 4; ++m) {
                    float mx = -INFINITY;
#pragma unroll
                    for (int bj = 0; bj < 2; ++bj)
#pragma unroll
                        for (int n = 0; n < 2; ++n)
#pragma unroll
                            for (int j = 0; j < 4; ++j) mx = fmaxf(mx, acc[ai][bj][m][n][j]);
                    mx = fmaxf(mx, sx<16>(mx)); { float lo_, hi_; halves(mx, lo_, hi_); mx = fmaxf(lo_, hi_); }
                    float s = 0.f;
#pragma unroll
                    for (int bj = 0; bj < 2; ++bj)
#pragma unroll
                        for (int n = 0; n < 2; ++n)
#pragma unroll
                            for (int j = 0; j < 4; ++j) { const float e = fexp(acc[ai][bj][m][n][j] - mx); acc[ai][bj][m][n][j] = e; s += e; }
                    s += sx<16>(s); { float lo_, hi_; halves(s, lo_, hi_); s = lo_ + hi_; }
                    if (fq == 0) { const int rl = ai * HALF + wr * 64 + m * 16 + fr; red[(rl * 4 + wc) * 2] = mx; red[(rl * 4 + wc) * 2 + 1] = s; }
                }
            asm volatile("s_waitcnt lgkmcnt(0)" ::: "memory"); __builtin_amdgcn_s_barrier(); asm volatile("" ::: "memory");
            bf16_t* Cb = GPTR(bf16_t*, bC, oC) + ZOFF(g, C, cur.z); const int ldc = GI(ldc);
#pragma unroll
            for (int ai = 0; ai < 2; ++ai)
#pragma unroll
                for (int m = 0; m < 4; ++m) {
                    const int rl = ai * HALF + wr * 64 + m * 16 + fr;
                    const f32x4 p0 = *(const LAS f32x4*)(red + rl * 8), p1 = *(const LAS f32x4*)(red + rl * 8 + 4);
                    const float M_ = fmaxf(fmaxf(p0.x, p0.z), fmaxf(p1.x, p1.z));
                    const float tot = p0.y * fexp(p0.x - M_) + p0.w * fexp(p0.z - M_) + p1.y * fexp(p1.x - M_) + p1.w * fexp(p1.z - M_);
                    const float sc = fexp(red[(rl * 4 + wc) * 2] - M_) * frcp(tot);
                    bf16_t* rowp = Cb + (size_t)(cur.pm * BM + rl) * ldc + cur.pn * BM + wc * 32 + 8 * fq;
#pragma unroll
                    for (int bj = 0; bj < 2; ++bj) {
                        float v[8];
#pragma unroll
                        for (int j = 0; j < 4; ++j) { v[j] = acc[ai][bj][m][0][j] * sc; v[4 + j] = acc[ai][bj][m][1][j] * sc; }
                        store8_bf16(rowp + bj * HALF, v);
                    }
                }
        } else {
            const int row0 = cur.pm * BM + wr * 64 + fr, col0 = cur.pn * BM + wc * 32 + 8 * fq;
            const EpiU eu = epi_unit(p, g, cur.z);
#pragma unroll
            for (int ai = 0; ai < 2; ++ai)
#pragma unroll
                for (int m = 0; m < 4; ++m) {
                    EpiL L[2];
#pragma unroll
                    for (int bj = 0; bj < 2; ++bj) epi_load(eu, row0 + ai * HALF + m * 16, col0 + bj * HALF, L[bj]);
#pragma unroll
                    for (int bj = 0; bj < 2; ++bj) {
                        float v[8];
#pragma unroll
                        for (int j = 0; j < 4; ++j) { v[j] = acc[ai][bj][m][0][j]; v[4 + j] = acc[ai][bj][m][1][j]; }
                        epi_finish(tc.nostore, eu, row0 + ai * HALF + m * 16, col0 + bj * HALF, v, L[bj]);
                    }
                }
        }
#undef fr
#undef fq
#undef p
        if (!has_next) break;
#pragma unroll
        for (int a = 0; a < 2; ++a)
#pragma unroll
            for (int b = 0; b < 2; ++b)
#pragma unroll
                for (int m = 0; m < 4; ++m)
#pragma unroll
                    for (int n = 0; n < 2; ++n) acc[a][b][m][n] = (f32x4){0.f, 0.f, 0.f, 0.f};
        cur = nxt; cA = nA; cB = nB; ++ui;
        if (wr == 1) MG_BAR;
    }
    MG_WAIT_V(0);
    MG_BAR;
#undef MG_SA
#undef MG_SB
#undef MG_STAGE
#undef MG_LDA
#undef MG_LDB
#undef MG_MMA
#undef MG_WAIT_V
#undef MG_WAIT_L
#undef MG_BAR
#undef MG_SCHED
}

DI void transpose_item(const float* W, int K, int N, bf16_t* WT, LAS float* scr, int item, int lane) {
    const int nblk = N / 32, kb = item / nblk, nb = item % nblk, k0 = 64 * kb, n0 = 32 * nb;
#pragma unroll 8
    for (int i = 0; i < 32; ++i) { const int kk = 2 * i + (lane >> 5); scr[kk * 33 + (lane & 31)] = W[(size_t)(k0 + kk) * N + n0 + (lane & 31)]; }
    asm volatile("s_waitcnt lgkmcnt(0)" ::: "memory");
    const int c = lane & 7;
#pragma unroll
    for (int j = 0; j < 4; ++j) { const int n = (lane >> 3) + 8 * j; const LAS float* s = scr + (8 * c) * 33 + n;
        u32x4 o; o.x = pk2(s[0 * 33], s[1 * 33]); o.y = pk2(s[2 * 33], s[3 * 33]); o.z = pk2(s[4 * 33], s[5 * 33]); o.w = pk2(s[6 * 33], s[7 * 33]);
        *(u32x4*)(WT + (size_t)(n0 + n) * K + k0 + 8 * c) = o; }
    asm volatile("s_waitcnt lgkmcnt(0)" ::: "memory");
}
DI void prep_weights(const TC tc, PRM p, LAS unsigned char* lds) {
    const int lane = tc.tid & 63, wave = tc.tid >> 6, gw = tc.bid * 8 + wave, NGW = tc.nb * 8;
    LAS float* scr = (LAS float*)(lds + wave * 16384);
    unsigned char* ws = pws(p);
    constexpr int I_IN = (D / 64) * (INC / 32), I_BR = (512 / 64) * (D / 32), I_OUT = (D / 64) * (D / 32), I_GLU = (512 / 64) * (512 / 32), I_KV = (D / 64) * (2 * D / 32), I_WO = (D / 64) * (D / 32);
    constexpr int PER_L = I_IN + 3 * I_BR + I_OUT + I_GLU + I_KV + I_WO;
    for (int it = gw; it < DEPTH * PER_L; it += NGW) {
        const int l = it / PER_L; int r = it % PER_L;
        if (r < I_IN) { transpose_item((const float*)pin(p, I_W_IN) + (size_t)l * D * INC, D, INC, (bf16_t*)(ws + WS_WIN_T) + (size_t)l * INC * D, scr, r, lane); continue; } r -= I_IN;
        if (r < 3 * I_BR) { const int br = r / I_BR; transpose_item((const float*)pin(p, I_W_BRANCH) + (size_t)l * 1536 * D + (size_t)br * 512 * D, 512, D, (bf16_t*)(ws + WS_WBR_T) + (size_t)(l * 3 + br) * D * 512, scr, r % I_BR, lane); continue; } r -= 3 * I_BR;
        if (r < I_OUT) { transpose_item((const float*)pin(p, I_W_OUT) + (size_t)l * D * D, D, D, (bf16_t*)(ws + WS_WOUT_T) + (size_t)l * D * D, scr, r, lane); continue; } r -= I_OUT;
        if (r < I_GLU) { transpose_item((const float*)pin(p, I_S5_WGLU) + (size_t)l * 512 * 512, 512, 512, (bf16_t*)(ws + WS_WGLU_T) + (size_t)l * 512 * 512, scr, r, lane); continue; } r -= I_GLU;
        if (r < I_KV) { transpose_item((const float*)pin(p, I_XA_WKV) + (size_t)l * D * 2 * D, D, 2 * D, (bf16_t*)(ws + WS_WKV_T) + (size_t)l * 2 * D * D, scr, r, lane); continue; } r -= I_KV;
        transpose_item((const float*)pin(p, I_XA_WO) + (size_t)l * D * D, D, D, (bf16_t*)(ws + WS_WOT) + (size_t)l * D * D, scr, r, lane);
    }
    {
        const size_t n_wq = (size_t)DEPTH * D * D / 8, n_pq = (size_t)DEPTH * D * 2048 / 8;
        const float* wq = (const float*)pin(p, I_XA_WQ); const float* pq = (const float*)pin(p, I_PEER_WQ);
        bf16_t* wqb = (bf16_t*)(ws + WS_WQB); bf16_t* pqb = (bf16_t*)(ws + WS_PWQB);
        for (size_t i = (size_t)tc.bid * 512 + tc.tid; i < n_wq + n_pq; i += (size_t)tc.nb * 512) {
            const float* s = i < n_wq ? wq + i * 8 : pq + (i - n_wq) * 8; bf16_t* d = i < n_wq ? wqb + i * 8 : pqb + (i - n_wq) * 8;
            const f32x4 a = *(const f32x4*)s, b = *(const f32x4*)(s + 4);
            u32x4 w; w.x = pk2(a.x, a.y); w.y = pk2(a.z, a.w); w.z = pk2(b.x, b.y); w.w = pk2(b.z, b.w); *(u32x4*)d = w;
        }
    }
    {
        const float* keys = (const float*)pin(p, I_PEER_KEYS); bf16_t* kbd = (bf16_t*)(ws + WS_KBD);
        const size_t n = (size_t)DEPTH * 8 * 256 * 256 / 8;
        for (size_t i = (size_t)tc.bid * 512 + tc.tid; i < n; i += (size_t)tc.nb * 512) {
            const size_t e = i * 8; const int c = (int)(e & 255), r = (int)((e >> 8) & 255); const size_t lh = e >> 16;
            const int pr = r >> 7, key = r & 127, pc = c >> 7, d = c & 127;
            u32x4 w = (u32x4){0u, 0u, 0u, 0u};
            if (pr == pc) { const float* s = keys + ((lh * 2 + pr) * 128 + key) * 128 + d; const f32x4 a = *(const f32x4*)s, b = *(const f32x4*)(s + 4);
                w.x = pk2(a.x, a.y); w.y = pk2(a.z, a.w); w.z = pk2(b.x, b.y); w.w = pk2(b.z, b.w); }
            *(u32x4*)(kbd + e) = w;
        }
    }
}

DI unsigned fp8x4(float a, float b, float c, float d) {
    a = fminf(fmaxf(a, -448.f), 448.f); b = fminf(fmaxf(b, -448.f), 448.f); c = fminf(fmaxf(c, -448.f), 448.f); d = fminf(fmaxf(d, -448.f), 448.f);
    int t = 0; t = __builtin_amdgcn_cvt_pk_fp8_f32(a, b, t, false); t = __builtin_amdgcn_cvt_pk_fp8_f32(c, d, t, true); return (unsigned)t;
}
DI void rms_rows(const TC tc, const float* X, const float* gain, bf16_t* ob, float* of, int rows, unsigned char* oq = nullptr) {
    const int lane = tc.tid & 63, gw = tc.bid * 8 + (tc.tid >> 6), NGW = tc.nb * 8;
    f32x4 n0[4], n1[4];
#pragma unroll
    for (int j = 0; j < 4; ++j) { n0[j] = (f32x4){0.f, 0.f, 0.f, 0.f}; n1[j] = n0[j]; }
    if (gw < rows) {
#pragma unroll
        for (int j = 0; j < 4; ++j) n0[j] = ((const f32x4*)(X + (size_t)gw * D) + lane)[64 * j]; }
    if (gw + NGW < rows) {
#pragma unroll
        for (int j = 0; j < 4; ++j) n1[j] = ((const f32x4*)(X + (size_t)(gw + NGW) * D) + lane)[64 * j]; }
    for (int r = gw; r < rows; r += NGW) {
        f32x4 v[4]; float ss = 0.f;
#pragma unroll
        for (int j = 0; j < 4; ++j) { v[j] = n0[j]; n0[j] = n1[j]; }
        if (r + 2 * NGW < rows) {
#pragma unroll
            for (int j = 0; j < 4; ++j) n1[j] = ((const f32x4*)(X + (size_t)(r + 2 * NGW) * D) + lane)[64 * j]; }
#pragma unroll
        for (int j = 0; j < 4; ++j) ss += v[j].x * v[j].x + v[j].y * v[j].y + v[j].z * v[j].z + v[j].w * v[j].w;
        const float sc = frsq(wave_sum(ss) * (1.0f / D) + EPS);
#pragma unroll
        for (int j = 0; j < 4; ++j) {
            const f32x4 g = ((const f32x4*)gain)[lane + 64 * j];
            const f32x4 o = v[j] * sc * g;
            if (ob) { u32x2 w; w.x = pk2(o.x, o.y); w.y = pk2(o.z, o.w); *((u32x2*)(ob + (size_t)r * D) + lane + 64 * j) = w; }
            if (of) ((f32x4*)(of + (size_t)r * D))[lane + 64 * j] = o;
            if (oq) {
                typedef float f32x2 __attribute__((ext_vector_type(2)));
                const f32x4 o8 = o * 8.0f; const unsigned q1 = fp8x4(o8.x, o8.y, o8.z, o8.w);
                const f32x2 d0 = __builtin_amdgcn_cvt_pk_f32_fp8((int)q1, false), d1 = __builtin_amdgcn_cvt_pk_f32_fp8((int)q1, true);
                ((unsigned*)(oq + (size_t)r * D))[lane + 64 * j] = q1;
                if (PEER_LO) { const unsigned q2 = fp8x4((o8.x - d0.x) * 16.0f, (o8.y - d0.y) * 16.0f, (o8.z - d1.x) * 16.0f, (o8.w - d1.y) * 16.0f);
                    ((unsigned*)(oq + (size_t)T * D + (size_t)r * D))[lane + 64 * j] = q2; }
            }
        }
    }
}

template <bool RET>
DI void seq_linattn(const TC tc, PRM p, int l, int item) {
    const bf16_t* PROJ = (const bf16_t*)(pws(p) + WS_PROJ);
    float* OT = (float*)(pws(p) + WS_OTMP) + (size_t)(RET ? 2 : 0) * T * 512;
    const int b = item >> 5, h = (item >> 3) & 3, jg = item & 7;
    const int tid = tc.tid, j = tid >> 5, ks = tid & 31, k0 = ks * 4;
    const int qoff = (RET ? C_RTQ : C_HGQ) + h * 128, foff = (RET ? C_RTK : C_HGF) + h * 128, voff = (RET ? C_RTV : C_HGI) + h * 128 + jg * 16 + j;
    const int* pos = (const int*)pin(p, I_POS) + b * SEQ;
    float lb[4], inv[4];
    float gam = 1.0f;
    if (RET) {
        gam = 1.0f - exp2f(-5.0f - (float)h);
#pragma unroll
        for (int i = 0; i < 4; ++i) inv[i] = powf(10000.0f, -(float)((k0 + i) & 63) * (1.0f / 64.0f));
    } else {
        const float* hl = (const float*)pin(p, I_HG_LB);
#pragma unroll
        for (int i = 0; i < 4; ++i) {
            const int c = h * 128 + k0 + i;
            if (l == 0) lb[i] = 0.f;
            else { const float a0 = hl[c], a1 = hl[512 + c], m = fmaxf(a0, a1), e0 = expf(a0 - m), e1 = expf(a1 - m); lb[i] = e1 / (e0 + e1); }
        }
    }
    float S[4] = {0.f, 0.f, 0.f, 0.f};
    const bf16_t* base = PROJ + (size_t)b * SEQ * INC;
    const int pk0 = k0 ^ 64;
    for (int t0 = 0; t0 < SEQ; t0 += 4) {
        u32x2 q4[4], f4[4], qp4[4], fp4[4]; bf16_t vv[4]; int ps[4];
#pragma unroll
        for (int u = 0; u < 4; ++u) {
            const bf16_t* row = base + (size_t)(t0 + u) * INC;
            q4[u] = *(const u32x2*)(row + qoff + k0); f4[u] = *(const u32x2*)(row + foff + k0); vv[u] = row[voff];
            if (RET) { qp4[u] = *(const u32x2*)(row + qoff + pk0); fp4[u] = *(const u32x2*)(row + foff + pk0); ps[u] = pos[t0 + u]; }
        }
#pragma unroll
        for (int u = 0; u < 4; ++u) {
            const float qv[4] = {bflo(q4[u].x), bfhi(q4[u].x), bflo(q4[u].y), bfhi(q4[u].y)};
            const float fv[4] = {bflo(f4[u].x), bfhi(f4[u].x), bflo(f4[u].y), bfhi(f4[u].y)};
            const float v = bf2f(vv[u]);
            float part = 0.f;
            if (RET) {
                const float qpv[4] = {bflo(qp4[u].x), bfhi(qp4[u].x), bflo(qp4[u].y), bfhi(qp4[u].y)};
                const float fpv[4] = {bflo(fp4[u].x), bfhi(fp4[u].x), bflo(fp4[u].y), bfhi(fp4[u].y)};
                const float pf = (float)ps[u];
#pragma unroll
                for (int i = 0; i < 4; ++i) {
                    const float ang = pf * inv[i]; float sn, cs; sincosf(ang, &sn, &cs);
                    float qr, kr;
                    if (k0 < 64) { qr = qv[i] * cs - qpv[i] * sn; kr = fv[i] * cs - fpv[i] * sn; }
                    else { qr = qpv[i] * sn + qv[i] * cs; kr = fpv[i] * sn + fv[i] * cs; }
                    kr *= 0.08838834764831845f;
                    S[i] = gam * S[i] + kr * v;
                    part += S[i] * qr;
                }
            } else {
#pragma unroll
                for (int i = 0; i < 4; ++i) {
                    const float z = fv[i];
                    const float sg = 1.0f / (1.0f + expf(-z));
                    float f = lb[i] + (1.0f - lb[i]) * sg; f = fminf(fmaxf(f, 1e-6f), 1.0f);
                    const float kk = (1.0f - lb[i]) / (1.0f + expf(z));
                    S[i] = f * S[i] + kk * v;
                    part += S[i] * (qv[i] * 0.08838834764831845f);
                }
            }
            part += sx<16>(part); part += sx<8>(part); part += sx<4>(part); part += sx<2>(part); part += sx<1>(part);
            if (ks == 0) OT[(size_t)(b * SEQ + t0 + u) * 512 + h * 128 + jg * 16 + j] = part;
        }
    }
}

DI float reduce16(float (&v)[16], int lane) {
    const bool h4 = lane & 16, h3 = lane & 8, h2 = lane & 4, h1 = lane & 2;
#pragma unroll
    for (int i = 0; i < 8; ++i) { const float send = h4 ? v[i] : v[i + 8], keep = h4 ? v[i + 8] : v[i]; v[i] = keep + sx<16>(send); }
#pragma unroll
    for (int i = 0; i < 4; ++i) { const float send = h3 ? v[i] : v[i + 4], keep = h3 ? v[i + 4] : v[i]; v[i] = keep + sx<8>(send); }
#pragma unroll
    for (int i = 0; i < 2; ++i) { const float send = h2 ? v[i] : v[i + 2], keep = h2 ? v[i + 2] : v[i]; v[i] = keep + sx<4>(send); }
    { const float send = h1 ? v[0] : v[1], keep = h1 ? v[1] : v[0]; v[0] = keep + sx<2>(send); }
    float r = v[0]; r += sx<1>(r);
    float lo, hi; halves(r, lo, hi);
    return lo + hi;
}

constexpr int S5_LC = 128, S5_NCH = SEQ / S5_LC;
struct S5Const { float a_re, a_im; };
DI void s5_disc_init(PRM p, int idx, float* out) {
    const int l = idx >> 11, g = (idx >> 6) & 31, lane = idx & 63;
    const float lr = fminf(((const float*)pin(p, I_S5_LRE))[(l * 32 + g) * 64 + lane], -1e-4f);
    const float li = ((const float*)pin(p, I_S5_LIM))[(l * 32 + g) * 64 + lane];
    const float dt = expf(((const float*)pin(p, I_S5_LOGSTEP))[l * 32 + g]);
    const float mag = expf(lr * dt);
    const float a_re = mag * cosf(li * dt), a_im = mag * sinf(li * dt);
    const float den = lr * lr + li * li;
    out[0] = a_re; out[1] = a_im; out[2] = ((a_re - 1.0f) * lr + a_im * li) / den; out[3] = (a_im * lr - (a_re - 1.0f) * li) / den;
}
DI S5Const s5_disc(PRM p, int l, int g, int lane, float& z_re, float& z_im) {
    const f32x4 v = *(const f32x4*)((const float*)(pws(p) + WS_TAB) + (size_t)((l * 32 + g) * 64 + lane) * 4);
    S5Const c; c.a_re = v.x; c.a_im = v.y; z_re = v.z; z_im = v.w; return c;
}
template <int MODE>
DI void s5_chunk(const TC tc, PRM p, int l, int item) {
    const bf16_t* PROJ = (const bf16_t*)(pws(p) + WS_PROJ);
    float* XEND = (float*)(pws(p) + WS_S5X);
    const int b = item / (32 * S5_NCH), g = (item / S5_NCH) & 31, n = item % S5_NCH, lane = tc.tid & 63;
    float z_re, z_im; const S5Const cc = s5_disc(p, l, g, lane, z_re, z_im);
    const float a_re = cc.a_re, a_im = cc.a_im;
    float bbr[16], bbi[16];
    const float* Bre = (const float*)pin(p, I_S5_BRE) + ((size_t)(l * 32 + g) * 64 + lane) * 16;
    const float* Bim = (const float*)pin(p, I_S5_BIM) + ((size_t)(l * 32 + g) * 64 + lane) * 16;
#pragma unroll
    for (int c = 0; c < 16; ++c) { const float br = Bre[c], bi = Bim[c]; bbr[c] = z_re * br - z_im * bi; bbi[c] = z_re * bi + z_im * br; }
    float cr[16], ci[16]; float dch = 0.f;
    const int cch = ((lane >> 4) & 1) * 8 + ((lane >> 3) & 1) * 4 + ((lane >> 2) & 1) * 2 + ((lane >> 1) & 1);
    if (MODE == 3) {
        const float* Cre = (const float*)pin(p, I_S5_CRE) + (size_t)(l * 32 + g) * 16 * 64 + lane;
        const float* Cim = (const float*)pin(p, I_S5_CIM) + (size_t)(l * 32 + g) * 16 * 64 + lane;
#pragma unroll
        for (int c = 0; c < 16; ++c) { cr[c] = Cre[c * 64]; ci[c] = Cim[c * 64]; }
        dch = ((const float*)pin(p, I_S5_D))[l * 512 + g * 16 + cch];
    }
    float* xe = XEND + ((size_t)((b * 32 + g) * S5_NCH + n) * 64 + lane) * 2;
    float xr = 0.f, xi = 0.f;
    if (MODE == 3) { xr = xe[0]; xi = xe[1]; }
    const bf16_t* base = PROJ + (size_t)(b * SEQ + n * S5_LC) * INC + C_S5U + g * 16;
    bf16_t* yo = (bf16_t*)(pws(p) + WS_YS5) + (size_t)(b * SEQ + n * S5_LC) * 512 + g * 16 + cch;
    for (int t0 = 0; t0 < S5_LC; t0 += 4) {
        u32x4 ua[4], ub[4];
#pragma unroll
        for (int u = 0; u < 4; ++u) { const bf16_t* row = base + (size_t)(t0 + u) * INC; ua[u] = *(const u32x4*)row; ub[u] = *(const u32x4*)(row + 8); }
#pragma unroll
        for (int u = 0; u < 4; ++u) {
            const float uu[16] = {bflo(ua[u].x), bfhi(ua[u].x), bflo(ua[u].y), bfhi(ua[u].y), bflo(ua[u].z), bfhi(ua[u].z), bflo(ua[u].w), bfhi(ua[u].w),
                                  bflo(ub[u].x), bfhi(ub[u].x), bflo(ub[u].y), bfhi(ub[u].y), bflo(ub[u].z), bfhi(ub[u].z), bflo(ub[u].w), bfhi(ub[u].w)};
            float br = 0.f, bi = 0.f;
#pragma unroll
            for (int c = 0; c < 16; ++c) { br += bbr[c] * uu[c]; bi += bbi[c] * uu[c]; }
            const float nr = a_re * xr - a_im * xi + br, ni = a_re * xi + a_im * xr + bi;
            xr = nr; xi = ni;
            if (MODE == 3) {
                float pv[16];
#pragma unroll
                for (int c = 0; c < 16; ++c) pv[c] = cr[c] * xr - ci[c] * xi;
                float y = reduce16(pv, lane);
                float uc = 0.f;
#pragma unroll
                for (int c = 0; c < 16; ++c) uc = (cch == c) ? uu[c] : uc;
                y = gelu_tanh(y + dch * uc);
                if ((lane & 33) == 0) yo[(size_t)(t0 + u) * 512] = (bf16_t)f2bf(y);
            }
        }
    }
    if (MODE == 1) { xe[0] = xr; xe[1] = xi; }
}
constexpr int S5W_BU = 0, S5W_X = 10240, S5W_BYTES = 15360;
template <int MODE>
DI void s5_chunk_mfma(const TC tc, PRM p, int l, int item, LAS unsigned char* lds) {
    const bf16_t* PROJ = (const bf16_t*)(pws(p) + WS_PROJ);
    float* XEND = (float*)(pws(p) + WS_S5X);
    const int b = item / (32 * S5_NCH), g = (item / S5_NCH) & 31, n = item % S5_NCH, lane = tc.tid & 63, w = tc.tid >> 6, tl = lane & 15, kg = lane >> 4;
    LAS float* BUs = (LAS float*)(lds + w * S5W_BYTES + S5W_BU); LAS bf16_t* Xs = (LAS bf16_t*)(lds + w * S5W_BYTES + S5W_X);
    float z_re, z_im; const S5Const cc = s5_disc(p, l, g, lane, z_re, z_im);
    const float a_re = cc.a_re, a_im = cc.a_im;
    const bf16_t* BBF = (const bf16_t*)(pws(p) + WS_TAB + 256 * 1024) + (size_t)(l * 32 + g) * 128 * 16;
    const bf16_t* CMF = (const bf16_t*)(pws(p) + WS_TAB + 512 * 1024) + (size_t)(l * 32 + g) * 16 * 128;
    bf16x8 bbf[8], cmf[4];
    const bf16x8 zf = {0, 0, 0, 0, 0, 0, 0, 0};
#pragma unroll
    for (int nt = 0; nt < 8; ++nt) bbf[nt] = (kg < 2) ? *(const bf16x8*)(BBF + (nt * 16 + tl) * 16 + 8 * kg) : zf;
    float dch = 0.f;
    if (MODE == 3) {
#pragma unroll
        for (int ks = 0; ks < 4; ++ks) cmf[ks] = *(const bf16x8*)(CMF + tl * 128 + ks * 32 + 8 * kg);
        dch = ((const float*)pin(p, I_S5_D))[l * 512 + g * 16 + tl];
    }
    float* xe = XEND + ((size_t)((b * 32 + g) * S5_NCH + n) * 64 + lane) * 2;
    float xr = 0.f, xi = 0.f;
    if (MODE == 3) { xr = xe[0]; xi = xe[1]; }
    const size_t tok0 = (size_t)b * SEQ + (size_t)n * S5_LC;
    const bf16_t* ub = PROJ + tok0 * INC + C_S5U + g * 16;
    bf16_t* yo = (bf16_t*)(pws(p) + WS_YS5) + tok0 * 512 + g * 16 + tl;
    bf16x8 un = (kg < 2) ? *(const bf16x8*)(ub + (size_t)tl * INC + 8 * kg) : zf;
    bf16_t uon[4] = {0, 0, 0, 0};
    if (MODE == 3) {
#pragma unroll
        for (int r = 0; r < 4; ++r) uon[r] = ub[(size_t)(kg * 4 + r) * INC + tl]; }
#pragma unroll 1
    for (int t0 = 0; t0 < S5_LC; t0 += 16) {
        const bf16x8 ua = un;
        bf16_t uo[4];
#pragma unroll
        for (int r = 0; r < 4; ++r) uo[r] = uon[r];
        if (t0 + 16 < S5_LC) { un = (kg < 2) ? *(const bf16x8*)(ub + (size_t)(t0 + 16 + tl) * INC + 8 * kg) : zf;
            if (MODE == 3) {
#pragma unroll
                for (int r = 0; r < 4; ++r) uon[r] = ub[(size_t)(t0 + 16 + kg * 4 + r) * INC + tl]; } }
        f32x4 bu[8];
#pragma unroll
        for (int nt = 0; nt < 8; ++nt) bu[nt] = __builtin_amdgcn_mfma_f32_16x16x32_bf16(ua, bbf[nt], (f32x4){0.f, 0.f, 0.f, 0.f}, 0, 0, 0);
        __builtin_amdgcn_sched_barrier(0); asm volatile("s_nop 15\n\ts_nop 15" ::: "memory"); __builtin_amdgcn_sched_barrier(0);
#pragma unroll
        for (int nt = 0; nt < 8; ++nt) *(LAS f32x4*)(BUs + (nt * 16 + tl) * 20 + kg * 4) = bu[nt];
        float brv[16], biv[16];
#pragma unroll
        for (int j = 0; j < 4; ++j) { const f32x4 a = *(const LAS f32x4*)(BUs + lane * 20 + 4 * j), c = *(const LAS f32x4*)(BUs + (64 + lane) * 20 + 4 * j);
            brv[4 * j] = a.x; brv[4 * j + 1] = a.y; brv[4 * j + 2] = a.z; brv[4 * j + 3] = a.w; biv[4 * j] = c.x; biv[4 * j + 1] = c.y; biv[4 * j + 2] = c.z; biv[4 * j + 3] = c.w; }
        __builtin_amdgcn_sched_barrier(0);
#pragma unroll
        for (int t = 0; t < 16; ++t) {
            const float br = brv[t], bi = biv[t];
            const float nr = a_re * xr - a_im * xi + br, ni = a_re * xi + a_im * xr + bi;
            xr = nr; xi = ni;
            if (MODE == 3) { brv[t] = xr; biv[t] = xi; }
        }
        if (MODE == 3) {
#pragma unroll
            for (int j = 0; j < 2; ++j) {
                u32x4 wr_, wi_;
                wr_.x = pk2(brv[8 * j], brv[8 * j + 1]); wr_.y = pk2(brv[8 * j + 2], brv[8 * j + 3]); wr_.z = pk2(brv[8 * j + 4], brv[8 * j + 5]); wr_.w = pk2(brv[8 * j + 6], brv[8 * j + 7]);
                wi_.x = pk2(biv[8 * j], biv[8 * j + 1]); wi_.y = pk2(biv[8 * j + 2], biv[8 * j + 3]); wi_.z = pk2(biv[8 * j + 4], biv[8 * j + 5]); wi_.w = pk2(biv[8 * j + 6], biv[8 * j + 7]);
                *(LAS u32x4*)(Xs + lane * 20 + 8 * j) = wr_; *(LAS u32x4*)(Xs + (64 + lane) * 20 + 8 * j) = wi_;
            }
            f32x4 y = (f32x4){0.f, 0.f, 0.f, 0.f};
            typedef short i16x4_ __attribute__((ext_vector_type(4)));
#pragma unroll
            for (int ks = 0; ks < 4; ++ks) {
                const LAS bf16_t* rp0 = Xs + (ks * 32 + 8 * kg + (tl >> 2)) * 20 + 4 * (tl & 3);
                const i16x4_ lo4 = __builtin_amdgcn_ds_read_tr16_b64_v4i16((LAS i16x4_*)rp0), hi4 = __builtin_amdgcn_ds_read_tr16_b64_v4i16((LAS i16x4_*)(rp0 + 4 * 20));
                const bf16x8 af = {lo4.x, lo4.y, lo4.z, lo4.w, hi4.x, hi4.y, hi4.z, hi4.w};
                y = __builtin_amdgcn_mfma_f32_16x16x32_bf16(af, cmf[ks], y, 0, 0, 0);
            }
#pragma unroll
            for (int r = 0; r < 4; ++r) { const int t = t0 + kg * 4 + r; const float u = bf2f(uo[r]);
                yo[(size_t)t * 512] = (bf16_t)f2bf(gelu_tanh(y[r] + dch * u)); }
        }
    }
    if (MODE == 1) { xe[0] = xr; xe[1] = xi; }
}

DI void s5_scan(const TC tc, PRM p, int l) {
    float* XEND = (float*)(pws(p) + WS_S5X);
    for (int it = tc.bid * 512 + tc.tid; it < NB * 32 * 64; it += tc.nb * 512) {
        const int bg = it >> 6, lane = it & 63, g = bg & 31;
        float z_re, z_im; const S5Const cc = s5_disc(p, l, g, lane, z_re, z_im);
        float pr = cc.a_re, pi = cc.a_im;
#pragma unroll
        for (int i = 0; i < 7; ++i) { const float nr = pr * pr - pi * pi, ni = 2.0f * pr * pi; pr = nr; pi = ni; }
        float* xe = XEND + ((size_t)bg * S5_NCH * 64 + lane) * 2;
        float sr = 0.f, si = 0.f; asm volatile("" : "+v"(sr), "+v"(si));
        for (int n0 = 0; n0 < S5_NCH; n0 += 32) {
            float er[32], ei[32];
#pragma unroll
            for (int u = 0; u < 32; ++u) { er[u] = xe[(size_t)(n0 + u) * 128]; ei[u] = xe[(size_t)(n0 + u) * 128 + 1]; }
#pragma unroll
            for (int u = 0; u < 32; ++u) {
                if (!tc.nostore) { xe[(size_t)(n0 + u) * 128] = sr; xe[(size_t)(n0 + u) * 128 + 1] = si; }
                const float nr = pr * sr - pi * si + er[u], ni = pr * si + pi * sr + ei[u]; sr = nr; si = ni;
            }
        }
    }
}

constexpr int LA_C = 64, LA_NCH = SEQ / LA_C, LA_ITEMS = 2 * NB * 4 * LA_NCH;
constexpr int LA_Q = 0, LA_K = 17408, LA_B = 34816, LA_VT = 68608, LA_ST = 87040, LA_P = 121856, LA_X = 131072;
constexpr int LA_QS = 136, LA_BS = 132, LA_VS = 72, LA_SS = 136, LA_PS = 72;
DI bf16x8 pack8(const float (&v)[8]) { u32x4 w; w.x = pk2(v[0], v[1]); w.y = pk2(v[2], v[3]); w.z = pk2(v[4], v[5]); w.w = pk2(v[6], v[7]); return __builtin_bit_cast(bf16x8, w); }

DI void la_item(int item, int& m, int& b, int& h, int& n) { n = item % LA_NCH; h = (item / LA_NCH) & 3; b = (item / (LA_NCH * 4)) & 1; m = item / (LA_NCH * 4 * NB); }
DI void la_vt_commit(const TC tc, const u32x4 va, const u32x4 vb, LAS unsigned char* lds) {
    const int t2 = tc.tid & 31, cv = (tc.tid >> 5) * 8; LAS unsigned* VT32 = (LAS unsigned*)(lds + LA_VT);
    VT32[((cv + 0) * LA_VS) / 2 + t2] = (va.x & 0xffffu) | (vb.x << 16); VT32[((cv + 1) * LA_VS) / 2 + t2] = (va.x >> 16) | (vb.x & 0xffff0000u);
    VT32[((cv + 2) * LA_VS) / 2 + t2] = (va.y & 0xffffu) | (vb.y << 16); VT32[((cv + 3) * LA_VS) / 2 + t2] = (va.y >> 16) | (vb.y & 0xffff0000u);
    VT32[((cv + 4) * LA_VS) / 2 + t2] = (va.z & 0xffffu) | (vb.z << 16); VT32[((cv + 5) * LA_VS) / 2 + t2] = (va.z >> 16) | (vb.z & 0xffff0000u);
    VT32[((cv + 6) * LA_VS) / 2 + t2] = (va.w & 0xffffu) | (vb.w << 16); VT32[((cv + 7) * LA_VS) / 2 + t2] = (va.w >> 16) | (vb.w & 0xffff0000u);
}
DI void la_hg_kf(const float* tab, int l, int h, int c0, int t, const u32x4 zraw, LAS unsigned char* lds) {
    LAS bf16_t* Ks = (LAS bf16_t*)(lds + LA_K); LAS float* Bs = (LAS float*)(lds + LA_B);
    float z[8], kk[8], lf[8]; unpack8(zraw, z);
#pragma unroll
    for (int j = 0; j < 8; ++j) { const float lb = tab[l * 512 + h * 128 + c0 + j]; const float sg = frcp(1.0f + fexp(-z[j])); float f = lb + (1.0f - lb) * sg; f = fminf(fmaxf(f, 1e-6f), 1.0f);
        lf[j] = flog(f); kk[j] = (1.0f - lb) * frcp(1.0f + fexp(z[j])); }
    *(LAS bf16x8*)(Ks + t * LA_QS + c0) = pack8(kk);
    *(LAS f32x4*)(Bs + t * LA_BS + c0) = (f32x4){lf[0], lf[1], lf[2], lf[3]}; *(LAS f32x4*)(Bs + t * LA_BS + c0 + 4) = (f32x4){lf[4], lf[5], lf[6], lf[7]};
}
DI void la_cumsum(const TC tc, int m, LAS unsigned char* lds) {
    LAS float* Bs = (LAS float*)(lds + LA_B);
    __syncthreads();
    if (m == 0) {
        LAS float* Xs = (LAS float*)(lds + LA_X);
        const int k = tc.tid & 127, sg = tc.tid >> 7;
        float v[16]; float tot = 0.f;
#pragma unroll
        for (int i = 0; i < 16; ++i) { v[i] = Bs[(sg * 16 + i) * LA_BS + k]; tot += v[i]; }
        Xs[sg * 128 + k] = tot;
        __syncthreads();
        float run = 0.f;
#pragma unroll
        for (int s = 0; s < 3; ++s) run += (s < sg) ? Xs[s * 128 + k] : 0.f;
#pragma unroll
        for (int i = 0; i < 16; ++i) { run += v[i]; Bs[(sg * 16 + i) * LA_BS + k] = run; }
    }
    __syncthreads();
}
struct LaPreA { u32x4 q[2], qp[2], k[2], kp[2]; f32x4 cs[2][2], sn[2][2]; u32x4 va, vb; };
DI void laA_issue(const TC tc, PRM p, int item, LaPreA& r) {
    int m, b, h, n; la_item(item, m, b, h, n);
    const bf16_t* PROJ = (const bf16_t*)(pws(p) + WS_PROJ); const int tid = tc.tid, c0 = (tid & 15) * 8;
#pragma unroll
    for (int ps = 0; ps < 2; ++ps) {
        const size_t tok = (size_t)b * SEQ + (size_t)n * LA_C + (tid >> 4) + 32 * ps; const bf16_t* prow = PROJ + tok * INC;
        if (m == 0) r.k[ps] = *(const u32x4*)(prow + C_HGF + h * 128 + c0);
        else {
            r.q[ps] = *(const u32x4*)(prow + C_RTQ + h * 128 + c0); r.qp[ps] = *(const u32x4*)(prow + C_RTQ + h * 128 + (c0 ^ 64));
            r.k[ps] = *(const u32x4*)(prow + C_RTK + h * 128 + c0); r.kp[ps] = *(const u32x4*)(prow + C_RTK + h * 128 + (c0 ^ 64));
            const float* rt = (const float*)(pws(p) + WS_ROPE) + tok * 128 + (c0 & 63);
            r.cs[ps][0] = *(const f32x4*)rt; r.cs[ps][1] = *(const f32x4*)(rt + 4); r.sn[ps][0] = *(const f32x4*)(rt + 64); r.sn[ps][1] = *(const f32x4*)(rt + 68);
        }
    }
    const size_t tokv = (size_t)b * SEQ + (size_t)n * LA_C + 2 * (tid & 31);
    const bf16_t* pv = PROJ + tokv * INC + (m == 0 ? C_HGI : C_RTV) + h * 128 + (tid >> 5) * 8;
    r.va = *(const u32x4*)pv; r.vb = *(const u32x4*)(pv + INC);
}
DI void laA_commit(const TC tc, PRM p, int l, int item, const LaPreA& r, LAS unsigned char* lds) {
    int m, b, h, n; la_item(item, m, b, h, n);
    const int tid = tc.tid, c0 = (tid & 15) * 8;
    const float* tab = (const float*)(pws(p) + WS_TAB) + 16384;
    LAS bf16_t* Ks = (LAS bf16_t*)(lds + LA_K); LAS float* Bs = (LAS float*)(lds + LA_B);
#pragma unroll
    for (int ps = 0; ps < 2; ++ps) {
        const int t = (tid >> 4) + 32 * ps; const size_t tok = (size_t)b * SEQ + (size_t)n * LA_C + t;
        if (m == 0) la_hg_kf(tab, l, h, c0, t, r.k[ps], lds);
        else {
            float q[8], qp[8], k[8], kp[8]; unpack8(r.q[ps], q); unpack8(r.qp[ps], qp); unpack8(r.k[ps], k); unpack8(r.kp[ps], kp);
            const float cs[8] = {r.cs[ps][0].x, r.cs[ps][0].y, r.cs[ps][0].z, r.cs[ps][0].w, r.cs[ps][1].x, r.cs[ps][1].y, r.cs[ps][1].z, r.cs[ps][1].w};
            const float sn[8] = {r.sn[ps][0].x, r.sn[ps][0].y, r.sn[ps][0].z, r.sn[ps][0].w, r.sn[ps][1].x, r.sn[ps][1].y, r.sn[ps][1].z, r.sn[ps][1].w};
            float qr[8], kr[8];
#pragma unroll
            for (int j = 0; j < 8; ++j) {
                if (c0 < 64) { qr[j] = q[j] * cs[j] - qp[j] * sn[j]; kr[j] = k[j] * cs[j] - kp[j] * sn[j]; }
                else { qr[j] = qp[j] * sn[j] + q[j] * cs[j]; kr[j] = kp[j] * sn[j] + k[j] * cs[j]; }
            }
            const bf16x8 qb = pack8(qr), kb = pack8(kr);
            *(bf16x8*)((bf16_t*)(pws(p) + WS_RQ) + tok * 512 + h * 128 + c0) = qb; *(bf16x8*)((bf16_t*)(pws(p) + WS_RK) + tok * 512 + h * 128 + c0) = kb;
            *(LAS bf16x8*)(Ks + t * LA_QS + c0) = kb;
            const float bt = (float)(t + 1) * tab[1024 + h];
            *(LAS f32x4*)(Bs + t * LA_BS + c0) = (f32x4){bt, bt, bt, bt}; *(LAS f32x4*)(Bs + t * LA_BS + c0 + 4) = (f32x4){bt, bt, bt, bt};
        }
    }
    la_vt_commit(tc, r.va, r.vb, lds);
    la_cumsum(tc, m, lds);
}
struct LaPreC { u32x4 a[2], b[2], va, vb, st[4]; };
DI void laC_issue(const TC tc, PRM p, int item, LaPreC& r) {
    int m, b, h, n; la_item(item, m, b, h, n);
    const bf16_t* PROJ = (const bf16_t*)(pws(p) + WS_PROJ); const int tid = tc.tid, c0 = (tid & 15) * 8;
#pragma unroll
    for (int ps = 0; ps < 2; ++ps) {
        const size_t tok = (size_t)b * SEQ + (size_t)n * LA_C + (tid >> 4) + 32 * ps;
        if (m == 0) { r.a[ps] = *(const u32x4*)(PROJ + tok * INC + C_HGQ + h * 128 + c0); r.b[ps] = *(const u32x4*)(PROJ + tok * INC + C_HGF + h * 128 + c0); }
        else { r.a[ps] = *(const u32x4*)((const bf16_t*)(pws(p) + WS_RQ) + tok * 512 + h * 128 + c0); r.b[ps] = *(const u32x4*)((const bf16_t*)(pws(p) + WS_RK) + tok * 512 + h * 128 + c0); }
    }
    const size_t tokv = (size_t)b * SEQ + (size_t)n * LA_C + 2 * (tid & 31);
    const bf16_t* pv = PROJ + tokv * INC + (m == 0 ? C_HGI : C_RTV) + h * 128 + (tid >> 5) * 8;
    r.va = *(const u32x4*)pv; r.vb = *(const u32x4*)(pv + INC);
    const bf16_t* st = (const bf16_t*)(pws(p) + WS_LAST) + (size_t)item * 16384;
#pragma unroll
    for (int i = 0; i < 4; ++i) r.st[i] = *(const u32x4*)(st + (i * 512 + tid) * 8);
}
DI void laC_commit(const TC tc, PRM p, int l, int item, const LaPreC& r, LAS unsigned char* lds) {
    int m, b, h, n; la_item(item, m, b, h, n);
    const int tid = tc.tid, c0 = (tid & 15) * 8;
    const float* tab = (const float*)(pws(p) + WS_TAB) + 16384;
    LAS bf16_t* Qs = (LAS bf16_t*)(lds + LA_Q); LAS bf16_t* Ks = (LAS bf16_t*)(lds + LA_K);
#pragma unroll
    for (int ps = 0; ps < 2; ++ps) {
        const int t = (tid >> 4) + 32 * ps;
        *(LAS u32x4*)(Qs + t * LA_QS + c0) = r.a[ps];
        if (m == 0) la_hg_kf(tab, l, h, c0, t, r.b[ps], lds);
        else *(LAS u32x4*)(Ks + t * LA_QS + c0) = r.b[ps];
    }
    la_vt_commit(tc, r.va, r.vb, lds);
    LAS bf16_t* STs = (LAS bf16_t*)(lds + LA_ST);
#pragma unroll
    for (int i = 0; i < 4; ++i) { const int e = (i * 512 + tid) * 8, v = e >> 7, k = e & 127; *(LAS u32x4*)(STs + v * LA_SS + k) = r.st[i]; }
    la_cumsum(tc, m, lds);
}

DI void la_phaseA(const TC tc, PRM p, int l, int item, LaPreA& pre, int next_item, LAS unsigned char* lds) {
    { TC t2 = tc; asm volatile("" : "+v"(t2.tid)); laA_commit(t2, p, l, item, pre, lds); }
    __builtin_amdgcn_sched_barrier(0);
    if (next_item >= 0) { TC t3 = tc; asm volatile("" : "+v"(t3.tid)); laA_issue(t3, p, next_item, pre); }
    __builtin_amdgcn_sched_barrier(0);
    const int tid = tc.tid, lane = tid & 63, w = tid >> 6, c0 = (tid & 15) * 8, tl = lane & 15, kg = lane >> 4;
    LAS bf16_t* Ks = (LAS bf16_t*)(lds + LA_K); LAS float* Bs = (LAS float*)(lds + LA_B); LAS bf16_t* VT = (LAS bf16_t*)(lds + LA_VT); LAS bf16_t* KT = (LAS bf16_t*)(lds + LA_ST);
    float bl[8];
    { const f32x4 a = *(const LAS f32x4*)(Bs + (LA_C - 1) * LA_BS + c0), c = *(const LAS f32x4*)(Bs + (LA_C - 1) * LA_BS + c0 + 4);
      bl[0] = a.x; bl[1] = a.y; bl[2] = a.z; bl[3] = a.w; bl[4] = c.x; bl[5] = c.y; bl[6] = c.z; bl[7] = c.w; }
#pragma unroll
    for (int ps = 0; ps < 2; ++ps) {
        const int t = (tid >> 4) + 32 * ps;
        float k[8]; unpack8(*(const LAS u32x4*)(Ks + t * LA_QS + c0), k);
        const f32x4 a = *(const LAS f32x4*)(Bs + t * LA_BS + c0), c = *(const LAS f32x4*)(Bs + t * LA_BS + c0 + 4);
        const float bt[8] = {a.x, a.y, a.z, a.w, c.x, c.y, c.z, c.w};
#pragma unroll
        for (int j = 0; j < 8; ++j) KT[(c0 + j) * LA_VS + t] = (bf16_t)f2bf(k[j] * fexp(bl[j] - bt[j]));
    }
    if (tid < 128) ((float*)(pws(p) + WS_LADEC))[(size_t)item * 128 + tid] = fexp(Bs[(LA_C - 1) * LA_BS + tid]);
    __syncthreads();
    f32x4 acc[8];
#pragma unroll
    for (int cb = 0; cb < 8; ++cb) acc[cb] = (f32x4){0.f, 0.f, 0.f, 0.f};
#pragma unroll
    for (int ks = 0; ks < 2; ++ks) {
        const bf16x8 a = *(const LAS bf16x8*)(VT + (16 * w + tl) * LA_VS + ks * 32 + 8 * kg);
#pragma unroll
        for (int cb = 0; cb < 8; ++cb) {
            const bf16x8 bb = *(const LAS bf16x8*)(KT + (cb * 16 + tl) * LA_VS + ks * 32 + 8 * kg);
            acc[cb] = __builtin_amdgcn_mfma_f32_16x16x32_bf16(bb, a, acc[cb], 0, 0, 0);
        }
    }
    bf16_t* st = (bf16_t*)(pws(p) + WS_LAST) + (size_t)item * 16384;
#pragma unroll
    for (int cb = 0; cb < 8; ++cb) { u32x2 w2; w2.x = pk2(acc[cb][0], acc[cb][1]); w2.y = pk2(acc[cb][2], acc[cb][3]); *(u32x2*)(st + (16 * w + tl) * 128 + cb * 16 + kg * 4) = w2; }
    __syncthreads();
}

DI void la_scan(const TC tc, PRM p) {
    bf16_t* ST = (bf16_t*)(pws(p) + WS_LAST); const float* DEC = (const float*)(pws(p) + WS_LADEC);
    for (int gid = tc.bid * 512 + tc.tid; gid < 16 * 8192; gid += tc.nb * 512) {
        const int seq = gid >> 13, e = (gid & 8191) * 2, k = e & 127;
        unsigned* st = (unsigned*)(ST + (size_t)seq * LA_NCH * 16384 + e); const float* dc = DEC + (size_t)seq * LA_NCH * 128 + k;
        float s0 = 0.f, s1 = 0.f;
        for (int n0 = 0; n0 < LA_NCH; n0 += 32) {
            unsigned kv[32]; float d0[32], d1[32];
#pragma unroll
            for (int u = 0; u < 32; ++u) { kv[u] = st[(size_t)(n0 + u) * 8192]; d0[u] = dc[(n0 + u) * 128]; d1[u] = dc[(n0 + u) * 128 + 1]; }
#pragma unroll
            for (int u = 0; u < 32; ++u) { if (tc.nostore && s0 == 12345.678f) st[0] = 1u; if (!tc.nostore) st[(size_t)(n0 + u) * 8192] = pk2(s0, s1); s0 = d0[u] * s0 + bflo(kv[u]); s1 = d1[u] * s1 + bfhi(kv[u]); }
        }
    }
}

DI void la_phaseC(const TC tc, PRM p, int l, int item, LaPreC& pre, int next_item, LAS unsigned char* lds) {
    const int n = item % LA_NCH, h = (item / LA_NCH) & 3, b = (item / (LA_NCH * 4)) & 1, m = item / (LA_NCH * 4 * NB);
    int tid = tc.tid; asm volatile("" : "+v"(tid));
    const int lane = tid & 63, w = tid >> 6, tl = lane & 15, kg = lane >> 4, rb = w >> 1, vh = w & 1;
    bf16_t gatev[4][4];
    {
        const bf16_t* pg = (const bf16_t*)(pws(p) + WS_PROJ) + ((size_t)b * SEQ + (size_t)n * LA_C + 16 * rb + kg * 4) * INC + (m == 0 ? C_HGG : C_RTG) + h * 128 + vh * 64 + tl;
#pragma unroll
        for (int r = 0; r < 4; ++r)
#pragma unroll
            for (int vb = 0; vb < 4; ++vb) gatev[r][vb] = pg[(size_t)r * INC + vb * 16];
    }
    { TC t2 = tc; asm volatile("" : "+v"(t2.tid)); laC_commit(t2, p, l, item, pre, lds); }
    __builtin_amdgcn_sched_barrier(0);
    if (next_item >= 0) { TC t3 = tc; asm volatile("" : "+v"(t3.tid)); laC_issue(t3, p, next_item, pre); }
    __builtin_amdgcn_sched_barrier(0);
    LAS bf16_t* Qs = (LAS bf16_t*)(lds + LA_Q); LAS bf16_t* Ks = (LAS bf16_t*)(lds + LA_K); LAS float* Bs = (LAS float*)(lds + LA_B); LAS bf16_t* VT = (LAS bf16_t*)(lds + LA_VT);
    LAS bf16_t* STs = (LAS bf16_t*)(lds + LA_ST); LAS bf16_t* Ps = (LAS bf16_t*)(lds + LA_P); LAS float* Xs = (LAS float*)(lds + LA_X);
    const float lgam = ((const float*)(pws(p) + WS_TAB))[16384 + 1024 + h];
    if (m == 0) {
        const int c0 = (tid & 15) * 8;
#pragma unroll
        for (int ps = 0; ps < 2; ++ps) {
            const int t = (tid >> 4) + 32 * ps, te = (t | 15);
            float k[8]; unpack8(*(const LAS u32x4*)(Ks + t * LA_QS + c0), k);
            const f32x4 a = *(const LAS f32x4*)(Bs + t * LA_BS + c0), c = *(const LAS f32x4*)(Bs + t * LA_BS + c0 + 4);
            const f32x4 ea = *(const LAS f32x4*)(Bs + te * LA_BS + c0), ec = *(const LAS f32x4*)(Bs + te * LA_BS + c0 + 4);
            const float bt[8] = {a.x, a.y, a.z, a.w, c.x, c.y, c.z, c.w}, be[8] = {ea.x, ea.y, ea.z, ea.w, ec.x, ec.y, ec.z, ec.w};
#pragma unroll
            for (int j = 0; j < 8; ++j) k[j] *= fexp(be[j] - bt[j]);
            *(LAS bf16x8*)(Ks + t * LA_QS + c0) = pack8(k);
        }
        __syncthreads();
    }
    f32x4 acc1[4];
#pragma unroll
    for (int vb = 0; vb < 4; ++vb) acc1[vb] = (f32x4){0.f, 0.f, 0.f, 0.f};
    if (m == 1) {
        bf16x8 qa[4];
#pragma unroll
        for (int ks = 0; ks < 4; ++ks) qa[ks] = *(const LAS bf16x8*)(Qs + (16 * rb + tl) * LA_QS + ks * 32 + 8 * kg);
#pragma unroll
        for (int ks = 0; ks < 4; ++ks)
#pragma unroll
            for (int vb = 0; vb < 4; ++vb) acc1[vb] = __builtin_amdgcn_mfma_f32_16x16x32_bf16(qa[ks], *(const LAS bf16x8*)(STs + (vh * 64 + vb * 16 + tl) * LA_SS + ks * 32 + 8 * kg), acc1[vb], 0, 0, 0);
#pragma unroll
        for (int r = 0; r < 4; ++r) { const float dq = fexp(lgam * (float)(16 * rb + kg * 4 + r + 1));
#pragma unroll
            for (int vb = 0; vb < 4; ++vb) acc1[vb][r] *= dq; }
        for (int cb = 0; cb <= rb; ++cb) {
            f32x4 sc = (f32x4){0.f, 0.f, 0.f, 0.f};
#pragma unroll
            for (int ks = 0; ks < 4; ++ks) sc = __builtin_amdgcn_mfma_f32_16x16x32_bf16(qa[ks], *(const LAS bf16x8*)(Ks + (cb * 16 + tl) * LA_QS + ks * 32 + 8 * kg), sc, 0, 0, 0);
#pragma unroll
            for (int r = 0; r < 4; ++r) { const int dts = (16 * rb + kg * 4 + r) - (cb * 16 + tl);
                const float v = dts >= 0 ? sc[r] * fexp(lgam * (float)dts) : 0.f; Ps[(16 * rb + kg * 4 + r) * LA_PS + cb * 16 + tl] = (bf16_t)f2bf(v); }
        }
    } else {
        bf16x8 qw[4], q0[4];
#pragma unroll
        for (int ks = 0; ks < 4; ++ks) {
            const int kc = ks * 32 + 8 * kg;
            float bw[8];
            if (rb > 0) { const f32x4 a = *(const LAS f32x4*)(Bs + (16 * rb - 1) * LA_BS + kc), c = *(const LAS f32x4*)(Bs + (16 * rb - 1) * LA_BS + kc + 4);
                bw[0] = a.x; bw[1] = a.y; bw[2] = a.z; bw[3] = a.w; bw[4] = c.x; bw[5] = c.y; bw[6] = c.z; bw[7] = c.w; }
            else {
#pragma unroll
                for (int j = 0; j < 8; ++j) bw[j] = 0.f; }
            float q[8]; unpack8(*(const LAS u32x4*)(Qs + (16 * rb + tl) * LA_QS + kc), q);
            const f32x4 a = *(const LAS f32x4*)(Bs + (16 * rb + tl) * LA_BS + kc), c = *(const LAS f32x4*)(Bs + (16 * rb + tl) * LA_BS + kc + 4);
            const float bt[8] = {a.x, a.y, a.z, a.w, c.x, c.y, c.z, c.w};
            float x0[8], x1[8];
#pragma unroll
            for (int j = 0; j < 8; ++j) { x1[j] = q[j] * fexp(bt[j] - bw[j]); x0[j] = q[j] * fexp(bt[j]); }
            q0[ks] = pack8(x0); qw[ks] = pack8(x1);
        }
#pragma unroll
        for (int ks = 0; ks < 4; ++ks)
#pragma unroll
            for (int vb = 0; vb < 4; ++vb) acc1[vb] = __builtin_amdgcn_mfma_f32_16x16x32_bf16(q0[ks], *(const LAS bf16x8*)(STs + (vh * 64 + vb * 16 + tl) * LA_SS + ks * 32 + 8 * kg), acc1[vb], 0, 0, 0);
        for (int cb = 0; cb <= rb; ++cb) {
            f32x4 sc = (f32x4){0.f, 0.f, 0.f, 0.f};
            if (cb == rb) {
#pragma unroll
                for (int ks = 0; ks < 4; ++ks) {
                    const int kc = ks * 32 + 8 * kg;
                    float q[8]; unpack8(*(const LAS u32x4*)(Qs + (16 * rb + tl) * LA_QS + kc), q);
                    const f32x4 a = *(const LAS f32x4*)(Bs + (16 * rb + tl) * LA_BS + kc), c = *(const LAS f32x4*)(Bs + (16 * rb + tl) * LA_BS + kc + 4);
                    const f32x4 na = *(const LAS f32x4*)(Bs + (16 * rb + 15) * LA_BS + kc), nc = *(const LAS f32x4*)(Bs + (16 * rb + 15) * LA_BS + kc + 4);
                    const float bt[8] = {a.x, a.y, a.z, a.w, c.x, c.y, c.z, c.w}, bn[8] = {na.x, na.y, na.z, na.w, nc.x, nc.y, nc.z, nc.w};
#pragma unroll
                    for (int j = 0; j < 8; ++j) q[j] *= fexp(fminf(bt[j] - bn[j], 80.0f));
                    sc = __builtin_amdgcn_mfma_f32_16x16x32_bf16(pack8(q), *(const LAS bf16x8*)(Ks + (cb * 16 + tl) * LA_QS + kc), sc, 0, 0, 0);
                }
            } else {
#pragma unroll
                for (int ks = 0; ks < 4; ++ks) {
                    const int kc = ks * 32 + 8 * kg;
                    bf16x8 af;
                    if (cb == rb - 1) af = qw[ks];
                    else {
                        float q[8]; unpack8(*(const LAS u32x4*)(Qs + (16 * rb + tl) * LA_QS + kc), q);
                        const f32x4 a = *(const LAS f32x4*)(Bs + (16 * rb + tl) * LA_BS + kc), c = *(const LAS f32x4*)(Bs + (16 * rb + tl) * LA_BS + kc + 4);
                        const f32x4 ea = *(const LAS f32x4*)(Bs + (16 * cb + 15) * LA_BS + kc), ec = *(const LAS f32x4*)(Bs + (16 * cb + 15) * LA_BS + kc + 4);
                        const float bt[8] = {a.x, a.y, a.z, a.w, c.x, c.y, c.z, c.w}, be[8] = {ea.x, ea.y, ea.z, ea.w, ec.x, ec.y, ec.z, ec.w};
#pragma unroll
                        for (int j = 0; j < 8; ++j) q[j] *= fexp(bt[j] - be[j]);
                        af = pack8(q);
                    }
                    sc = __builtin_amdgcn_mfma_f32_16x16x32_bf16(af, *(const LAS bf16x8*)(Ks + (cb * 16 + tl) * LA_QS + kc), sc, 0, 0, 0);
                }
            }
#pragma unroll
            for (int r = 0; r < 4; ++r) { const float v = (cb < rb || tl <= kg * 4 + r) ? sc[r] : 0.f; Ps[(16 * rb + kg * 4 + r) * LA_PS + cb * 16 + tl] = (bf16_t)f2bf(v); }
        }
    }
    if ((rb & 1) == 0) {
#pragma unroll
        for (int r = 0; r < 4; ++r) Ps[(16 * rb + kg * 4 + r) * LA_PS + (rb + 1) * 16 + tl] = (bf16_t)0;
    }
    const int nks = (rb >> 1) + 1;
    for (int ks = 0; ks < nks; ++ks) {
        const bf16x8 a = *(const LAS bf16x8*)(Ps + (16 * rb + tl) * LA_PS + ks * 32 + 8 * kg);
#pragma unroll
        for (int vb = 0; vb < 4; ++vb) acc1[vb] = __builtin_amdgcn_mfma_f32_16x16x32_bf16(a, *(const LAS bf16x8*)(VT + (vh * 64 + vb * 16 + tl) * LA_VS + ks * 32 + 8 * kg), acc1[vb], 0, 0, 0);
    }
    float s1[4], s2[4];
#pragma unroll
    for (int r = 0; r < 4; ++r) { float a = 0.f, q = 0.f;
#pragma unroll
        for (int vb = 0; vb < 4; ++vb) { acc1[vb][r] *= 0.08838834764831845f; a += acc1[vb][r]; q += acc1[vb][r] * acc1[vb][r]; }
        a += sx<1>(a); a += sx<2>(a); a += sx<4>(a); a += sx<8>(a);
        q += sx<1>(q); q += sx<2>(q); q += sx<4>(q); q += sx<8>(q);
        s1[r] = a; s2[r] = q;
        if (tl == 0) { Xs[((16 * rb + kg * 4 + r) * 2 + vh) * 2] = a; Xs[((16 * rb + kg * 4 + r) * 2 + vh) * 2 + 1] = q; } }
    __syncthreads();
    const bf16_t* PROJ = (const bf16_t*)(pws(p) + WS_PROJ);
    bf16_t* OBm = (bf16_t*)(pws(p) + WS_OB) + (size_t)(m == 0 ? 0 : 2) * T * 512;
    const float* hnorm = (const float*)pin(p, I_HG_NORM) + l * 512 + h * 128;
#pragma unroll
    for (int r = 0; r < 4; ++r) {
        const int t = 16 * rb + kg * 4 + r; const size_t tok = (size_t)b * SEQ + (size_t)n * LA_C + t;
        const float a = s1[r] + Xs[(t * 2 + (vh ^ 1)) * 2], q = s2[r] + Xs[(t * 2 + (vh ^ 1)) * 2 + 1];
        float mu = 0.f, rs;
        if (m == 0) rs = frsq(q * (1.0f / 128.0f) + EPS);
        else { mu = a * (1.0f / 128.0f); rs = frsq(fmaxf(q * (1.0f / 128.0f) - mu * mu, 0.f) + EPS); }
#pragma unroll
        for (int vb = 0; vb < 4; ++vb) {
            const int v = vh * 64 + vb * 16 + tl;
            const float gt = bf2f(gatev[r][vb]);
            float o = (acc1[vb][r] - mu) * rs * siluf_(gt);
            if (m == 0) o *= hnorm[v];
            OBm[tok * 512 + h * 128 + v] = (bf16_t)f2bf(o);
        }
    }
    __syncthreads();
}

DI void mixer_post(const TC tc, PRM p, int l) {
    const bf16_t* PROJ = (const bf16_t*)(pws(p) + WS_PROJ);
    const float* OT = (const float*)(pws(p) + WS_OTMP);
    bf16_t* OB = (bf16_t*)(pws(p) + WS_OB); bf16_t* YS5 = (bf16_t*)(pws(p) + WS_YS5);
    const float* hnorm = (const float*)pin(p, I_HG_NORM) + l * 512; const float* s5d = (const float*)pin(p, I_S5_D) + l * 512;
    const int lane = tc.tid & 63, gw = tc.bid * 8 + (tc.tid >> 6), NGW = tc.nb * 8, c0 = lane * 8;
    for (int t = gw; t < T; t += NGW) {
        const bf16_t* prow = PROJ + (size_t)t * INC;
        if (!LA_HG) {
            float o[8], g[8], r[8];
            const f32x4 a = *(const f32x4*)(OT + (size_t)t * 512 + c0), bq = *(const f32x4*)(OT + (size_t)t * 512 + c0 + 4);
            o[0] = a.x; o[1] = a.y; o[2] = a.z; o[3] = a.w; o[4] = bq.x; o[5] = bq.y; o[6] = bq.z; o[7] = bq.w;
            float ss = 0.f;
#pragma unroll
            for (int j = 0; j < 8; ++j) ss += o[j] * o[j];
            ss += sx<8>(ss); ss += sx<4>(ss); ss += sx<2>(ss); ss += sx<1>(ss);
            const float sc = 1.0f / sqrtf(ss * (1.0f / 128.0f) + EPS);
            load8_bf16(prow + C_HGG + c0, g);
#pragma unroll
            for (int j = 0; j < 8; ++j) r[j] = o[j] * sc * hnorm[c0 + j] * siluf_(g[j]);
            store8_bf16(OB + (size_t)t * 512 + c0, r);
        }
        if (!LA_RT) {
            float o[8], g[8], r[8];
            const float* src = OT + (size_t)2 * T * 512 + (size_t)t * 512 + c0;
            const f32x4 a = *(const f32x4*)src, bq = *(const f32x4*)(src + 4);
            o[0] = a.x; o[1] = a.y; o[2] = a.z; o[3] = a.w; o[4] = bq.x; o[5] = bq.y; o[6] = bq.z; o[7] = bq.w;
            float s = 0.f;
#pragma unroll
            for (int j = 0; j < 8; ++j) s += o[j];
            s += sx<8>(s); s += sx<4>(s); s += sx<2>(s); s += sx<1>(s);
            const float mu = s * (1.0f / 128.0f);
            float q = 0.f;
#pragma unroll
            for (int j = 0; j < 8; ++j) { o[j] -= mu; q += o[j] * o[j]; }
            q += sx<8>(q); q += sx<4>(q); q += sx<2>(q); q += sx<1>(q);
            const float sc = 1.0f / sqrtf(q * (1.0f / 128.0f) + EPS);
            load8_bf16(prow + C_RTG + c0, g);
#pragma unroll
            for (int j = 0; j < 8; ++j) r[j] = o[j] * sc * siluf_(g[j]);
            store8_bf16(OB + (size_t)2 * T * 512 + (size_t)t * 512 + c0, r);
        }
    }
}

DI unsigned f2key(float x) { const unsigned u = __float_as_uint(x); return u ^ ((u >> 31) ? 0xffffffffu : 0x80000000u); }
DI float key2f(unsigned k) { const unsigned u = (k >> 31) ? (k ^ 0x80000000u) : ~k; return __uint_as_float(u); }
#define CE_DESC(a, b) do { const unsigned _x = (a), _y = (b); (a) = _x > _y ? _x : _y; (b) = _x > _y ? _y : _x; } while (0)
DI void sort16_desc(unsigned (&v)[16]) {
#pragma unroll
    for (int k = 2; k <= 16; k <<= 1)
#pragma unroll
        for (int j = k >> 1; j > 0; j >>= 1)
#pragma unroll
            for (int i = 0; i < 16; ++i) { const int q = i ^ j; if (q > i) { if ((i & k) == 0) CE_DESC(v[i], v[q]); else CE_DESC(v[q], v[i]); } }
}
DI void merge16_desc(unsigned (&r)[16], const unsigned (&g)[16]) {
#pragma unroll
    for (int i = 0; i < 16; ++i) r[i] = r[i] > g[15 - i] ? r[i] : g[15 - i];
#pragma unroll
    for (int j = 8; j > 0; j >>= 1)
#pragma unroll
        for (int i = 0; i < 16; ++i) if ((i & j) == 0) CE_DESC(r[i], r[i + j]);
}
DI void top16_of_128(const unsigned short* row, unsigned (&r)[16]) {
    u32x4 nx[2];
#pragma unroll
    for (int q = 0; q < 2; ++q) nx[q] = *(const u32x4*)(row + q * 8);
#pragma unroll 1
    for (int gi = 0; gi < 8; ++gi) {
        unsigned g[16];
        f32x4 cv[4];
#pragma unroll
        for (int q = 0; q < 2; ++q) { const u32x4 w = nx[q];
            cv[2 * q] = (f32x4){h2f((unsigned short)w.x), h2f((unsigned short)(w.x >> 16)), h2f((unsigned short)w.y), h2f((unsigned short)(w.y >> 16))};
            cv[2 * q + 1] = (f32x4){h2f((unsigned short)w.z), h2f((unsigned short)(w.z >> 16)), h2f((unsigned short)w.w), h2f((unsigned short)(w.w >> 16))}; }
        if (gi < 7) {
#pragma unroll
            for (int q = 0; q < 2; ++q) nx[q] = *(const u32x4*)(row + (gi + 1) * 16 + q * 8); }
#pragma unroll
        for (int q = 0; q < 4; ++q) { const f32x4 v = cv[q]; const unsigned ib = 127u - (unsigned)(gi * 16 + q * 4);
            g[q * 4 + 0] = (f2key(v.x) & ~127u) | ib; g[q * 4 + 1] = (f2key(v.y) & ~127u) | (ib - 1u); g[q * 4 + 2] = (f2key(v.z) & ~127u) | (ib - 2u); g[q * 4 + 3] = (f2key(v.w) & ~127u) | (ib - 3u); }
        sort16_desc(g);
        if (gi == 0) {
#pragma unroll
            for (int i = 0; i < 16; ++i) r[i] = g[i];
        } else merge16_desc(r, g);
    }
}
DI void peer_route(const TC tc, PRM p, LAS unsigned char* lds) {
    const unsigned short* SC = (const unsigned short*)(pws(p) + WS_SC);
    float* GATE = (float*)(pws(p) + WS_GATE);
    LAS unsigned short* li = (LAS unsigned short*)lds;
    for (int it = tc.bid * 512 + tc.tid; it < T * 8; it += tc.nb * 512) {
        unsigned r1[16], r2[16];
        top16_of_128(SC + (size_t)it * 256, r1);
        top16_of_128(SC + (size_t)it * 256 + 128, r2);
        float s1[16], s2[16];
#pragma unroll
        for (int i = 0; i < 16; ++i) { li[i * 512 + tc.tid] = (unsigned short)(127u - (r1[i] & 127u)); li[(16 + i) * 512 + tc.tid] = (unsigned short)(127u - (r2[i] & 127u));
            s1[i] = key2f(r1[i] & ~127u); s2[i] = key2f(r2[i] & ~127u); }
        unsigned best[16];
#pragma unroll
        for (int gi = 0; gi < 4; ++gi) {
            unsigned g[16];
#pragma unroll
            for (int q = 0; q < 16; ++q) {
                constexpr int CI[64] = {0,0,0,0,0,0,0,0,0,0,0,0,0,0,0,0, 1,1,1,1,1,1,1,1, 2,2,2,2,2, 3,3,3,3, 4,4,4, 5,5, 6,6, 7,7, 8,9,10,11,12,13,14,15, -1,-1,-1,-1,-1,-1,-1,-1,-1,-1,-1,-1,-1,-1};
                constexpr int CJ[64] = {0,1,2,3,4,5,6,7,8,9,10,11,12,13,14,15, 0,1,2,3,4,5,6,7, 0,1,2,3,4, 0,1,2,3, 0,1,2, 0,1, 0,1, 0,1, 0,0,0,0,0,0,0,0, 0,0,0,0,0,0,0,0,0,0,0,0,0,0};
                const int ci = CI[gi * 16 + q], cj = CJ[gi * 16 + q];
                g[q] = ci < 0 ? 0u : ((f2key(s1[ci < 0 ? 0 : ci] + s2[cj]) & ~255u) | (255u - (unsigned)((ci < 0 ? 0 : ci) * 16 + cj)));
            }
            sort16_desc(g);
            if (gi == 0) {
#pragma unroll
                for (int i = 0; i < 16; ++i) best[i] = g[i];
            } else merge16_desc(best, g);
        }
        float e[16], sum = 0.f; const float m0 = key2f(best[0] & ~255u);
        int ids[16];
#pragma unroll
        for (int s = 0; s < 16; ++s) { const unsigned pos = 255u - (best[s] & 255u); const int i1 = li[(pos >> 4) * 512 + tc.tid], i2 = li[(16 + (pos & 15u)) * 512 + tc.tid];
            ids[s] = i1 * 128 + i2; e[s] = fexp(key2f(best[s] & ~255u) - m0); sum += e[s]; }
        const float inv = frcp(sum);
#pragma unroll
        for (int s = 0; s < 16; s += 4) {
            *(u32x2*)((unsigned short*)(pws(p) + WS_IDX16) + (size_t)it * 16 + s) = (u32x2){(unsigned)ids[s] | ((unsigned)ids[s + 1] << 16), (unsigned)ids[s + 2] | ((unsigned)ids[s + 3] << 16)};
            *(f32x4*)(GATE + (size_t)it * 16 + s) = (f32x4){e[s] * inv, e[s + 1] * inv, e[s + 2] * inv, e[s + 3] * inv};
        }
    }
}

DI void peer_convert(const TC tc, PRM p, int l) {
    const float* U = (const float*)pin(p, I_PEER_U) + (size_t)l * NEXP * D; const float* V = (const float*)pin(p, I_PEER_V) + (size_t)l * NEXP * D;
    unsigned char* UB = pws(p) + WS_PEERU; unsigned char* VB = pws(p) + WS_PEERV; float* SCL = (float*)(pws(p) + WS_PEERS);
    const int lane = tc.tid & 63, gw = tc.bid * 8 + (tc.tid >> 6), NGW = tc.nb * 8;
    f32x4 nx[4], ny[4];
#pragma unroll
    for (int q = 0; q < 4; ++q) { nx[q] = (f32x4){0.f, 0.f, 0.f, 0.f}; ny[q] = nx[q]; }
    if (gw < 2 * NEXP) { const float* s = (gw < NEXP ? U + (size_t)gw * D : V + (size_t)(gw - NEXP) * D) + lane * 16;
#pragma unroll
        for (int q = 0; q < 4; ++q) nx[q] = __builtin_nontemporal_load((const f32x4*)(s + 4 * q)); }
    if (gw + NGW < 2 * NEXP) { const int rn = gw + NGW; const float* s = (rn < NEXP ? U + (size_t)rn * D : V + (size_t)(rn - NEXP) * D) + lane * 16;
#pragma unroll
        for (int q = 0; q < 4; ++q) ny[q] = __builtin_nontemporal_load((const f32x4*)(s + 4 * q)); }
    for (int r = gw; r < 2 * NEXP; r += NGW) {
        f32x4 v[4];
#pragma unroll
        for (int q = 0; q < 4; ++q) { v[q] = nx[q]; nx[q] = ny[q]; }
        { const int rn = r + 2 * NGW;
          if (rn < 2 * NEXP) { const float* s = (rn < NEXP ? U + (size_t)rn * D : V + (size_t)(rn - NEXP) * D) + lane * 16;
#pragma unroll
              for (int q = 0; q < 4; ++q) ny[q] = __builtin_nontemporal_load((const f32x4*)(s + 4 * q)); } }
        float am = 0.f;
#pragma unroll
        for (int q = 0; q < 4; ++q) am = fmaxf(fmaxf(am, fmaxf(fabsf(v[q].x), fabsf(v[q].y))), fmaxf(fabsf(v[q].z), fabsf(v[q].w)));
        am = fmaxf(wave_max(am), 1e-30f);
        int ex = 8 - (int)((__float_as_uint(am) >> 23) & 0xffu) + 127;
        ex = ex > 120 ? 120 : (ex < -120 ? -120 : ex);
        float sc = __uint_as_float((unsigned)(ex + 127) << 23);
        if (am * sc > 448.0f) sc *= 0.5f;
        u32x4 w;
        int t0 = 0, t1 = 0, t2 = 0, t3 = 0;
        t0 = __builtin_amdgcn_cvt_pk_fp8_f32(v[0].x * sc, v[0].y * sc, t0, false); t0 = __builtin_amdgcn_cvt_pk_fp8_f32(v[0].z * sc, v[0].w * sc, t0, true);
        t1 = __builtin_amdgcn_cvt_pk_fp8_f32(v[1].x * sc, v[1].y * sc, t1, false); t1 = __builtin_amdgcn_cvt_pk_fp8_f32(v[1].z * sc, v[1].w * sc, t1, true);
        t2 = __builtin_amdgcn_cvt_pk_fp8_f32(v[2].x * sc, v[2].y * sc, t2, false); t2 = __builtin_amdgcn_cvt_pk_fp8_f32(v[2].z * sc, v[2].w * sc, t2, true);
        t3 = __builtin_amdgcn_cvt_pk_fp8_f32(v[3].x * sc, v[3].y * sc, t3, false); t3 = __builtin_amdgcn_cvt_pk_fp8_f32(v[3].z * sc, v[3].w * sc, t3, true);
        w.x = (unsigned)t0; w.y = (unsigned)t1; w.z = (unsigned)t2; w.w = (unsigned)t3;
        *(u32x4*)((r < NEXP ? UB : VB) + (size_t)(lane >> 3) * ((size_t)NEXP * 128) + (size_t)(r < NEXP ? r : r - NEXP) * 128 + (lane & 7) * 16) = w;
        if (lane == 0) SCL[r] = 1.0f / sc;
    }
}
DI void unpack_fp8x16(const u32x4 w, float (&o)[16]) {
    typedef float f32x2 __attribute__((ext_vector_type(2)));
    const unsigned ww[4] = {w.x, w.y, w.z, w.w};
#pragma unroll
    for (int q = 0; q < 4; ++q) { const f32x2 a = __builtin_amdgcn_cvt_pk_f32_fp8((int)ww[q], false), b = __builtin_amdgcn_cvt_pk_f32_fp8((int)ww[q], true);
        o[4 * q] = a.x; o[4 * q + 1] = a.y; o[4 * q + 2] = b.x; o[4 * q + 3] = b.y; }
}
typedef __amdgpu_buffer_rsrc_t brsrc_t;
DI brsrc_t mk_rsrc(const void* base) { return __builtin_amdgcn_make_buffer_rsrc((void*)base, 0, 0x7fffffff, 0x00020000); }
DI u32x4 bld4(brsrc_t r, unsigned voff, unsigned soff, int imm) { return __builtin_amdgcn_raw_buffer_load_b128(r, (int)voff + imm, (int)soff, 0); }
DI u32x2 bld2(brsrc_t r, unsigned voff, unsigned soff, int imm) { return __builtin_amdgcn_raw_buffer_load_b64(r, (int)voff + imm, (int)soff, 0); }
DI long pu_op(unsigned lo, unsigned hi) { u32x2 w; w.x = lo; w.y = hi; return __builtin_bit_cast(long, w); }
struct PuG { u32x4 g[16]; };
DI void pu_issue(brsrc_t ru, unsigned soff, unsigned vc, const u32x4 (&id)[2], PuG& G) {
#pragma unroll
    for (int n = 0; n < 16; ++n) { const unsigned w = id[n >> 3][(n >> 1) & 3]; const unsigned e7 = (n & 1) ? ((w >> 9) & 0x7fff80u) : ((w << 7) & 0x7fff80u); G.g[n] = bld4(ru, e7 + vc, soff, 0); }
}
DI void peer_experts_u(const TC tc, PRM p, int l, LAS unsigned char* lds) {
    const unsigned short* IDX16 = (const unsigned short*)(pws(p) + WS_IDX16); float* GATE = (float*)(pws(p) + WS_GATE); const float* SCL = (const float*)(pws(p) + WS_PEERS);
    const brsrc_t ru = mk_rsrc(pws(p) + WS_PEERU), ri = mk_rsrc(pws(p) + WS_IDX16), rh = mk_rsrc(pws(p) + WS_HQ);
    const int lane = tc.tid & 63, r16 = lane & 15, kg = lane >> 4, r8 = lane >> 3, c8 = lane & 7, xs = rfl(tc.bid & 7);
    const int wv = rfl(tc.tid >> 6), gw = rfl(tc.bid * 8 + wv), NGW = rfl(tc.nb * 8);
    const unsigned vid = (unsigned)r8 * 32u, vc = (unsigned)c8 * 16u, vh = (unsigned)kg * 8u;
    LAS unsigned char* wl = lds + wv * 16384;
    LAS unsigned char* wp = wl + r8 * 128 + ((c8 ^ r8) << 4);
    LAS unsigned char* rp[4];
#pragma unroll
    for (int s = 0; s < 4; ++s) rp[s] = wl + r16 * 128 + (((2 * s + (kg >> 1)) ^ (r16 & 7)) << 4) + (kg & 1) * 8;
    for (int tb = gw; tb < T; tb += NGW * 8) {
        f32x4 ah[8], al[8];
#pragma unroll
        for (int i = 0; i < 8; ++i) { ah[i] = (f32x4){0.f, 0.f, 0.f, 0.f}; al[i] = (f32x4){0.f, 0.f, 0.f, 0.f}; }
#define PU_TOK(i) ((unsigned)((tb + (i) * NGW) < T ? (tb + (i) * NGW) : T - 1))
#define PU_IDS(dst, i) do { const unsigned _o = PU_TOK(i) * 256u; dst[0] = bld4(ri, vid, _o, 0); dst[1] = bld4(ri, vid, _o, 16); } while (0)
#define PU_H(dst1, dst2, i, sl) do { const unsigned _o = PU_TOK(i) * (unsigned)D + (unsigned)(sl) * 128u; _Pragma("unroll") for (int _s = 0; _s < 4; ++_s) { dst1[_s] = bld2(rh, vh, _o, 32 * _s); \
        dst2[_s] = PEER_LO ? bld2(rh, vh, _o + (unsigned)(T * D), 32 * _s) : dst1[_s]; } } while (0)
        PuG G; u32x4 idn[2]; u32x2 hc1[4], hc2[4], hn1[4], hn2[4];
        { PU_IDS(idn, 0); PU_H(hc1, hc2, 0, xs); pu_issue(ru, (unsigned)xs * (unsigned)(NEXP * 128), vc, idn, G); PU_IDS(idn, 1); }
#pragma unroll 1
        for (int js = 0; js < 8; ++js) {
            const int sl = (tc.nostore && PROBE_SEL == 7) ? xs : ((js + xs) & 7), sln = (tc.nostore && PROBE_SEL == 7) ? xs : ((js + 1 + xs) & 7);
            const unsigned so = (unsigned)sl * (unsigned)(NEXP * 128), son = (unsigned)sln * (unsigned)(NEXP * 128);
#pragma unroll
            for (int i = 0; i < 8; ++i) {
#pragma unroll
                for (int n = 0; n < 16; ++n) *(LAS u32x4*)(wp + n * 1024) = G.g[n];
                pu_issue(ru, i == 7 ? son : so, vc, idn, G);
                PU_IDS(idn, (i + 2) & 7);
                PU_H(hn1, hn2, (i + 1) & 7, i == 7 ? sln : sl);
#pragma unroll
                for (int mb = 0; mb < 8; ++mb) {
                    const bool sel = (r16 == mb);
#pragma unroll
                    for (int s = 0; s < 4; ++s) {
                        const long ao = *(const LAS long*)(rp[s] + mb * 2048);
                        ah[i] = __builtin_amdgcn_mfma_f32_16x16x32_fp8_fp8(ao, pu_op(sel ? hc1[s].x : 0u, sel ? hc1[s].y : 0u), ah[i], 0, 0, 0);
                        if (PEER_LO) al[i] = __builtin_amdgcn_mfma_f32_16x16x32_fp8_fp8(ao, pu_op(sel ? hc2[s].x : 0u, sel ? hc2[s].y : 0u), al[i], 0, 0, 0);
                        asm volatile("s_nop 7");
                    }
                }
#pragma unroll
                for (int s = 0; s < 4; ++s) { hc1[s] = hn1[s]; hc2[s] = hn2[s]; }
            }
        }
        asm volatile("s_nop 15\n\ts_nop 15");
        unsigned char* AQ = pws(p) + WS_AQ; float* ASC = (float*)(pws(p) + WS_ASC);
#pragma unroll
        for (int i = 0; i < 8; ++i) {
            const int t = tb + i * NGW; const int tl = t < T ? t : T - 1;
            float act[4];
#pragma unroll
            for (int r = 0; r < 4; ++r) {
                const size_t o = (size_t)tl * 128 + 64 * (kg & 1) + 16 * r + 2 * (r16 & 7) + (kg >> 1);
                const int e = (int)IDX16[o]; const float a = (ah[i][r] + (PEER_LO ? al[i][r] * 0.0625f : 0.f)) * 0.125f * SCL[e];
                act[r] = (r16 < 8) ? gelu_tanh(a) * GATE[o] * SCL[NEXP + e] : 0.f;
            }
            float am = fmaxf(wave_max(fmaxf(fmaxf(fabsf(act[0]), fabsf(act[1])), fmaxf(fabsf(act[2]), fabsf(act[3])))), 1e-30f);
            int ex = 8 - (int)((__float_as_uint(am) >> 23) & 0xffu) + 127; ex = ex > 120 ? 120 : (ex < -120 ? -120 : ex);
            float sc = __uint_as_float((unsigned)(ex + 127) << 23); if (am * sc > 448.0f) sc *= 0.5f;
            typedef float f32x2 __attribute__((ext_vector_type(2)));
            const unsigned q1 = fp8x4(act[0] * sc, act[1] * sc, act[2] * sc, act[3] * sc);
            const f32x2 d0 = __builtin_amdgcn_cvt_pk_f32_fp8((int)q1, false), d1 = __builtin_amdgcn_cvt_pk_f32_fp8((int)q1, true);
            const unsigned q2 = fp8x4((act[0] * sc - d0.x) * 16.0f, (act[1] * sc - d0.y) * 16.0f, (act[2] * sc - d1.x) * 16.0f, (act[3] * sc - d1.y) * 16.0f);
            if (t < T && r16 < 8 && (!tc.nostore || q1 == 0x12345678u)) {
                unsigned char* d = AQ + (size_t)t * 256 + (2 * (r16 & 1) + (kg >> 1)) * 32 + (r16 >> 1) * 8 + 4 * (kg & 1);
                *(unsigned*)d = q1; *(unsigned*)(d + 128) = q2;
                if (lane == 0) ASC[t] = 1.0f / sc;
            }
        }
#undef PU_TOK
#undef PU_IDS
#undef PU_H
    }
}
DI void peer_experts_v(const TC tc, PRM p, LAS unsigned char* lds) {
    typedef int i32x2_ __attribute__((ext_vector_type(2)));
    const brsrc_t rv = mk_rsrc(pws(p) + WS_PEERV), ri = mk_rsrc(pws(p) + WS_IDX16), ra = mk_rsrc(pws(p) + WS_AQ);
    const float* ASC = (const float*)(pws(p) + WS_ASC); float* X = pout(p);
    const int lane = tc.tid & 63, r16 = lane & 15, kg = lane >> 4, r8 = lane >> 3, c8 = lane & 7;
    const int xs = rfl(tc.bid & 7), rank = rfl(tc.bid >> 3), nrank = rfl(tc.nb >> 3), wv = rfl(tc.tid >> 6), tstep = nrank * 8;
    if (rank >= nrank) return;
    const unsigned vid = (unsigned)r8 * 32u, vc = (unsigned)c8 * 16u, va = (unsigned)(r16 & 1) * 128u + (unsigned)kg * 32u, so = (unsigned)xs * (unsigned)(NEXP * 128);
    LAS unsigned char* wl = lds + wv * 16384;
    LAS unsigned char* wp = wl + r8 * 128 + ((c8 ^ r8) << 4);
    LAS unsigned char* tp[8];
#pragma unroll
    for (int cb = 0; cb < 8; ++cb) tp[cb] = wl + (8 * kg + (r16 >> 1)) * 128 + ((cb ^ (r16 >> 1)) << 4) + 8 * (r16 & 1);
#define PV_IDS(dst, t) do { const unsigned _o = (unsigned)(t) * 256u; dst[0] = bld4(ri, vid, _o, 0); dst[1] = bld4(ri, vid, _o, 16); } while (0)
    int t = rank * 8 + wv;
    PuG G0, G1; u32x4 idn[2]; u32x4 aq0, aq1; float asc;
    if (t < T) { PV_IDS(idn, t); pu_issue(rv, so, vc, idn, G0); aq0 = bld4(ra, va, (unsigned)t * 256u, 0); aq1 = bld4(ra, va, (unsigned)t * 256u, 16); asc = ASC[t];
                 if (t + tstep < T) { PV_IDS(idn, t + tstep); pu_issue(rv, so, vc, idn, G1); }
                 if (t + 2 * tstep < T) PV_IDS(idn, t + 2 * tstep); }
#define PV_STEP(G, tt) do { \
        _Pragma("unroll") for (int n = 0; n < 16; ++n) *(LAS u32x4*)(wp + n * 1024) = G.g[n]; \
        const u32x4 ca0 = aq0, ca1 = aq1; const float casc = asc; \
        const int tn = (tt) + tstep, tn2 = (tt) + 2 * tstep; \
        if (tn2 < T) { pu_issue(rv, so, vc, idn, G); if (tn2 + tstep < T) PV_IDS(idn, tn2 + tstep); } \
        if (tn < T) { aq0 = bld4(ra, va, (unsigned)tn * 256u, 0); aq1 = bld4(ra, va, (unsigned)tn * 256u, 16); asc = ASC[tn]; } \
        float* xr = X + (size_t)(tt) * D + xs * 128 + r16; \
        float xv[8]; \
        if (kg == 0) { _Pragma("unroll") for (int cb = 0; cb < 8; ++cb) xv[cb] = xr[cb * 16]; } \
        const bool sel = r16 < 2; \
        long aop[4]; \
        aop[0] = pu_op(sel ? ca0.x : 0u, sel ? ca0.y : 0u); aop[1] = pu_op(sel ? ca0.z : 0u, sel ? ca0.w : 0u); \
        aop[2] = pu_op(sel ? ca1.x : 0u, sel ? ca1.y : 0u); aop[3] = pu_op(sel ? ca1.z : 0u, sel ? ca1.w : 0u); \
        f32x4 acc[8]; \
        _Pragma("unroll") for (int cb = 0; cb < 8; ++cb) { \
            acc[cb] = (f32x4){0.f, 0.f, 0.f, 0.f}; \
            _Pragma("unroll") for (int s = 0; s < 4; ++s) { \
                const i32x2_ bv = __builtin_amdgcn_ds_read_tr8_b64_v2i32((LAS i32x2_*)(tp[cb] + s * 4096)); \
                acc[cb] = __builtin_amdgcn_mfma_f32_16x16x32_fp8_fp8(aop[s], __builtin_bit_cast(long, bv), acc[cb], 0, 0, 0); } \
            asm volatile("s_nop 7"); } \
        asm volatile("s_nop 15\n\ts_nop 15"); \
        if (kg == 0 && (!tc.nostore || acc[0][0] == 12345.678f)) {        \
            _Pragma("unroll") for (int cb = 0; cb < 8; ++cb) xr[cb * 16] = xv[cb] + (acc[cb][0] + acc[cb][1] * 0.0625f) * casc; } \
    } while (0)
    for (; t < T; t += 2 * tstep) {
        PV_STEP(G0, t);
        if (t + tstep < T) PV_STEP(G1, t + tstep);
    }
#undef PV_STEP
#undef PV_IDS
}

constexpr int PH_PRO = 3, PH_MAX = 48;
struct Prog { GemmDesc d[PH_MAX]; int n; };
constexpr GemmDesc gd0() { GemmDesc g{}; g.nz = 1; g.scale = 1.0f; g.M = T; g.bA = B_WS; g.bB = B_WS; g.bC = B_WS; g.bE0 = B_WS; g.bE1 = B_WS; g.bE2 = B_WS; return g; }
constexpr Prog make_prog() {
    Prog P{};
    for (int ph = 0; ph < PH_MAX; ++ph) P.d[ph] = gd0();
    P.d[0].kind = K_INIT;
    {
        GemmDesc& g = P.d[1]; GemmDesc& g2 = P.d[PH_MAX - 2]; g.alt = PH_MAX - 2; g.split = 32;
        g.kind = K_GEMM; g.oA = WS_MEMN; g.lda = D; g.zA_lo = (long)NB * MEM * D; g.oB = WS_WKV_T; g.ldb = D; g.zB_lo = (long)2 * D * D; g.M = NB * MEM; g.N = 2 * D; g.K = D; g.nz = DEPTH;
        g.oC = WS_KVB; g.ldc = 2 * D; g.zC_lo = (long)NB * MEM * 2 * D; g.epi = E_BF16;
        g2.kind = K_GEMM; g2.oA = WS_KBD; g2.lda = 256; g2.zA_l = 8 * 65536; g2.zA_hi = 4 * 65536; g2.zA_lo = 65536;
        g2.oB = WS_PWQB; g2.ldb = 2048; g2.zB_l = (long)D * 2048; g2.zB_hi = 4 * 256; g2.zB_lo = 256; g2.M = 256; g2.N = D; g2.K = 256; g2.nz = 16;
        g2.oC = WS_WPK_T; g2.ldc = D; g2.zC_l = (long)2048 * D; g2.zC_hi = (long)4 * 256 * D; g2.zC_lo = (long)256 * D; g2.epi = E_BF16;
    }
    {
        GemmDesc& g = P.d[2]; GemmDesc& g2 = P.d[PH_MAX - 1]; g.alt = PH_MAX - 1; g.split = 128;
        g.kind = K_GEMM; g.oA = WS_KVB; g.lda = 2 * D; g.zA_l = (long)NB * MEM * 2 * D; g.zA_hi = (long)MEM * 2 * D; g.zA_lo = 256;
        g.oB = WS_WQB; g.ldb = D; g.zB_l = (long)D * D; g.zB_hi = 0; g.zB_lo = 256; g.M = 256; g.N = D; g.K = 256; g.nz = 16;
        g.oC = WS_WQK_T; g.ldc = D; g.zC_l = (long)2 * D * D; g.zC_hi = (long)D * D; g.zC_lo = (long)256 * D; g.epi = E_BF16; g.scale = 0.0625f;
        g2.kind = K_GEMM; g2.oA = WS_WOT; g2.lda = D; g2.zA_l = (long)D * D; g2.zA_hi = 0; g2.zA_lo = 256;
        g2.oB = WS_KVB + (size_t)D * 2; g2.ldb = 2 * D; g2.zB_l = (long)NB * MEM * 2 * D; g2.zB_hi = (long)MEM * 2 * D; g2.zB_lo = 256; g2.M = D; g2.N = 256; g2.K = 256; g2.nz = 16;
        g2.oC = WS_VWO_T; g2.ldc = D; g2.zC_l = (long)2 * D * D; g2.zC_hi = (long)D * D; g2.zC_lo = 256; g2.epi = E_BF16;
    }
    int n = PH_PRO;
    for (int l = 0; l < DEPTH; ++l) {
        const int base = n;
        for (int s = 0; s < 16; ++s) P.d[base + s].layer = l;
        { GemmDesc& g = P.d[base + 0]; g.kind = K_RMS; g.bA = (l == 0 ? (int)I_X : (int)B_OUT); g.bB = I_NORM_MIX; g.oB = (long)l * D * 4; g.oC = WS_HN; g.epi = E_BF16; }
        { GemmDesc& g = P.d[base + 1]; g.kind = K_GEMM; g.oA = WS_HN; g.lda = D; g.oB = WS_WIN_T + (size_t)l * INC * D * 2; g.ldb = D; g.N = INC; g.K = D; g.oC = WS_PROJ; g.ldc = INC; g.epi = E_BF16; }
        P.d[base + 2].kind = K_MIX1;
        P.d[base + 3].kind = K_MIX2;
        P.d[base + 4].kind = K_MIX3;
        { GemmDesc& g = P.d[base + 5]; g.kind = K_GEMM; g.oA = WS_YS5; g.lda = 512; g.oB = WS_WGLU_T + (size_t)l * 512 * 512 * 2; g.ldb = 512; g.N = 512; g.K = 512;
          g.oC = WS_OB + (size_t)1 * T * 512 * 2; g.ldc = 512; g.epi = E_GLU; g.bE0 = I_S5_BGLU; g.oE0 = (long)l * 512 * 4; }
        { GemmDesc& g = P.d[base + 6];
          g.kind = K_GEMM; g.oA = WS_OB; g.lda = 512; g.zA_lo = (long)T * 512; g.oB = WS_WBR_T + (size_t)(l * 3) * D * 512 * 2; g.ldb = 512; g.zB_lo = (long)D * 512; g.N = D; g.K = 512; g.nz = 3; g.zinner = 1;
          g.oC = WS_MRG; g.ldc = D; g.epi = E_BRZ; g.oE0 = WS_PROJ + (size_t)C_GATE * 2; g.bE1 = I_B_GATE; g.oE1 = (long)(l * 3 * D) * 4; g.oE2 = WS_MF32; }
        { GemmDesc& g = P.d[base + 7]; g.kind = K_GEMM; g.oA = WS_MRG; g.lda = D; g.oB = WS_WOUT_T + (size_t)l * D * D * 2; g.ldb = D; g.N = D; g.K = D; g.bC = B_OUT; g.ldc = D; g.epi = E_ADDX; g.bE0 = (l == 0 ? (int)I_X : (int)B_OUT); g.oE0 = 0;   }
        { GemmDesc& g = P.d[base + 8]; g.kind = K_RMS; g.bA = B_OUT; g.bB = I_NORM_CROSS; g.oB = (long)l * D * 4; g.oC = WS_HN; g.epi = E_BF16; g.nz = 2;   }
        { GemmDesc& g = P.d[base + 9];
          g.kind = K_GEMM; g.oA = WS_HN; g.lda = D; g.zA_lo = (long)SEQ * D; g.oB = WS_WQK_T + (size_t)l * 2 * D * D * 2; g.ldb = D; g.zB_lo = (long)D * D; g.M = SEQ; g.N = D; g.K = D; g.nz = NB;
          g.oC = WS_P; g.ldc = D; g.zC_lo = (long)SEQ * D; g.epi = E_SOFTMAX; }
        { GemmDesc& g = P.d[base + 10];
          g.kind = K_GEMM; g.oA = WS_P; g.lda = D; g.zA_lo = (long)SEQ * D; g.oB = WS_VWO_T + (size_t)l * 2 * D * D * 2; g.ldb = D; g.zB_lo = (long)D * D; g.M = SEQ; g.N = D; g.K = D; g.nz = NB;
          g.bC = B_OUT; g.ldc = D; g.zC_lo = (long)SEQ * D; g.epi = E_ADDX; g.bE0 = B_OUT; g.oE0 = 0; }
        { GemmDesc& g = P.d[base + 11]; g.kind = K_RMS; g.bA = B_OUT; g.bB = I_NORM_FFN; g.oB = (long)l * D * 4; g.oC = WS_HN; g.epi = E_BF16; g.nz = 3;   }
        { GemmDesc& g = P.d[base + 12]; g.kind = K_GEMM; g.oA = WS_HN; g.lda = D; g.oB = WS_WPK_T + (size_t)l * 2048 * D * 2; g.ldb = D; g.N = 2048; g.K = D; g.oC = WS_SC; g.ldc = 2048; g.epi = E_F16; }
        P.d[base + 13].kind = K_ROUTE;
        P.d[base + 14].kind = K_EXPERTS;
        P.d[base + 15].kind = K_EXPERTS_V;
        n = base + 16;
    }
    { GemmDesc& g = P.d[n]; g.kind = K_RMS; g.bA = B_OUT; g.bB = I_NORM_FINAL; g.bC = B_OUT; g.epi = E_F32; g.M = T; ++n; }
    P.n = n;
    return P;
}
__constant__ Prog PROG = make_prog();
constexpr int NPH = make_prog().n;

DI void init_phase(const TC tc, PRM p, unsigned char* lds) {
        unsigned char* ws = pws(p); float* X = pout(p);
        prep_weights(tc, p, (LAS unsigned char*)lds);
        {
            const int* pos = (const int*)pin(p, I_POS); float* rt = (float*)(ws + WS_ROPE);
            for (int i = tc.bid * 512 + tc.tid; i < T * 64; i += tc.nb * 512) { const int tok = i >> 6, d = i & 63;
                const float ang = (float)pos[tok] * powf(10000.0f, -(float)d * (1.0f / 64.0f)); float sn, cs; sincosf(ang, &sn, &cs); rt[(size_t)tok * 128 + d] = cs; rt[(size_t)tok * 128 + 64 + d] = sn; }
        }
        {
            float* tb = (float*)(ws + WS_TAB);
            for (int i = tc.bid * 512 + tc.tid; i < DEPTH * 32 * 64; i += tc.nb * 512) s5_disc_init(p, i, tb + (size_t)i * 4);
            {
                bf16_t* bbf = (bf16_t*)(ws + WS_TAB + 256 * 1024); bf16_t* cmf = (bf16_t*)(ws + WS_TAB + 512 * 1024);
                const float* Bre = (const float*)pin(p, I_S5_BRE); const float* Bim = (const float*)pin(p, I_S5_BIM); const float* Cre = (const float*)pin(p, I_S5_CRE); const float* Cim = (const float*)pin(p, I_S5_CIM);
                for (int i = tc.bid * 512 + tc.tid; i < DEPTH * 32 * 128 * 16; i += tc.nb * 512) {
                    const int c = i & 15, n = (i >> 4) & 127, lg = i >> 11, ri = n >> 6, pp = n & 63;
                    float d4[4]; s5_disc_init(p, lg * 64 + pp, d4);
                    const float br = Bre[((size_t)lg * 64 + pp) * 16 + c], bi = Bim[((size_t)lg * 64 + pp) * 16 + c];
                    bbf[i] = (bf16_t)f2bf(ri == 0 ? d4[2] * br - d4[3] * bi : d4[2] * bi + d4[3] * br);
                    const int c2 = i >> 7 & 15, k2 = i & 127, lg2 = i >> 11, ri2 = k2 >> 6, p2 = k2 & 63;
                    cmf[i] = (bf16_t)f2bf(ri2 == 0 ? Cre[((size_t)lg2 * 16 + c2) * 64 + p2] : -Cim[((size_t)lg2 * 16 + c2) * 64 + p2]);
                }
            }
            const float* hl = (const float*)pin(p, I_HG_LB);
            for (int i = tc.bid * 512 + tc.tid; i < 512; i += tc.nb * 512) { const float a0 = hl[i], a1 = hl[512 + i], mx = fmaxf(a0, a1), e0 = expf(a0 - mx), e1 = expf(a1 - mx);
                tb[16384 + i] = 0.f; tb[16384 + 512 + i] = e1 / (e0 + e1); }
            if (tc.bid == 0 && tc.tid < 4) tb[16384 + 1024 + tc.tid] = log1pf(-exp2f(-5.0f - (float)tc.tid));
        }
        rms_rows(tc, (const float*)pin(p, I_MEM), (const float*)pin(p, I_NORM_MEM), (bf16_t*)(ws + WS_MEMN), nullptr, NB * MEM);
        rms_rows(tc, (const float*)pin(p, I_MEM), (const float*)pin(p, I_NORM_MEM) + D, (bf16_t*)(ws + WS_MEMN) + (size_t)NB * MEM * D, nullptr, NB * MEM);
    }

DI void run_phase(const TC tc, PRM p, int ph, unsigned char* lds, LAS unsigned char* lds_raw) {
    const GemmDesc& g = PROG.d[ph];
    const int kind = g.kind, l = g.layer;
    if (kind == K_GEMM) {
        const int alt = g.alt, split = g.split < tc.nb ? g.split : tc.nb / 2; const bool second = alt != 0 && tc.bid >= split;
        const GemmDesc& gg = PROG.d[rfl(second ? alt : ph)];
        TC t2 = tc; t2.bid = second ? tc.bid - split : tc.bid; t2.nb = alt != 0 ? (second ? tc.nb - split : split) : tc.nb;
        mgemm(t2, p, gg, (LAS unsigned char*)lds, lds_raw);
    }
    else if (kind == K_RMS) { rms_rows(tc, GPTR(const float*, bA, oA), GPTR(const float*, bB, oB), g.epi == E_BF16 ? GPTR(bf16_t*, bC, oC) : nullptr, g.epi == E_F32 ? GPTR(float*, bC, oC) : nullptr, g.M, g.nz == 3 ? pws(p) + WS_HQ : nullptr);
        if (g.nz == 2) peer_convert(tc, p, l); }
    else if (kind == K_MIX1) {
        constexpr int N_S5 = NB * 32 * S5_NCH / 8;
        for (int it = tc.bid; it < N_S5; it += tc.nb) s5_chunk_mfma<1>(tc, p, l, it * 8 + (tc.tid >> 6), (LAS unsigned char*)lds);
        __syncthreads();
        LaPreA pre; int it = tc.bid;
        if (it < LA_ITEMS) laA_issue(tc, p, it, pre);
        for (; it < LA_ITEMS; it += tc.nb) { const int nx = it + tc.nb; la_phaseA(tc, p, l, it, pre, nx < LA_ITEMS ? nx : -1, (LAS unsigned char*)lds); }
    }
    else if (kind == K_MIX2) { s5_scan(tc, p, l); la_scan(tc, p); }
    else if (kind == K_MIX3) {
        constexpr int N_S5 = NB * 32 * S5_NCH / 8;
        if (!(tc.nostore && PROBE_SEL == 1)) for (int it = tc.bid; it < N_S5; it += tc.nb) s5_chunk_mfma<3>(tc, p, l, it * 8 + (tc.tid >> 6), (LAS unsigned char*)lds);
        __syncthreads();
        if (!(tc.nostore && PROBE_SEL == 2)) {
            LaPreC pre; int it = tc.bid;
            if (it < LA_ITEMS) laC_issue(tc, p, it, pre);
            for (; it < LA_ITEMS; it += tc.nb) { const int nx = it + tc.nb; la_phaseC(tc, p, l, it, pre, nx < LA_ITEMS ? nx : -1, (LAS unsigned char*)lds); }
        }
    }
    else if (kind == K_ROUTE) peer_route(tc, p, (LAS unsigned char*)lds);
    else if (kind == K_EXPERTS) peer_experts_u(tc, p, l, (LAS unsigned char*)lds);
    else if (kind == K_EXPERTS_V) peer_experts_v(tc, p, (LAS unsigned char*)lds);

}

__global__ void __launch_bounds__(512, 2) mega(Params p) {
    extern __shared__ __attribute__((aligned(16))) unsigned char lds[];
    {
        volatile LAS unsigned* MISC = (volatile LAS unsigned*)((LAS unsigned char*)lds + LDS_BYTES - 64);
        if (threadIdx.x < 16) MISC[threadIdx.x] = 0u;
        LAS Params* lp = (LAS Params*)((LAS unsigned char*)lds + LDS_BYTES - 1024);
        if (threadIdx.x == 0) {
#pragma unroll
            for (int i = 0; i < 31; ++i) lp->in[i] = p.in[i];
            lp->out = p.out; lp->ws = p.ws; lp->lo = p.lo; lp->hi = p.hi;
        }
        __syncthreads();
        if (p.hi - p.lo > 1 && threadIdx.x == 0) (void)xb_add((unsigned*)(p.ws + WS_CTL) + 4096 + XB_XCNT(xb_xcc_id()), 1u);
    }
    int hi = rfl(p.hi), ph = rfl(p.lo);
    if (ph == 0) {
        TC tc; tc.tid = threadIdx.x; tc.bid = blockIdx.x; tc.nb = gridDim.x; tc.nostore = 0;
        PRM lp0 = *(LAS Params*)((LAS unsigned char*)lds + LDS_BYTES - 1024);
        init_phase(tc, lp0, lds);
        if (hi > 1) { XcdBarrier b0; b0.bar = (unsigned*)(pws(lp0) + WS_CTL) + 4096; b0.x = xb_xcc_id(); b0.st = (volatile LAS unsigned*)((LAS unsigned char*)lds + LDS_BYTES - 64); xcd_barrier(b0); }
        ph = 1;
    }
    int wave_s = __builtin_amdgcn_readfirstlane(threadIdx.x >> 6);
    int dup = 0;
    for (; ph < hi; ph = rfl(ph + ((PROBE_MASK != 0ull && ((PROBE_MASK >> ph) & 1ull) && dup < PROBE_REP) ? (++dup, 0) : (dup = 0, 1)))) {
        unsigned ones = ~0u; asm volatile("" : "+s"(ones), "+s"(hi), "+s"(ph), "+s"(wave_s));
        TC tc; tc.tid = wave_s * 64 + (int)__builtin_amdgcn_mbcnt_hi(ones, __builtin_amdgcn_mbcnt_lo(ones, 0u)); tc.bid = blockIdx.x; tc.nb = gridDim.x;
        tc.nostore = (PROBE_MASK != 0ull && ((PROBE_MASK >> ph) & 1ull) && dup < PROBE_REP) ? 1 : 0;
        asm volatile("" : "+v"(tc.tid), "+s"(tc.bid), "+s"(tc.nb));
        int lz = 0; asm volatile("" : "+v"(lz));
        LAS unsigned char* L = (LAS unsigned char*)lds + lz;
        PRM lp = *(LAS Params*)(L + LDS_BYTES - 1024);
        run_phase(tc, lp, rfl(ph), (unsigned char*)L, (LAS unsigned char*)lds);
        if (ph + 1 < hi) {
            XcdBarrier b2; b2.bar = (unsigned*)(pws(lp) + WS_CTL) + 4096; b2.x = xb_xcc_id(); b2.st = (volatile LAS unsigned*)(L + LDS_BYTES - 64);
            xcd_barrier(b2);
#if PROBE_BAR
            if (ph == PROBE_BAR) for (int k = 0; k < 10; ++k) xcd_barrier(b2);
#endif
        }
    }
}

extern "C" void kernel_launch(void* const* d_in, const int* in_sizes, int n_in, void* d_out, int out_size, void* d_ws, size_t ws_size, hipStream_t stream) {
    static int grid = 0;
    if (grid == 0) {
        if (n_in != 31 || out_size != T * D || ws_size < WS_END) { fprintf(stderr, "kernel_launch: unexpected shapes n_in %d out %d ws %zu (need %zu)\n", n_in, out_size, ws_size, (size_t)WS_END); grid = -1; return; }
        int dev = 0, cus = 0;
        if (hipGetDevice(&dev) != hipSuccess || hipDeviceGetAttribute(&cus, hipDeviceAttributeMultiprocessorCount, dev) != hipSuccess) { grid = -1; return; }
        if (hipFuncSetAttribute((const void*)mega, hipFuncAttributeMaxDynamicSharedMemorySize, LDS_BYTES) != hipSuccess) { fprintf(stderr, "kernel_launch: hipFuncSetAttribute failed\n"); grid = -1; return; }
        int per_cu = 0;
        if (hipOccupancyMaxActiveBlocksPerMultiprocessor(&per_cu, (const void*)mega, 512, LDS_BYTES) != hipSuccess || per_cu < 1) fprintf(stderr, "kernel_launch: occupancy query says %d\n", per_cu);
        (void)hipGetLastError();
        grid = cus;
    }
    if (grid < 0) return;
    (void)hipMemsetAsync((char*)d_ws + WS_CTL, 0, 32768, stream);
    Params p{};
    for (int i = 0; i < 31; ++i) p.in[i] = d_in[i];
    p.out = (float*)d_out; p.ws = (unsigned char*)d_ws;
#if ONE_LAUNCH
    p.lo = 0; p.hi = NPH;
    hipLaunchKernelGGL(mega, dim3(grid), dim3(512), LDS_BYTES, stream, p);
#else
    for (int ph = 0; ph < NPH; ++ph) { p.lo = ph; p.hi = ph + 1; hipLaunchKernelGGL(mega, dim3(grid), dim3(512), LDS_BYTES, stream, p); }
#endif
}
```

```cpp
#include <hip/hip_runtime.h>
#include <stdint.h>
#include <stdio.h>

#ifndef LA_HG
#define LA_HG 1
#endif
#ifndef LA_RT
#define LA_RT 1
#endif
#ifndef PEER_LO
#define PEER_LO 0
#endif
#ifndef PROBE_MASK
#define PROBE_MASK 0ull
#endif
#ifndef PROBE_REP
#define PROBE_REP 1
#endif
#ifndef PROBE_BAR
#define PROBE_BAR 0
#endif
#ifndef PROBE_SEL
#define PROBE_SEL 0
#endif
#ifndef ONE_LAUNCH
#define ONE_LAUNCH 1
#endif

typedef unsigned short bf16_t;
typedef float f32x4 __attribute__((ext_vector_type(4)));
typedef unsigned u32x4 __attribute__((ext_vector_type(4)));
typedef unsigned u32x2 __attribute__((ext_vector_type(2)));
#define DI __device__ __forceinline__
#define LAS __attribute__((address_space(3)))

constexpr int NB = 2, SEQ = 8192, T = NB * SEQ, D = 1024, DEPTH = 2;
constexpr int INC = 7680;
constexpr int C_HGQ = 0, C_HGF = 512, C_HGI = 1024, C_HGG = 1536, C_S5U = 2048, C_RTQ = 2560, C_RTK = 3072, C_RTV = 3584, C_RTG = 4096, C_GATE = 4608;
constexpr int MEM = 256, NEXP = 16384;
constexpr float EPS = 1e-6f;

constexpr size_t MiB = 1u << 20;
constexpr size_t WS_CTL = 0, CTL_BYTES = 1 * MiB;
constexpr size_t WS_HN = 1 * MiB;
constexpr size_t WS_OB = 33 * MiB;
constexpr size_t WS_YS5 = 81 * MiB;
constexpr size_t WS_WIN_T = 97 * MiB;
constexpr size_t WS_WBR_T = 127 * MiB;
constexpr size_t WS_WOUT_T = 133 * MiB;
constexpr size_t WS_WGLU_T = 137 * MiB;
constexpr size_t WS_WPK_T = 138 * MiB;
constexpr size_t WS_WQK_T = 146 * MiB;
constexpr size_t WS_VWO_T = 154 * MiB;
constexpr size_t WS_R = 162 * MiB;
constexpr size_t WS_PROJ = WS_R;
constexpr size_t WS_OTMP = WS_R + 240 * MiB;
constexpr size_t WS_LAST = WS_OTMP;
constexpr size_t WS_LADEC = WS_R + 344 * MiB;
constexpr size_t WS_S5X = WS_R + 345 * MiB;
constexpr size_t WS_MF32 = WS_OTMP;
constexpr size_t WS_MRG = WS_OTMP + 64 * MiB;
constexpr size_t WS_RQ = WS_OTMP + 64 * MiB;
constexpr size_t WS_RK = WS_OTMP + 80 * MiB;
constexpr size_t WS_MEMN = WS_R;
constexpr size_t WS_WKV_T = WS_R + 2 * MiB;
constexpr size_t WS_WOT = WS_R + 10 * MiB;
constexpr size_t WS_WQB = WS_R + 14 * MiB;
constexpr size_t WS_PWQB = WS_R + 18 * MiB;
constexpr size_t WS_KBD = WS_R + 26 * MiB;
constexpr size_t WS_KVB = WS_R + 28 * MiB;
constexpr size_t WS_P = WS_R;
constexpr size_t WS_SC = WS_R;
constexpr size_t WS_PEERU = WS_R + 176 * MiB;
constexpr size_t WS_PEERV = WS_R + 192 * MiB;
constexpr size_t WS_PEERS = WS_R + 208 * MiB;
constexpr size_t WS_HQ = WS_R + 128 * MiB;
constexpr size_t WS_AQ = WS_R + 210 * MiB;
constexpr size_t WS_ASC = WS_R + 216 * MiB;
constexpr size_t WS_IDX16 = WS_R + 218 * MiB;
constexpr size_t WS_IDX = WS_R + 160 * MiB;
constexpr size_t WS_GATE = WS_R + 168 * MiB;
constexpr size_t WS_ROPE = WS_R + 336 * MiB;
constexpr size_t WS_TAB = WS_R + 347 * MiB;
constexpr size_t WS_END = WS_ROPE + 12 * MiB;

constexpr int LDS_BYTES = 147456;
constexpr int LDS_GD = 131072 + 8192;

DI float bf2f(bf16_t v) { return __uint_as_float((unsigned)v << 16); }
DI float bflo(unsigned w) { return __uint_as_float(w << 16); }
DI float bfhi(unsigned w) { return __uint_as_float(w & 0xffff0000u); }
DI unsigned f2bf(float f) { unsigned u = __float_as_uint(f); return (u + 0x7fffu + ((u >> 16) & 1u)) >> 16; }
typedef float f32x2_ __attribute__((ext_vector_type(2)));
typedef __bf16 bf16x2_ __attribute__((ext_vector_type(2)));
DI unsigned pk2(float lo, float hi) { const f32x2_ v = {lo, hi}; return __builtin_bit_cast(unsigned, __builtin_convertvector(v, bf16x2_)); }
template <int M> DI float sx(float v) { return __int_as_float(__builtin_amdgcn_ds_swizzle(__float_as_int(v), (M << 10) | 0x1f)); }
DI void halves(float v, float& lo, float& hi) { const auto r = __builtin_amdgcn_permlane32_swap(__float_as_uint(v), __float_as_uint(v), false, false); lo = __uint_as_float(r[0]); hi = __uint_as_float(r[1]); }
DI float wave_sum(float v) { v += sx<1>(v); v += sx<2>(v); v += sx<4>(v); v += sx<8>(v); v += sx<16>(v); float lo, hi; halves(v, lo, hi); return lo + hi; }
DI float wave_max(float v) { v = fmaxf(v, sx<1>(v)); v = fmaxf(v, sx<2>(v)); v = fmaxf(v, sx<4>(v)); v = fmaxf(v, sx<8>(v)); v = fmaxf(v, sx<16>(v)); float lo, hi; halves(v, lo, hi); return fmaxf(lo, hi); }
DI float fexp(float x) { return __builtin_amdgcn_exp2f(x * 1.4426950408889634f); }
DI float flog(float x) { return __builtin_amdgcn_logf(x) * 0.6931471805599453f; }
DI float frcp(float x) { return __builtin_amdgcn_rcpf(x); }
DI float frsq(float x) { return __builtin_amdgcn_rsqf(x); }
DI float sigmoidf_(float x) { return frcp(1.0f + fexp(-x)); }
DI float siluf_(float x) { return x * frcp(1.0f + fexp(-x)); }
DI float gelu_tanh(float x) { const float u = 0.7978845608028654f * (x + 0.044715f * x * x * x); return x - x * frcp(1.0f + fexp(2.0f * u)); }

#define XB_TMO      128
#define XB_XCNT(j)  (256  + 64 * (j))
#define XB_XSUB(j)  (1280 + 64 * (j))
#define XB_XGEN(j)  (2304 + 64 * (j))
#define XB_TOP      3328
#define XB_TOPGEN   3392
#define XCD_BAR_WORDS 3456
#define XB_SPIN_CAP (1u << 22)
DI unsigned xb_ld(unsigned* p) { return __hip_atomic_load(p, __ATOMIC_RELAXED, __HIP_MEMORY_SCOPE_AGENT); }
DI unsigned xb_add(unsigned* p, unsigned v) { return __hip_atomic_fetch_add(p, v, __ATOMIC_RELAXED, __HIP_MEMORY_SCOPE_AGENT); }
DI unsigned xb_xcc_id() { return (unsigned)__builtin_amdgcn_s_getreg((3 << 11) | 20) & 0xFu; }
#define XB_SPIN(cond, bar) do { unsigned _sp = 0; while (cond) { __builtin_amdgcn_s_sleep(1); \
    if ((++_sp & 255u) == 0u) { if (xb_ld(&(bar)[XB_TMO])) break; if (_sp > XB_SPIN_CAP) { atomicAdd(&(bar)[XB_TMO], 1u); break; } } } } while (0)
struct XcdBarrier { unsigned* bar; unsigned x; volatile LAS unsigned* st; };
DI XcdBarrier xcd_barrier_post(unsigned* bar, volatile LAS unsigned* st) {
    XcdBarrier b; b.bar = bar; b.x = xb_xcc_id(); b.st = st;
    if (threadIdx.x == 0) (void)xb_add(&bar[XB_XCNT(b.x)], 1u);
    return b;
}
DI void xcd_barrier_complete(unsigned* bar, unsigned x, unsigned& nloc, unsigned& nx) {
    const unsigned G = gridDim.x * gridDim.y * gridDim.z;
    unsigned sum, cnt, mine, sp = 0u;
    for (;;) {
        sum = 0u; cnt = 0u; mine = 0u;
#pragma unroll
        for (unsigned j = 0; j < 16; ++j) { const unsigned c = xb_ld(&bar[XB_XCNT(j)]); sum += c; cnt += (c > 0u) ? 1u : 0u; mine = (j == x) ? c : mine; }
        if (sum == G) break;
        __builtin_amdgcn_s_sleep(1);
        if ((++sp & 255u) == 0u) { if (xb_ld(&bar[XB_TMO])) break; if (sp > XB_SPIN_CAP) { atomicAdd(&bar[XB_TMO], 1u); break; } }
    }
    nloc = mine > 0u ? mine : 1u; nx = cnt > 0u ? cnt : 1u;
}
DI void xcd_barrier(const XcdBarrier& b) {
    asm volatile("s_waitcnt vmcnt(0)" ::: "memory");
    __syncthreads();
    if (threadIdx.x == 0) {
        unsigned* bar = b.bar;
        __builtin_amdgcn_s_waitcnt(0);
        unsigned nloc = b.st[0], nx = b.st[1];
        if (nloc == 0u) { xcd_barrier_complete(bar, b.x, nloc, nx); b.st[0] = nloc; b.st[1] = nx; }
        const unsigned old = xb_add(&bar[XB_XSUB(b.x)], 1u);
        const unsigned gen = old / nloc;
        if (old + 1u == (gen + 1u) * nloc) {
            __builtin_amdgcn_fence(__ATOMIC_RELEASE, "agent");
            asm volatile("s_waitcnt vmcnt(0)" ::: "memory");
            __builtin_amdgcn_fence(__ATOMIC_ACQUIRE, "agent");
            const unsigned og = xb_add(&bar[XB_TOP], 1u);
            const unsigned tg = og / nx;
            if (og + 1u == (tg + 1u) * nx) xb_add(&bar[XB_TOPGEN], 1u);
            else XB_SPIN(xb_ld(&bar[XB_TOPGEN]) == tg, bar);
            asm volatile("s_waitcnt vmcnt(0)" ::: "memory");
            xb_add(&bar[XB_XGEN(b.x)], 1u);
            asm volatile("s_waitcnt vmcnt(0)" ::: "memory");
        } else {
            __builtin_amdgcn_fence(__ATOMIC_ACQUIRE, "agent");
            XB_SPIN(xb_ld(&bar[XB_XGEN(b.x)]) == gen, bar);
            asm volatile("s_waitcnt vmcnt(0)" ::: "memory");
        }
    }
    __syncthreads();
}

struct Params { const void* in[31]; float* out; unsigned char* ws; int lo, hi; };
typedef const LAS Params& PRM;
DI unsigned long long rfl64(unsigned long long v) { const unsigned lo = __builtin_amdgcn_readfirstlane((unsigned)v), hi = __builtin_amdgcn_readfirstlane((unsigned)(v >> 32)); return ((unsigned long long)hi << 32) | lo; }
DI int rfl(int v) { return __builtin_amdgcn_readfirstlane(v); }
#define GLOBAL_AS __attribute__((address_space(1)))
DI const void* pin(PRM p, int i) { return (const void*)(const GLOBAL_AS char*)rfl64((unsigned long long)p.in[i]); }
DI unsigned char* pws(PRM p) { return (unsigned char*)(GLOBAL_AS unsigned char*)rfl64((unsigned long long)p.ws); }
DI float* pout(PRM p) { return (float*)(GLOBAL_AS float*)rfl64((unsigned long long)p.out); }

enum { I_X = 0, I_MEM, I_POS, I_NORM_MIX, I_W_IN, I_B_GATE, I_HG_LB, I_HG_NORM, I_S5_LRE, I_S5_LIM, I_S5_LOGSTEP, I_S5_BRE, I_S5_BIM, I_S5_CRE, I_S5_CIM,
       I_S5_D, I_S5_WGLU, I_S5_BGLU, I_W_BRANCH, I_W_OUT, I_NORM_CROSS, I_NORM_MEM, I_XA_WQ, I_XA_WKV, I_XA_WO, I_NORM_FFN, I_PEER_WQ, I_PEER_KEYS,
       I_PEER_U, I_PEER_V, I_NORM_FINAL };

struct TC { int tid, bid, nb, nostore; };
enum { E_BF16 = 0, E_F32, E_GLU, E_BR0, E_BR1, E_BR2, E_ADDX, E_SOFTMAX, E_BRZ, E_F16 };
enum { K_NONE = 0, K_GEMM, K_RMS, K_MIX1, K_MIX2, K_MIX3, K_ROUTE, K_EXPERTS, K_EXPERTS_V, K_INIT };
enum { B_OUT = 31, B_WS = 32 };
struct GemmDesc {
    int kind, epi, layer, alt;
    int bA, bB, bC, bE0, bE1, bE2, zinner, split;
    long oA, oB, oC, oE0, oE1, oE2;
    long zA_l, zA_hi, zA_lo, zB_l, zB_hi, zB_lo, zC_l, zC_hi, zC_lo;
    int lda, ldb, ldc, M, N, K, nz; float scale;
};
DI const void* base_ptr(PRM p, int id) { const unsigned long long v = rfl64(id < 31 ? (unsigned long long)p.in[id] : (id == 31 ? (unsigned long long)p.out : (unsigned long long)p.ws)); return (const void*)(const GLOBAL_AS char*)v; }
typedef const GemmDesc& GD;
#define GI(f) (g.f)
#define GL(f) (g.f)
#define GPTR(ty, bf, of) ((ty)((const char*)base_ptr(p, g.bf) + g.of))
#define ZOFF(g, X, zi) ((size_t)(((zi) >> 3) * GL(z##X##_l) + (((zi) >> 2) & 1) * GL(z##X##_hi) + ((zi) & 3) * GL(z##X##_lo)))
DI unsigned pkh2(float lo, float hi) { typedef float f32x2h __attribute__((ext_vector_type(2))); typedef _Float16 f16x2h __attribute__((ext_vector_type(2)));
    return __builtin_bit_cast(unsigned, __builtin_convertvector((f32x2h){lo, hi}, f16x2h)); }
DI float h2f(unsigned short h) { return (float)__builtin_bit_cast(_Float16, h); }
DI void store8_bf16(bf16_t* p, const float (&v)[8]) {
    u32x4 w; w.x = pk2(v[0], v[1]); w.y = pk2(v[2], v[3]); w.z = pk2(v[4], v[5]); w.w = pk2(v[6], v[7]);
    *(u32x4*)p = w;
}
DI void unpack8(const u32x4 w, float (&v)[8]) { v[0] = bflo(w.x); v[1] = bfhi(w.x); v[2] = bflo(w.y); v[3] = bfhi(w.y); v[4] = bflo(w.z); v[5] = bfhi(w.z); v[6] = bflo(w.w); v[7] = bfhi(w.w); }
DI void load8_bf16(const bf16_t* p, float (&v)[8]) {
    const u32x4 w = *(const u32x4*)p;
    v[0] = bflo(w.x); v[1] = bfhi(w.x); v[2] = bflo(w.y); v[3] = bfhi(w.y); v[4] = bflo(w.z); v[5] = bfhi(w.z); v[6] = bflo(w.w); v[7] = bfhi(w.w);
}
struct EpiU { int epi, ldc; size_t zo, zx; unsigned char* C; const unsigned char* A; const unsigned char* e0; const unsigned char* e1; unsigned char* e2; float scale; };
struct EpiL { u32x4 a, b; };
DI EpiU epi_unit(PRM p, GD g, int z) {
    EpiU u; u.ldc = GI(ldc); u.epi = GI(epi); u.zx = 0;
    if (u.epi == E_BRZ) { u.epi = E_BR0 + z; u.zx = (size_t)z * D; }
    u.zo = ZOFF(g, C, z); u.C = GPTR(unsigned char*, bC, oC); u.A = GPTR(const unsigned char*, bA, oA); u.e0 = GPTR(const unsigned char*, bE0, oE0); u.e1 = GPTR(const unsigned char*, bE1, oE1);
    u.e2 = GPTR(unsigned char*, bE2, oE2); u.scale = g.scale; return u;
}
DI void epi_load(const EpiU& u, int row, int col, EpiL& L) {
    const size_t co = u.zo + (size_t)row * u.ldc + col;
    switch (u.epi) {
    case E_GLU: L.a = *(const u32x4*)((const bf16_t*)u.A + (size_t)row * 512 + col); break;
    case E_BR0: L.a = *(const u32x4*)((const bf16_t*)u.e0 + u.zx + (size_t)row * INC + col); break;
    case E_BR1: case E_BR2: { L.a = *(const u32x4*)((const bf16_t*)u.e0 + u.zx + (size_t)row * INC + col); L.b = *(const u32x4*)((const bf16_t*)u.C + co); } break;
    case E_ADDX: { const float* x = (const float*)u.e0 + co; L.a = *(const u32x4*)x; L.b = *(const u32x4*)(x + 4); } break;
    default: break;
    }
}
DI void epi_finish(const int nostore, const EpiU& u, int row, int col, float (&v)[8], const EpiL& L) {
    const size_t co = u.zo + (size_t)row * u.ldc + col;
    switch (u.epi) {
    case E_BF16: {
#pragma unroll
        for (int j = 0; j < 8; ++j) v[j] *= u.scale;
        store8_bf16((bf16_t*)u.C + co, v); } break;
    case E_F32: { float* c = (float*)u.C + co; *(f32x4*)c = (f32x4){v[0], v[1], v[2], v[3]}; *(f32x4*)(c + 4) = (f32x4){v[4], v[5], v[6], v[7]}; } break;
    case E_F16: { u32x4 w; w.x = pkh2(v[0], v[1]); w.y = pkh2(v[2], v[3]); w.z = pkh2(v[4], v[5]); w.w = pkh2(v[6], v[7]); *(u32x4*)((unsigned short*)u.C + co) = w; } break;
    case E_GLU: {
        float y[8], o[8]; unpack8(L.a, y); const float* bias = (const float*)u.e0;
#pragma unroll
        for (int j = 0; j < 8; ++j) o[j] = y[j] * sigmoidf_(v[j] + bias[col + j]);
        store8_bf16((bf16_t*)u.C + co, o); } break;
    case E_BR0: case E_BR1: case E_BR2: {
        float lg[8], o[8]; unpack8(L.a, lg); const float* bg = (const float*)u.e1 + u.zx;
#pragma unroll
        for (int j = 0; j < 8; ++j) { o[j] = sigmoidf_(lg[j] + bg[col + j]) * v[j]; }
        if (u.epi != E_BR0) { float pr[8]; unpack8(L.b, pr);
#pragma unroll
            for (int j = 0; j < 8; ++j) o[j] += pr[j]; }
        if (nostore && o[0] != 12345.678f) break;
        store8_bf16((bf16_t*)u.C + co, o); } break;
    case E_ADDX: { float* x = (float*)u.C + co; f32x4 x0 = __builtin_bit_cast(f32x4, L.a), x1 = __builtin_bit_cast(f32x4, L.b);
        x0 += (f32x4){v[0], v[1], v[2], v[3]}; x1 += (f32x4){v[4], v[5], v[6], v[7]}; if (nostore && x0.x != 12345.678f) break; *(f32x4*)x = x0; *(f32x4*)(x + 4) = x1; } break;
    default: break;
    }
}
typedef short bf16x8 __attribute__((ext_vector_type(8)));
namespace mgk {
constexpr int BM = 256, BK = 64, HALF = 128, HTB = HALF * BK * 2, NXCD = 8, WGM = 8;
DI int lds_byte(int r, int c) { const int st = (r >> 4) * 2 + (c >> 5), rr = r & 15, cc = c & 31, ob = rr * 64 + cc * 2; return st * 1024 + (ob ^ (((ob >> 9) & 1) << 5)); }
DI void stage_rc(int b, int& R, int& C) { const int st = b / 1024, sb = b % 1024, swz = sb ^ (((sb >> 9) & 1) << 5); R = (st >> 1) * 16 + swz / 64; C = (st & 1) * 32 + (swz % 64) / 2; }
DI int perm32(int rho) { const int n = rho >> 4, i = rho & 15; return 8 * (i >> 2) + 4 * n + (i & 3); }
struct Unit { int pm, pn, z; };
DI bool next_unit(GD g, int i, int G, int c, Unit& u) {
    const int nM = GI(M) / BM, nN = GI(N) / BM, nwg = nM * nN;
    long L = (long)i * G + c; int zz;
    if (GI(zinner)) { const int nz = GI(nz); zz = i % nz; L = (long)(i / nz) * G + c; if (L >= nwg) return false; }
    else { if (L >= (long)nwg * GI(nz)) return false; zz = (int)(L / nwg); }
    u.z = zz; int wgid = (int)(L % nwg);
    { const int q = nwg / NXCD, r = nwg % NXCD, xcd = wgid % NXCD, off = wgid / NXCD; wgid = (xcd < r ? xcd * (q + 1) : r * (q + 1) + (xcd - r) * q) + off; }
    const int nig = WGM * nN, gid = wgid / nig, fm = gid * WGM, gsz = (nM - fm) < WGM ? (nM - fm) : WGM;
    u.pm = rfl(fm + ((wgid % nig) % gsz)); u.pn = rfl((wgid % nig) / gsz); u.z = rfl(u.z); return true;
}
}

DI void mgemm(const TC tc, PRM p, GD g, LAS unsigned char* lds, LAS unsigned char* lds_dma) {
    using namespace mgk;
    const int tid = tc.tid, wid = __builtin_amdgcn_readfirstlane(tid >> 6), lane = tid & 63, wr = wid >> 2, wc = wid & 3, fr = lane & 15, fq = lane >> 4;
    const int nt = (tc.nostore && PROBE_SEL == 6) ? 2 : GI(K) / BK, lda = GI(lda), ldb = GI(ldb);
    unsigned voffA[2], voffB[2];
#pragma unroll
    for (int i = 0; i < 2; ++i) { int R, C; stage_rc(tid * 16 + i * 8192, R, C); const int Rb = (R & ~31) + perm32(R & 31);
        voffA[i] = (unsigned)(R * lda + C) * 2u; voffB[i] = (unsigned)(Rb * ldb + C) * 2u; }
    const size_t kstep = (size_t)(BK * 2);
    const size_t hstepA = (size_t)HALF * lda * 2, hstepB = (size_t)HALF * ldb * 2;
    const unsigned ldsw = (unsigned)wid * 1024u;
    const unsigned ldsm0 = (unsigned)__builtin_amdgcn_readfirstlane((int)((unsigned)(size_t)lds_dma + ldsw));
    LAS unsigned char* aB = lds + lds_byte(wr * 64 + fr, fq * 8); LAS unsigned char* bB = lds + 4 * HTB + lds_byte(wc * 32 + fr, fq * 8);
    asm volatile("" : "+v"(aB), "+v"(bB));
#define MG_SA(b, h) (((b) * 2 + (h)) * HTB)
#define MG_SB(b, h) ((4 + (b) * 2 + (h)) * HTB)
#ifndef MG_ASM_DMA
#define MG_ASM_DMA 0
#endif
#if MG_ASM_DMA
#define MG_STAGE(bufoff, gbase, voff) do { _Pragma("unroll") for (int _i = 0; _i < 2; ++_i) \
        asm volatile("s_mov_b32 m0, %0\n\ts_nop 0\n\tglobal_load_lds_dwordx4 %1, %2" :: "s"(ldsm0 + (unsigned)((bufoff) + _i * 8192)), "v"((voff)[_i]), "s"((const char*)(gbase)) : "m0", "memory"); } while (0)
#else
#define MG_STAGE(bufoff, gbase, voff) do { _Pragma("unroll") for (int _i = 0; _i < 2; ++_i) \
        __builtin_amdgcn_global_load_lds((const unsigned*)((const char*)(gbase) + (voff)[_i]), (LAS unsigned*)(lds_dma + (bufoff) + ldsw + _i * 8192), 16, 0, 0); } while (0)
#endif
#define MG_LDA(dst, b, h) do { _Pragma("unroll") for (int m = 0; m < 4; ++m) _Pragma("unroll") for (int k = 0; k < 2; ++k) dst[m][k] = *(const LAS bf16x8*)(aB + MG_SA(b, h) + m * 2048 + k * 1024); } while (0)
#define MG_LDB(dst, b, h) do { _Pragma("unroll") for (int n = 0; n < 2; ++n) _Pragma("unroll") for (int k = 0; k < 2; ++k) dst[n][k] = *(const LAS bf16x8*)(bB + (MG_SB(b, h) - 4 * HTB) + n * 2048 + k * 1024); } while (0)
#define MG_MMA(ai, bj, At, Bt) do { __builtin_amdgcn_s_setprio(1); _Pragma("unroll") for (int m = 0; m < 4; ++m) _Pragma("unroll") for (int n = 0; n < 2; ++n) _Pragma("unroll") for (int k = 0; k < 2; ++k) \
        acc[ai][bj][m][n] = __builtin_amdgcn_mfma_f32_16x16x32_bf16(Bt[n][k], At[m][k], acc[ai][bj][m][n], 0, 0, 0); __builtin_amdgcn_s_setprio(0); } while (0)
#define MG_WAIT_V(n) asm volatile("s_waitcnt vmcnt(" #n ")" ::: "memory")
#define MG_WAIT_L(n) asm volatile("s_waitcnt lgkmcnt(" #n ")" ::: "memory")
#define MG_BAR __builtin_amdgcn_s_barrier()
#define MG_SCHED __builtin_amdgcn_sched_barrier(0)
    const int G = rfl(tc.nb), cidx = rfl(tc.bid);
    Unit cur, nxt; int ui = 0;
    if (!next_unit(g, 0, G, cidx, cur)) return;
    {
        const int nun = (GI(M) / BM) * (GI(N) / BM) * GI(nz), full = nun / G, rem = nun - full * G;
        if (rem != 0 && full >= 4 && cidx >= rem && !GI(zinner)) { const int steps = (cidx - rem) & 15; for (int k = 0; k < steps; ++k) __builtin_amdgcn_s_sleep(64); }
    }
    f32x4 acc[2][2][4][2];
#pragma unroll
    for (int a = 0; a < 2; ++a)
#pragma unroll
        for (int b = 0; b < 2; ++b)
#pragma unroll
            for (int m = 0; m < 4; ++m)
#pragma unroll
                for (int n = 0; n < 2; ++n) acc[a][b][m][n] = (f32x4){0.f, 0.f, 0.f, 0.f};
    bf16x8 At[4][2], B0[2][2], B1[2][2];
    const bf16_t* const Abase = GPTR(const bf16_t*, bA, oA); const bf16_t* const Bbase = GPTR(const bf16_t*, bB, oB);
    const char* cA = (const char*)(Abase + ZOFF(g, A, cur.z) + (size_t)cur.pm * BM * lda);
    const char* cB = (const char*)(Bbase + ZOFF(g, B, cur.z) + (size_t)cur.pn * BM * ldb);
    MG_STAGE(MG_SB(0, 0), cB, voffB); MG_STAGE(MG_SB(0, 1), cB + hstepB, voffB); MG_STAGE(MG_SA(0, 0), cA, voffA); MG_STAGE(MG_SA(0, 1), cA + hstepA, voffA);
    if (wr == 1) MG_BAR;
    MG_WAIT_V(2); MG_BAR;
    MG_STAGE(MG_SB(1, 0), cB + kstep, voffB); MG_STAGE(MG_SA(1, 0), cA + kstep, voffA); MG_STAGE(MG_SB(1, 1), cB + hstepB + kstep, voffB);
    MG_WAIT_V(6); MG_BAR;
    for (;;) {
        const bool has_next = next_unit(g, ui + 1, G, cidx, nxt);
        const char* nA = has_next ? (const char*)(Abase + ZOFF(g, A, nxt.z) + (size_t)nxt.pm * BM * GI(lda)) : cA;
        const char* nB = has_next ? (const char*)(Bbase + ZOFF(g, B, nxt.z) + (size_t)nxt.pn * BM * GI(ldb)) : cB;
        for (int t = 0; t < nt; t += 2) {
            const bool last = (t == nt - 2);
            const char* a1 = cA + (size_t)(t + 1) * kstep;
            const char* a2 = last ? nA : cA + (size_t)(t + 2) * kstep; const char* b2 = last ? nB : cB + (size_t)(t + 2) * kstep;
            const char* a3 = a2 + kstep; const char* b3 = b2 + kstep;
            MG_LDB(B0, 0, 0); MG_LDB(B1, 0, 1); MG_SCHED; MG_LDA(At, 0, 0); MG_STAGE(MG_SA(1, 1), a1 + hstepA, voffA);
            MG_WAIT_V(8); MG_WAIT_L(0); MG_BAR; MG_MMA(0, 0, At, B0); MG_MMA(0, 1, At, B1); MG_BAR; MG_SCHED;
            MG_LDA(At, 0, 1); MG_STAGE(MG_SB(0, 0), b2, voffB); MG_STAGE(MG_SB(0, 1), b2 + hstepB, voffB); MG_STAGE(MG_SA(0, 0), a2, voffA);
            MG_WAIT_V(8); MG_WAIT_L(0); MG_BAR; MG_MMA(1, 0, At, B0); MG_MMA(1, 1, At, B1); MG_BAR; MG_SCHED;
            MG_LDB(B0, 1, 0); MG_LDB(B1, 1, 1); MG_SCHED; MG_LDA(At, 1, 0); MG_STAGE(MG_SA(0, 1), a2 + hstepA, voffA);
            MG_WAIT_V(8); MG_WAIT_L(0); MG_BAR; MG_MMA(0, 0, At, B0); MG_MMA(0, 1, At, B1); MG_BAR; MG_SCHED;
            MG_LDA(At, 1, 1); MG_STAGE(MG_SB(1, 0), b3, voffB); MG_STAGE(MG_SB(1, 1), b3 + hstepB, voffB); MG_STAGE(MG_SA(1, 0), a3, voffA);
            MG_WAIT_V(8); MG_WAIT_L(0); MG_BAR; MG_MMA(1, 0, At, B0); MG_MMA(1, 1, At, B1); MG_BAR; MG_SCHED;
        }
        if (wr == 0) MG_BAR;
        int fr_e = fr, fq_e = fq, ez = 0;
        asm volatile("" : "+v"(fr_e), "+v"(fq_e), "+v"(ez));
        PRM pe = *(const LAS Params*)((const LAS unsigned char*)&p + ez);
#define p pe
#define fr fr_e
#define fq fq_e
        if (tc.nostore && PROBE_SEL == 5) {   }
        else if (GI(epi) == E_SOFTMAX) {
            LAS float* red = (LAS float*)(lds + 131072);
#pragma unroll
            for (int ai = 0; ai < 2; ++ai)
#pragma unroll
                for (int m = 0; m < 4; ++m) {
                    float mx = -INFINITY;
#pragma unroll
                    for (int bj = 0; bj < 2; ++bj)
#pragma unroll
                        for (int n = 0; n < 2; ++n)
#pragma unroll
                            for (int j = 0; j < 4; ++j) mx = fmaxf(mx, acc[ai][bj][m][n][j]);
                    mx = fmaxf(mx, sx<16>(mx)); { float lo_, hi_; halves(mx, lo_, hi_); mx = fmaxf(lo_, hi_); }
                    float s = 0.f;
#pragma unroll
                    for (int bj = 0; bj < 2; ++bj)
#pragma unroll
                        for (int n = 0; n < 2; ++n)
#pragma unroll
                            for (int j = 0; j < 4; ++j) { const float e = fexp(acc[ai][bj][m][n][j] - mx); acc[ai][bj][m][n][j] = e; s += e; }
                    s += sx<16>(s); { float lo_, hi_; halves(s, lo_, hi_); s = lo_ + hi_; }
                    if (fq == 0) { const int rl = ai * HALF + wr * 64 + m * 16 + fr; red[(rl * 4 + wc) * 2] = mx; red[(rl * 4 + wc) * 2 + 1] = s; }
                }
            asm volatile("s_waitcnt lgkmcnt(0)" ::: "memory"); __builtin_amdgcn_s_barrier(); asm volatile("" ::: "memory");
            bf16_t* Cb = GPTR(bf16_t*, bC, oC) + ZOFF(g, C, cur.z); const int ldc = GI(ldc);
#pragma unroll
            for (int ai = 0; ai < 2; ++ai)
#pragma unroll
                for (int m = 0; m < 4; ++m) {
                    const int rl = ai * HALF + wr * 64 + m * 16 + fr;
                    const f32x4 p0 = *(const LAS f32x4*)(red + rl * 8), p1 = *(const LAS f32x4*)(red + rl * 8 + 4);
                    const float M_ = fmaxf(fmaxf(p0.x, p0.z), fmaxf(p1.x, p1.z));
                    const float tot = p0.y * fexp(p0.x - M_) + p0.w * fexp(p0.z - M_) + p1.y * fexp(p1.x - M_) + p1.w * fexp(p1.z - M_);
                    const float sc = fexp(red[(rl * 4 + wc) * 2] - M_) * frcp(tot);
                    bf16_t* rowp = Cb + (size_t)(cur.pm * BM + rl) * ldc + cur.pn * BM + wc * 32 + 8 * fq;
#pragma unroll
                    for (int bj = 0; bj < 2; ++bj) {
                        float v[8];
#pragma unroll
                        for (int j = 0; j < 4; ++j) { v[j] = acc[ai][bj][m][0][j] * sc; v[4 + j] = acc[ai][bj][m][1][j] * sc; }
                        store8_bf16(rowp + bj * HALF, v);
                    }
                }
        } else {
            const int row0 = cur.pm * BM + wr * 64 + fr, col0 = cur.pn * BM + wc * 32 + 8 * fq;
            const EpiU eu = epi_unit(p, g, cur.z);
#pragma unroll
            for (int ai = 0; ai < 2; ++ai)
#pragma unroll
                for (int m = 0; m < 4; ++m) {
                    EpiL L[2];
#pragma unroll
                    for (int bj = 0; bj < 2; ++bj) epi_load(eu, row0 + ai * HALF + m * 16, col0 + bj * HALF, L[bj]);
#pragma unroll
                    for (int bj = 0; bj < 2; ++bj) {
                        float v[8];
#pragma unroll
                        for (int j = 0; j < 4; ++j) { v[j] = acc[ai][bj][m][0][j]; v[4 + j] = acc[ai][bj][m][1][j]; }
                        epi_finish(tc.nostore, eu, row0 + ai * HALF + m * 16, col0 + bj * HALF, v, L[bj]);
                    }
                }
        }
#undef fr
#undef fq
#undef p
        if (!has_next) break;
#pragma unroll
        for (int a = 0; a < 2; ++a)
#pragma unroll
            for (int b = 0; b < 2; ++b)
#pragma unroll
                for (int m = 0; m < 4; ++m)
#pragma unroll
                    for (int n = 0; n < 2; ++n) acc[a][b][m][n] = (f32x4){0.f, 0.f, 0.f, 0.f};
        cur = nxt; cA = nA; cB = nB; ++ui;
        if (wr == 1) MG_BAR;
    }
    MG_WAIT_V(0);
    MG_BAR;
#undef MG_SA
#undef MG_SB
#undef MG_STAGE
#undef MG_LDA
#undef MG_LDB
#undef MG_MMA
#undef MG_WAIT_V
#undef MG_WAIT_L
#undef MG_BAR
#undef MG_SCHED
}

DI void transpose_item(const float* W, int K, int N, bf16_t* WT, LAS float* scr, int item, int lane) {
    const int nblk = N / 32, kb = item / nblk, nb = item % nblk, k0 = 64 * kb, n0 = 32 * nb;
#pragma unroll 8
    for (int i = 0; i < 32; ++i) { const int kk = 2 * i + (lane >> 5); scr[kk * 33 + (lane & 31)] = W[(size_t)(k0 + kk) * N + n0 + (lane & 31)]; }
    asm volatile("s_waitcnt lgkmcnt(0)" ::: "memory");
    const int c = lane & 7;
#pragma unroll
    for (int j = 0; j < 4; ++j) { const int n = (lane >> 3) + 8 * j; const LAS float* s = scr + (8 * c) * 33 + n;
        u32x4 o; o.x = pk2(s[0 * 33], s[1 * 33]); o.y = pk2(s[2 * 33], s[3 * 33]); o.z = pk2(s[4 * 33], s[5 * 33]); o.w = pk2(s[6 * 33], s[7 * 33]);
        *(u32x4*)(WT + (size_t)(n0 + n) * K + k0 + 8 * c) = o; }
    asm volatile("s_waitcnt lgkmcnt(0)" ::: "memory");
}
DI void prep_weights(const TC tc, PRM p, LAS unsigned char* lds) {
    const int lane = tc.tid & 63, wave = tc.tid >> 6, gw = tc.bid * 8 + wave, NGW = tc.nb * 8;
    LAS float* scr = (LAS float*)(lds + wave * 16384);
    unsigned char* ws = pws(p);
    constexpr int I_IN = (D / 64) * (INC / 32), I_BR = (512 / 64) * (D / 32), I_OUT = (D / 64) * (D / 32), I_GLU = (512 / 64) * (512 / 32), I_KV = (D / 64) * (2 * D / 32), I_WO = (D / 64) * (D / 32);
    constexpr int PER_L = I_IN + 3 * I_BR + I_OUT + I_GLU + I_KV + I_WO;
    for (int it = gw; it < DEPTH * PER_L; it += NGW) {
        const int l = it / PER_L; int r = it % PER_L;
        if (r < I_IN) { transpose_item((const float*)pin(p, I_W_IN) + (size_t)l * D * INC, D, INC, (bf16_t*)(ws + WS_WIN_T) + (size_t)l * INC * D, scr, r, lane); continue; } r -= I_IN;
        if (r < 3 * I_BR) { const int br = r / I_BR; transpose_item((const float*)pin(p, I_W_BRANCH) + (size_t)l * 1536 * D + (size_t)br * 512 * D, 512, D, (bf16_t*)(ws + WS_WBR_T) + (size_t)(l * 3 + br) * D * 512, scr, r % I_BR, lane); continue; } r -= 3 * I_BR;
        if (r < I_OUT) { transpose_item((const float*)pin(p, I_W_OUT) + (size_t)l * D * D, D, D, (bf16_t*)(ws + WS_WOUT_T) + (size_t)l * D * D, scr, r, lane); continue; } r -= I_OUT;
        if (r < I_GLU) { transpose_item((const float*)pin(p, I_S5_WGLU) + (size_t)l * 512 * 512, 512, 512, (bf16_t*)(ws + WS_WGLU_T) + (size_t)l * 512 * 512, scr, r, lane); continue; } r -= I_GLU;
        if (r < I_KV) { transpose_item((const float*)pin(p, I_XA_WKV) + (size_t)l * D * 2 * D, D, 2 * D, (bf16_t*)(ws + WS_WKV_T) + (size_t)l * 2 * D * D, scr, r, lane); continue; } r -= I_KV;
        transpose_item((const float*)pin(p, I_XA_WO) + (size_t)l * D * D, D, D, (bf16_t*)(ws + WS_WOT) + (size_t)l * D * D, scr, r, lane);
    }
    {
        const size_t n_wq = (size_t)DEPTH * D * D / 8, n_pq = (size_t)DEPTH * D * 2048 / 8;
        const float* wq = (const float*)pin(p, I_XA_WQ); const float* pq = (const float*)pin(p, I_PEER_WQ);
        bf16_t* wqb = (bf16_t*)(ws + WS_WQB); bf16_t* pqb = (bf16_t*)(ws + WS_PWQB);
        for (size_t i = (size_t)tc.bid * 512 + tc.tid; i < n_wq + n_pq; i += (size_t)tc.nb * 512) {
            const float* s = i < n_wq ? wq + i * 8 : pq + (i - n_wq) * 8; bf16_t* d = i < n_wq ? wqb + i * 8 : pqb + (i - n_wq) * 8;
            const f32x4 a = *(const f32x4*)s, b = *(const f32x4*)(s + 4);
            u32x4 w; w.x = pk2(a.x, a.y); w.y = pk2(a.z, a.w); w.z = pk2(b.x, b.y); w.w = pk2(b.z, b.w); *(u32x4*)d = w;
        }
    }
    {
        const float* keys = (const float*)pin(p, I_PEER_KEYS); bf16_t* kbd = (bf16_t*)(ws + WS_KBD);
        const size_t n = (size_t)DEPTH * 8 * 256 * 256 / 8;
        for (size_t i = (size_t)tc.bid * 512 + tc.tid; i < n; i += (size_t)tc.nb * 512) {
            const size_t e = i * 8; const int c = (int)(e & 255), r = (int)((e >> 8) & 255); const size_t lh = e >> 16;
            const int pr = r >> 7, key = r & 127, pc = c >> 7, d = c & 127;
            u32x4 w = (u32x4){0u, 0u, 0u, 0u};
            if (pr == pc) { const float* s = keys + ((lh * 2 + pr) * 128 + key) * 128 + d; const f32x4 a = *(const f32x4*)s, b = *(const f32x4*)(s + 4);
                w.x = pk2(a.x, a.y); w.y = pk2(a.z, a.w); w.z = pk2(b.x, b.y); w.w = pk2(b.z, b.w); }
            *(u32x4*)(kbd + e) = w;
        }
    }
}

DI unsigned fp8x4(float a, float b, float c, float d) {
    a = fminf(fmaxf(a, -448.f), 448.f); b = fminf(fmaxf(b, -448.f), 448.f); c = fminf(fmaxf(c, -448.f), 448.f); d = fminf(fmaxf(d, -448.f), 448.f);
    int t = 0; t = __builtin_amdgcn_cvt_pk_fp8_f32(a, b, t, false); t = __builtin_amdgcn_cvt_pk_fp8_f32(c, d, t, true); return (unsigned)t;
}
DI void rms_rows(const TC tc, const float* X, const float* gain, bf16_t* ob, float* of, int rows, unsigned char* oq = nullptr) {
    const int lane = tc.tid & 63, gw = tc.bid * 8 + (tc.tid >> 6), NGW = tc.nb * 8;
    f32x4 n0[4], n1[4];
#pragma unroll
    for (int j = 0; j < 4; ++j) { n0[j] = (f32x4){0.f, 0.f, 0.f, 0.f}; n1[j] = n0[j]; }
    if (gw < rows) {
#pragma unroll
        for (int j = 0; j < 4; ++j) n0[j] = ((const f32x4*)(X + (size_t)gw * D) + lane)[64 * j]; }
    if (gw + NGW < rows) {
#pragma unroll
        for (int j = 0; j < 4; ++j) n1[j] = ((const f32x4*)(X + (size_t)(gw + NGW) * D) + lane)[64 * j]; }
    for (int r = gw; r < rows; r += NGW) {
        f32x4 v[4]; float ss = 0.f;
#pragma unroll
        for (int j = 0; j < 4; ++j) { v[j] = n0[j]; n0[j] = n1[j]; }
        if (r + 2 * NGW < rows) {
#pragma unroll
            for (int j = 0; j < 4; ++j) n1[j] = ((const f32x4*)(X + (size_t)(r + 2 * NGW) * D) + lane)[64 * j]; }
#pragma unroll
        for (int j = 0; j < 4; ++j) ss += v[j].x * v[j].x + v[j].y * v[j].y + v[j].z * v[j].z + v[j].w * v[j].w;
        const float sc = frsq(wave_sum(ss) * (1.0f / D) + EPS);
#pragma unroll
        for (int j = 0; j < 4; ++j) {
            const f32x4 g = ((const f32x4*)gain)[lane + 64 * j];
            const f32x4 o = v[j] * sc * g;
            if (ob) { u32x2 w; w.x = pk2(o.x, o.y); w.y = pk2(o.z, o.w); *((u32x2*)(ob + (size_t)r * D) + lane + 64 * j) = w; }
            if (of) ((f32x4*)(of + (size_t)r * D))[lane + 64 * j] = o;
            if (oq) {
                typedef float f32x2 __attribute__((ext_vector_type(2)));
                const f32x4 o8 = o * 8.0f; const unsigned q1 = fp8x4(o8.x, o8.y, o8.z, o8.w);
                const f32x2 d0 = __builtin_amdgcn_cvt_pk_f32_fp8((int)q1, false), d1 = __builtin_amdgcn_cvt_pk_f32_fp8((int)q1, true);
                ((unsigned*)(oq + (size_t)r * D))[lane + 64 * j] = q1;
                if (PEER_LO) { const unsigned q2 = fp8x4((o8.x - d0.x) * 16.0f, (o8.y - d0.y) * 16.0f, (o8.z - d1.x) * 16.0f, (o8.w - d1.y) * 16.0f);
                    ((unsigned*)(oq + (size_t)T * D + (size_t)r * D))[lane + 64 * j] = q2; }
            }
        }
    }
}

template <bool RET>
DI void seq_linattn(const TC tc, PRM p, int l, int item) {
    const bf16_t* PROJ = (const bf16_t*)(pws(p) + WS_PROJ);
    float* OT = (float*)(pws(p) + WS_OTMP) + (size_t)(RET ? 2 : 0) * T * 512;
    const int b = item >> 5, h = (item >> 3) & 3, jg = item & 7;
    const int tid = tc.tid, j = tid >> 5, ks = tid & 31, k0 = ks * 4;
    const int qoff = (RET ? C_RTQ : C_HGQ) + h * 128, foff = (RET ? C_RTK : C_HGF) + h * 128, voff = (RET ? C_RTV : C_HGI) + h * 128 + jg * 16 + j;
    const int* pos = (const int*)pin(p, I_POS) + b * SEQ;
    float lb[4], inv[4];
    float gam = 1.0f;
    if (RET) {
        gam = 1.0f - exp2f(-5.0f - (float)h);
#pragma unroll
        for (int i = 0; i < 4; ++i) inv[i] = powf(10000.0f, -(float)((k0 + i) & 63) * (1.0f / 64.0f));
    } else {
        const float* hl = (const float*)pin(p, I_HG_LB);
#pragma unroll
        for (int i = 0; i < 4; ++i) {
            const int c = h * 128 + k0 + i;
            if (l == 0) lb[i] = 0.f;
            else { const float a0 = hl[c], a1 = hl[512 + c], m = fmaxf(a0, a1), e0 = expf(a0 - m), e1 = expf(a1 - m); lb[i] = e1 / (e0 + e1); }
        }
    }
    float S[4] = {0.f, 0.f, 0.f, 0.f};
    const bf16_t* base = PROJ + (size_t)b * SEQ * INC;
    const int pk0 = k0 ^ 64;
    for (int t0 = 0; t0 < SEQ; t0 += 4) {
        u32x2 q4[4], f4[4], qp4[4], fp4[4]; bf16_t vv[4]; int ps[4];
#pragma unroll
        for (int u = 0; u < 4; ++u) {
            const bf16_t* row = base + (size_t)(t0 + u) * INC;
            q4[u] = *(const u32x2*)(row + qoff + k0); f4[u] = *(const u32x2*)(row + foff + k0); vv[u] = row[voff];
            if (RET) { qp4[u] = *(const u32x2*)(row + qoff + pk0); fp4[u] = *(const u32x2*)(row + foff + pk0); ps[u] = pos[t0 + u]; }
        }
#pragma unroll
        for (int u = 0; u < 4; ++u) {
            const float qv[4] = {bflo(q4[u].x), bfhi(q4[u].x), bflo(q4[u].y), bfhi(q4[u].y)};
            const float fv[4] = {bflo(f4[u].x), bfhi(f4[u].x), bflo(f4[u].y), bfhi(f4[u].y)};
            const float v = bf2f(vv[u]);
            float part = 0.f;
            if (RET) {
                const float qpv[4] = {bflo(qp4[u].x), bfhi(qp4[u].x), bflo(qp4[u].y), bfhi(qp4[u].y)};
                const float fpv[4] = {bflo(fp4[u].x), bfhi(fp4[u].x), bflo(fp4[u].y), bfhi(fp4[u].y)};
                const float pf = (float)ps[u];
#pragma unroll
                for (int i = 0; i < 4; ++i) {
                    const float ang = pf * inv[i]; float sn, cs; sincosf(ang, &sn, &cs);
                    float qr, kr;
                    if (k0 < 64) { qr = qv[i] * cs - qpv[i] * sn; kr = fv[i] * cs - fpv[i] * sn; }
                    else { qr = qpv[i] * sn + qv[i] * cs; kr = fpv[i] * sn + fv[i] * cs; }
                    kr *= 0.08838834764831845f;
                    S[i] = gam * S[i] + kr * v;
                    part += S[i] * qr;
                }
            } else {
#pragma unroll
                for (int i = 0; i < 4; ++i) {
                    const float z = fv[i];
                    const float sg = 1.0f / (1.0f + expf(-z));
                    float f = lb[i] + (1.0f - lb[i]) * sg; f = fminf(fmaxf(f, 1e-6f), 1.0f);
                    const float kk = (1.0f - lb[i]) / (1.0f + expf(z));
                    S[i] = f * S[i] + kk * v;
                    part += S[i] * (qv[i] * 0.08838834764831845f);
                }
            }
            part += sx<16>(part); part += sx<8>(part); part += sx<4>(part); part += sx<2>(part); part += sx<1>(part);
            if (ks == 0) OT[(size_t)(b * SEQ + t0 + u) * 512 + h * 128 + jg * 16 + j] = part;
        }
    }
}

DI float reduce16(float (&v)[16], int lane) {
    const bool h4 = lane & 16, h3 = lane & 8, h2 = lane & 4, h1 = lane & 2;
#pragma unroll
    for (int i = 0; i < 8; ++i) { const float send = h4 ? v[i] : v[i + 8], keep = h4 ? v[i + 8] : v[i]; v[i] = keep + sx<16>(send); }
#pragma unroll
    for (int i = 0; i < 4; ++i) { const float send = h3 ? v[i] : v[i + 4], keep = h3 ? v[i + 4] : v[i]; v[i] = keep + sx<8>(send); }
#pragma unroll
    for (int i = 0; i < 2; ++i) { const float send = h2 ? v[i] : v[i + 2], keep = h2 ? v[i + 2] : v[i]; v[i] = keep + sx<4>(send); }
    { const float send = h1 ? v[0] : v[1], keep = h1 ? v[1] : v[0]; v[0] = keep + sx<2>(send); }
    float r = v[0]; r += sx<1>(r);
    float lo, hi; halves(r, lo, hi);
    return lo + hi;
}

constexpr int S5_LC = 128, S5_NCH = SEQ / S5_LC;
struct S5Const { float a_re, a_im; };
DI void s5_disc_init(PRM p, int idx, float* out) {
    const int l = idx >> 11, g = (idx >> 6) & 31, lane = idx & 63;
    const float lr = fminf(((const float*)pin(p, I_S5_LRE))[(l * 32 + g) * 64 + lane], -1e-4f);
    const float li = ((const float*)pin(p, I_S5_LIM))[(l * 32 + g) * 64 + lane];
    const float dt = expf(((const float*)pin(p, I_S5_LOGSTEP))[l * 32 + g]);
    const float mag = expf(lr * dt);
    const float a_re = mag * cosf(li * dt), a_im = mag * sinf(li * dt);
    const float den = lr * lr + li * li;
    out[0] = a_re; out[1] = a_im; out[2] = ((a_re - 1.0f) * lr + a_im * li) / den; out[3] = (a_im * lr - (a_re - 1.0f) * li) / den;
}
DI S5Const s5_disc(PRM p, int l, int g, int lane, float& z_re, float& z_im) {
    const f32x4 v = *(const f32x4*)((const float*)(pws(p) + WS_TAB) + (size_t)((l * 32 + g) * 64 + lane) * 4);
    S5Const c; c.a_re = v.x; c.a_im = v.y; z_re = v.z; z_im = v.w; return c;
}
template <int MODE>
DI void s5_chunk(const TC tc, PRM p, int l, int item) {
    const bf16_t* PROJ = (const bf16_t*)(pws(p) + WS_PROJ);
    float* XEND = (float*)(pws(p) + WS_S5X);
    const int b = item / (32 * S5_NCH), g = (item / S5_NCH) & 31, n = item % S5_NCH, lane = tc.tid & 63;
    float z_re, z_im; const S5Const cc = s5_disc(p, l, g, lane, z_re, z_im);
    const float a_re = cc.a_re, a_im = cc.a_im;
    float bbr[16], bbi[16];
    const float* Bre = (const float*)pin(p, I_S5_BRE) + ((size_t)(l * 32 + g) * 64 + lane) * 16;
    const float* Bim = (const float*)pin(p, I_S5_BIM) + ((size_t)(l * 32 + g) * 64 + lane) * 16;
#pragma unroll
    for (int c = 0; c < 16; ++c) { const float br = Bre[c], bi = Bim[c]; bbr[c] = z_re * br - z_im * bi; bbi[c] = z_re * bi + z_im * br; }
    float cr[16], ci[16]; float dch = 0.f;
    const int cch = ((lane >> 4) & 1) * 8 + ((lane >> 3) & 1) * 4 + ((lane >> 2) & 1) * 2 + ((lane >> 1) & 1);
    if (MODE == 3) {
        const float* Cre = (const float*)pin(p, I_S5_CRE) + (size_t)(l * 32 + g) * 16 * 64 + lane;
        const float* Cim = (const float*)pin(p, I_S5_CIM) + (size_t)(l * 32 + g) * 16 * 64 + lane;
#pragma unroll
        for (int c = 0; c < 16; ++c) { cr[c] = Cre[c * 64]; ci[c] = Cim[c * 64]; }
        dch = ((const float*)pin(p, I_S5_D))[l * 512 + g * 16 + cch];
    }
    float* xe = XEND + ((size_t)((b * 32 + g) * S5_NCH + n) * 64 + lane) * 2;
    float xr = 0.f, xi = 0.f;
    if (MODE == 3) { xr = xe[0]; xi = xe[1]; }
    const bf16_t* base = PROJ + (size_t)(b * SEQ + n * S5_LC) * INC + C_S5U + g * 16;
    bf16_t* yo = (bf16_t*)(pws(p) + WS_YS5) + (size_t)(b * SEQ + n * S5_LC) * 512 + g * 16 + cch;
    for (int t0 = 0; t0 < S5_LC; t0 += 4) {
        u32x4 ua[4], ub[4];
#pragma unroll
        for (int u = 0; u < 4; ++u) { const bf16_t* row = base + (size_t)(t0 + u) * INC; ua[u] = *(const u32x4*)row; ub[u] = *(const u32x4*)(row + 8); }
#pragma unroll
        for (int u = 0; u < 4; ++u) {
            const float uu[16] = {bflo(ua[u].x), bfhi(ua[u].x), bflo(ua[u].y), bfhi(ua[u].y), bflo(ua[u].z), bfhi(ua[u].z), bflo(ua[u].w), bfhi(ua[u].w),
                                  bflo(ub[u].x), bfhi(ub[u].x), bflo(ub[u].y), bfhi(ub[u].y), bflo(ub[u].z), bfhi(ub[u].z), bflo(ub[u].w), bfhi(ub[u].w)};
            float br = 0.f, bi = 0.f;
#pragma unroll
            for (int c = 0; c < 16; ++c) { br += bbr[c] * uu[c]; bi += bbi[c] * uu[c]; }
            const float nr = a_re * xr - a_im * xi + br, ni = a_re * xi + a_im * xr + bi;
            xr = nr; xi = ni;
            if (MODE == 3) {
                float pv[16];
#pragma unroll
                for (int c = 0; c < 16; ++c) pv[c] = cr[c] * xr - ci[c] * xi;
                float y = reduce16(pv, lane);
                float uc = 0.f;
#pragma unroll
                for (int c = 0; c < 16; ++c) uc = (cch == c) ? uu[c] : uc;
                y = gelu_tanh(y + dch * uc);
                if ((lane & 33) == 0) yo[(size_t)(t0 + u) * 512] = (bf16_t)f2bf(y);
            }
        }
    }
    if (MODE == 1) { xe[0] = xr; xe[1] = xi; }
}
constexpr int S5W_BU = 0, S5W_X = 10240, S5W_BYTES = 15360;
template <int MODE>
DI void s5_chunk_mfma(const TC tc, PRM p, int l, int item, LAS unsigned char* lds) {
    const bf16_t* PROJ = (const bf16_t*)(pws(p) + WS_PROJ);
    float* XEND = (float*)(pws(p) + WS_S5X);
    const int b = item / (32 * S5_NCH), g = (item / S5_NCH) & 31, n = item % S5_NCH, lane = tc.tid & 63, w = tc.tid >> 6, tl = lane & 15, kg = lane >> 4;
    LAS float* BUs = (LAS float*)(lds + w * S5W_BYTES + S5W_BU); LAS bf16_t* Xs = (LAS bf16_t*)(lds + w * S5W_BYTES + S5W_X);
    float z_re, z_im; const S5Const cc = s5_disc(p, l, g, lane, z_re, z_im);
    const float a_re = cc.a_re, a_im = cc.a_im;
    const bf16_t* BBF = (const bf16_t*)(pws(p) + WS_TAB + 256 * 1024) + (size_t)(l * 32 + g) * 128 * 16;
    const bf16_t* CMF = (const bf16_t*)(pws(p) + WS_TAB + 512 * 1024) + (size_t)(l * 32 + g) * 16 * 128;
    bf16x8 bbf[8], cmf[4];
    const bf16x8 zf = {0, 0, 0, 0, 0, 0, 0, 0};
#pragma unroll
    for (int nt = 0; nt < 8; ++nt) bbf[nt] = (kg < 2) ? *(const bf16x8*)(BBF + (nt * 16 + tl) * 16 + 8 * kg) : zf;
    float dch = 0.f;
    if (MODE == 3) {
#pragma unroll
        for (int ks = 0; ks < 4; ++ks) cmf[ks] = *(const bf16x8*)(CMF + tl * 128 + ks * 32 + 8 * kg);
        dch = ((const float*)pin(p, I_S5_D))[l * 512 + g * 16 + tl];
    }
    float* xe = XEND + ((size_t)((b * 32 + g) * S5_NCH + n) * 64 + lane) * 2;
    float xr = 0.f, xi = 0.f;
    if (MODE == 3) { xr = xe[0]; xi = xe[1]; }
    const size_t tok0 = (size_t)b * SEQ + (size_t)n * S5_LC;
    const bf16_t* ub = PROJ + tok0 * INC + C_S5U + g * 16;
    bf16_t* yo = (bf16_t*)(pws(p) + WS_YS5) + tok0 * 512 + g * 16 + tl;
    bf16x8 un = (kg < 2) ? *(const bf16x8*)(ub + (size_t)tl * INC + 8 * kg) : zf;
    bf16_t uon[4] = {0, 0, 0, 0};
    if (MODE == 3) {
#pragma unroll
        for (int r = 0; r < 4; ++r) uon[r] = ub[(size_t)(kg * 4 + r) * INC + tl]; }
#pragma unroll 1
    for (int t0 = 0; t0 < S5_LC; t0 += 16) {
        const bf16x8 ua = un;
        bf16_t uo[4];
#pragma unroll
        for (int r = 0; r < 4; ++r) uo[r] = uon[r];
        if (t0 + 16 < S5_LC) { un = (kg < 2) ? *(const bf16x8*)(ub + (size_t)(t0 + 16 + tl) * INC + 8 * kg) : zf;
            if (MODE == 3) {
#pragma unroll
                for (int r = 0; r < 4; ++r) uon[r] = ub[(size_t)(t0 + 16 + kg * 4 + r) * INC + tl]; } }
        f32x4 bu[8];
#pragma unroll
        for (int nt = 0; nt < 8; ++nt) bu[nt] = __builtin_amdgcn_mfma_f32_16x16x32_bf16(ua, bbf[nt], (f32x4){0.f, 0.f, 0.f, 0.f}, 0, 0, 0);
        __builtin_amdgcn_sched_barrier(0); asm volatile("s_nop 15\n\ts_nop 15" ::: "memory"); __builtin_amdgcn_sched_barrier(0);
#pragma unroll
        for (int nt = 0; nt < 8; ++nt) *(LAS f32x4*)(BUs + (nt * 16 + tl) * 20 + kg * 4) = bu[nt];
        float brv[16], biv[16];
#pragma unroll
        for (int j = 0; j < 4; ++j) { const f32x4 a = *(const LAS f32x4*)(BUs + lane * 20 + 4 * j), c = *(const LAS f32x4*)(BUs + (64 + lane) * 20 + 4 * j);
            brv[4 * j] = a.x; brv[4 * j + 1] = a.y; brv[4 * j + 2] = a.z; brv[4 * j + 3] = a.w; biv[4 * j] = c.x; biv[4 * j + 1] = c.y; biv[4 * j + 2] = c.z; biv[4 * j + 3] = c.w; }
        __builtin_amdgcn_sched_barrier(0);
#pragma unroll
        for (int t = 0; t < 16; ++t) {
            const float br = brv[t], bi = biv[t];
            const float nr = a_re * xr - a_im * xi + br, ni = a_re * xi + a_im * xr + bi;
            xr = nr; xi = ni;
            if (MODE == 3) { brv[t] = xr; biv[t] = xi; }
        }
        if (MODE == 3) {
#pragma unroll
            for (int j = 0; j < 2; ++j) {
                u32x4 wr_, wi_;
                wr_.x = pk2(brv[8 * j], brv[8 * j + 1]); wr_.y = pk2(brv[8 * j + 2], brv[8 * j + 3]); wr_.z = pk2(brv[8 * j + 4], brv[8 * j + 5]); wr_.w = pk2(brv[8 * j + 6], brv[8 * j + 7]);
                wi_.x = pk2(biv[8 * j], biv[8 * j + 1]); wi_.y = pk2(biv[8 * j + 2], biv[8 * j + 3]); wi_.z = pk2(biv[8 * j + 4], biv[8 * j + 5]); wi_.w = pk2(biv[8 * j + 6], biv[8 * j + 7]);
                *(LAS u32x4*)(Xs + lane * 20 + 8 * j) = wr_; *(LAS u32x4*)(Xs + (64 + lane) * 20 + 8 * j) = wi_;
            }
            f32x4 y = (f32x4){0.f, 0.f, 0.f, 0.f};
            typedef short i16x4_ __attribute__((ext_vector_type(4)));
#pragma unroll
            for (int ks = 0; ks < 4; ++ks) {
                const LAS bf16_t* rp0 = Xs + (ks * 32 + 8 * kg + (tl >> 2)) * 20 + 4 * (tl & 3);
                const i16x4_ lo4 = __builtin_amdgcn_ds_read_tr16_b64_v4i16((LAS i16x4_*)rp0), hi4 = __builtin_amdgcn_ds_read_tr16_b64_v4i16((LAS i16x4_*)(rp0 + 4 * 20));
                const bf16x8 af = {lo4.x, lo4.y, lo4.z, lo4.w, hi4.x, hi4.y, hi4.z, hi4.w};
                y = __builtin_amdgcn_mfma_f32_16x16x32_bf16(af, cmf[ks], y, 0, 0, 0);
            }
#pragma unroll
            for (int r = 0; r < 4; ++r) { const int t = t0 + kg * 4 + r; const float u = bf2f(uo[r]);
                yo[(size_t)t * 512] = (bf16_t)f2bf(gelu_tanh(y[r] + dch * u)); }
        }
    }
    if (MODE == 1) { xe[0] = xr; xe[1] = xi; }
}

DI void s5_scan(const TC tc, PRM p, int l) {
    float* XEND = (float*)(pws(p) + WS_S5X);
    for (int it = tc.bid * 512 + tc.tid; it < NB * 32 * 64; it += tc.nb * 512) {
        const int bg = it >> 6, lane = it & 63, g = bg & 31;
        float z_re, z_im; const S5Const cc = s5_disc(p, l, g, lane, z_re, z_im);
        float pr = cc.a_re, pi = cc.a_im;
#pragma unroll
        for (int i = 0; i < 7; ++i) { const float nr = pr * pr - pi * pi, ni = 2.0f * pr * pi; pr = nr; pi = ni; }
        float* xe = XEND + ((size_t)bg * S5_NCH * 64 + lane) * 2;
        float sr = 0.f, si = 0.f; asm volatile("" : "+v"(sr), "+v"(si));
        for (int n0 = 0; n0 < S5_NCH; n0 += 32) {
            float er[32], ei[32];
#pragma unroll
            for (int u = 0; u < 32; ++u) { er[u] = xe[(size_t)(n0 + u) * 128]; ei[u] = xe[(size_t)(n0 + u) * 128 + 1]; }
#pragma unroll
            for (int u = 0; u < 32; ++u) {
                if (!tc.nostore) { xe[(size_t)(n0 + u) * 128] = sr; xe[(size_t)(n0 + u) * 128 + 1] = si; }
                const float nr = pr * sr - pi * si + er[u], ni = pr * si + pi * sr + ei[u]; sr = nr; si = ni;
            }
        }
    }
}

constexpr int LA_C = 64, LA_NCH = SEQ / LA_C, LA_ITEMS = 2 * NB * 4 * LA_NCH;
constexpr int LA_QS = 144, LA_BS = 132, LA_VS = 80, LA_SS = 144, LA_PS = 80;
constexpr int LA_Q = 0, LA_K = LA_Q + 64 * LA_QS * 2, LA_B = LA_K + 64 * LA_QS * 2, LA_VT = LA_B + 64 * LA_BS * 4, LA_ST = LA_VT + 128 * LA_VS * 2, LA_P = LA_ST + 128 * LA_SS * 2,
              LA_X = LA_P + 64 * LA_PS * 2;
static_assert(LA_X + 2048 <= 144 * 1024 - 1024 && (LA_K | LA_B | LA_VT | LA_ST | LA_P | LA_X) % 16 == 0, "linear-attention LDS layout");
DI bf16x8 pack8(const float (&v)[8]) { u32x4 w; w.x = pk2(v[0], v[1]); w.y = pk2(v[2], v[3]); w.z = pk2(v[4], v[5]); w.w = pk2(v[6], v[7]); return __builtin_bit_cast(bf16x8, w); }

DI void la_item(int item, int& m, int& b, int& h, int& n) { n = item % LA_NCH; h = (item / LA_NCH) & 3; b = (item / (LA_NCH * 4)) & 1; m = item / (LA_NCH * 4 * NB); }
DI void la_vt_commit(const TC tc, const u32x4 va, const u32x4 vb, LAS unsigned char* lds) {
    const int t2 = tc.tid & 31, cv = (tc.tid >> 5) * 8; LAS unsigned* VT32 = (LAS unsigned*)(lds + LA_VT);
    VT32[((cv + 0) * LA_VS) / 2 + t2] = (va.x & 0xffffu) | (vb.x << 16); VT32[((cv + 1) * LA_VS) / 2 + t2] = (va.x >> 16) | (vb.x & 0xffff0000u);
    VT32[((cv + 2) * LA_VS) / 2 + t2] = (va.y & 0xffffu) | (vb.y << 16); VT32[((cv + 3) * LA_VS) / 2 + t2] = (va.y >> 16) | (vb.y & 0xffff0000u);
    VT32[((cv + 4) * LA_VS) / 2 + t2] = (va.z & 0xffffu) | (vb.z << 16); VT32[((cv + 5) * LA_VS) / 2 + t2] = (va.z >> 16) | (vb.z & 0xffff0000u);
    VT32[((cv + 6) * LA_VS) / 2 + t2] = (va.w & 0xffffu) | (vb.w << 16); VT32[((cv + 7) * LA_VS) / 2 + t2] = (va.w >> 16) | (vb.w & 0xffff0000u);
}
DI void la_hg_kf(const float* tab, int l, int h, int c0, int t, const u32x4 zraw, LAS unsigned char* lds) {
    LAS bf16_t* Ks = (LAS bf16_t*)(lds + LA_K); LAS float* Bs = (LAS float*)(lds + LA_B);
    float z[8], kk[8], lf[8]; unpack8(zraw, z);
#pragma unroll
    for (int j = 0; j < 8; ++j) { const float lb = tab[l * 512 + h * 128 + c0 + j]; const float sg = frcp(1.0f + fexp(-z[j])); float f = lb + (1.0f - lb) * sg; f = fminf(fmaxf(f, 1e-6f), 1.0f);
        lf[j] = flog(f); kk[j] = (1.0f - lb) * frcp(1.0f + fexp(z[j])); }
    *(LAS bf16x8*)(Ks + t * LA_QS + c0) = pack8(kk);
    *(LAS f32x4*)(Bs + t * LA_BS + c0) = (f32x4){lf[0], lf[1], lf[2], lf[3]}; *(LAS f32x4*)(Bs + t * LA_BS + c0 + 4) = (f32x4){lf[4], lf[5], lf[6], lf[7]};
}
DI void la_cumsum(const TC tc, int m, LAS unsigned char* lds) {
    LAS float* Bs = (LAS float*)(lds + LA_B);
    __syncthreads();
    if (m == 0) {
        LAS float* Xs = (LAS float*)(lds + LA_X);
        const int k = tc.tid & 127, sg = tc.tid >> 7;
        float v[16]; float tot = 0.f;
#pragma unroll
        for (int i = 0; i < 16; ++i) { v[i] = Bs[(sg * 16 + i) * LA_BS + k]; tot += v[i]; }
        Xs[sg * 128 + k] = tot;
        __syncthreads();
        float run = 0.f;
#pragma unroll
        for (int s = 0; s < 3; ++s) run += (s < sg) ? Xs[s * 128 + k] : 0.f;
#pragma unroll
        for (int i = 0; i < 16; ++i) { run += v[i]; Bs[(sg * 16 + i) * LA_BS + k] = run; }
    }
    __syncthreads();
}
struct LaPreA { u32x4 q[2], qp[2], k[2], kp[2]; f32x4 cs[2][2], sn[2][2]; u32x4 va, vb; };
DI void laA_issue(const TC tc, PRM p, int item, LaPreA& r) {
    int m, b, h, n; la_item(item, m, b, h, n);
    const bf16_t* PROJ = (const bf16_t*)(pws(p) + WS_PROJ); const int tid = tc.tid, c0 = (tid & 15) * 8;
#pragma unroll
    for (int ps = 0; ps < 2; ++ps) {
        const size_t tok = (size_t)b * SEQ + (size_t)n * LA_C + (tid >> 4) + 32 * ps; const bf16_t* prow = PROJ + tok * INC;
        if (m == 0) r.k[ps] = *(const u32x4*)(prow + C_HGF + h * 128 + c0);
        else {
            r.q[ps] = *(const u32x4*)(prow + C_RTQ + h * 128 + c0); r.qp[ps] = *(const u32x4*)(prow + C_RTQ + h * 128 + (c0 ^ 64));
            r.k[ps] = *(const u32x4*)(prow + C_RTK + h * 128 + c0); r.kp[ps] = *(const u32x4*)(prow + C_RTK + h * 128 + (c0 ^ 64));
            const float* rt = (const float*)(pws(p) + WS_ROPE) + tok * 128 + (c0 & 63);
            r.cs[ps][0] = *(const f32x4*)rt; r.cs[ps][1] = *(const f32x4*)(rt + 4); r.sn[ps][0] = *(const f32x4*)(rt + 64); r.sn[ps][1] = *(const f32x4*)(rt + 68);
        }
    }
    const size_t tokv = (size_t)b * SEQ + (size_t)n * LA_C + 2 * (tid & 31);
    const bf16_t* pv = PROJ + tokv * INC + (m == 0 ? C_HGI : C_RTV) + h * 128 + (tid >> 5) * 8;
    r.va = *(const u32x4*)pv; r.vb = *(const u32x4*)(pv + INC);
}
DI void laA_commit(const TC tc, PRM p, int l, int item, const LaPreA& r, LAS unsigned char* lds) {
    int m, b, h, n; la_item(item, m, b, h, n);
    const int tid = tc.tid, c0 = (tid & 15) * 8;
    const float* tab = (const float*)(pws(p) + WS_TAB) + 16384;
    LAS bf16_t* Ks = (LAS bf16_t*)(lds + LA_K); LAS float* Bs = (LAS float*)(lds + LA_B);
#pragma unroll
    for (int ps = 0; ps < 2; ++ps) {
        const int t = (tid >> 4) + 32 * ps; const size_t tok = (size_t)b * SEQ + (size_t)n * LA_C + t;
        if (m == 0) la_hg_kf(tab, l, h, c0, t, r.k[ps], lds);
        else {
            float q[8], qp[8], k[8], kp[8]; unpack8(r.q[ps], q); unpack8(r.qp[ps], qp); unpack8(r.k[ps], k); unpack8(r.kp[ps], kp);
            const float cs[8] = {r.cs[ps][0].x, r.cs[ps][0].y, r.cs[ps][0].z, r.cs[ps][0].w, r.cs[ps][1].x, r.cs[ps][1].y, r.cs[ps][1].z, r.cs[ps][1].w};
            const float sn[8] = {r.sn[ps][0].x, r.sn[ps][0].y, r.sn[ps][0].z, r.sn[ps][0].w, r.sn[ps][1].x, r.sn[ps][1].y, r.sn[ps][1].z, r.sn[ps][1].w};
            float qr[8], kr[8];
#pragma unroll
            for (int j = 0; j < 8; ++j) {
                if (c0 < 64) { qr[j] = q[j] * cs[j] - qp[j] * sn[j]; kr[j] = k[j] * cs[j] - kp[j] * sn[j]; }
                else { qr[j] = qp[j] * sn[j] + q[j] * cs[j]; kr[j] = kp[j] * sn[j] + k[j] * cs[j]; }
            }
            const bf16x8 qb = pack8(qr), kb = pack8(kr);
            *(bf16x8*)((bf16_t*)(pws(p) + WS_RQ) + tok * 512 + h * 128 + c0) = qb; *(bf16x8*)((bf16_t*)(pws(p) + WS_RK) + tok * 512 + h * 128 + c0) = kb;
            *(LAS bf16x8*)(Ks + t * LA_QS + c0) = kb;
            const float bt = (float)(t + 1) * tab[1024 + h];
            *(LAS f32x4*)(Bs + t * LA_BS + c0) = (f32x4){bt, bt, bt, bt}; *(LAS f32x4*)(Bs + t * LA_BS + c0 + 4) = (f32x4){bt, bt, bt, bt};
        }
    }
    la_vt_commit(tc, r.va, r.vb, lds);
    la_cumsum(tc, m, lds);
}
struct LaPreC { u32x4 a[2], b[2], va, vb, st[4]; };
DI void laC_issue(const TC tc, PRM p, int item, LaPreC& r) {
    int m, b, h, n; la_item(item, m, b, h, n);
    const bf16_t* PROJ = (const bf16_t*)(pws(p) + WS_PROJ); const int tid = tc.tid, c0 = (tid & 15) * 8;
#pragma unroll
    for (int ps = 0; ps < 2; ++ps) {
        const size_t tok = (size_t)b * SEQ + (size_t)n * LA_C + (tid >> 4) + 32 * ps;
        if (m == 0) { r.a[ps] = *(const u32x4*)(PROJ + tok * INC + C_HGQ + h * 128 + c0); r.b[ps] = *(const u32x4*)(PROJ + tok * INC + C_HGF + h * 128 + c0); }
        else { r.a[ps] = *(const u32x4*)((const bf16_t*)(pws(p) + WS_RQ) + tok * 512 + h * 128 + c0); r.b[ps] = *(const u32x4*)((const bf16_t*)(pws(p) + WS_RK) + tok * 512 + h * 128 + c0); }
    }
    const size_t tokv = (size_t)b * SEQ + (size_t)n * LA_C + 2 * (tid & 31);
    const bf16_t* pv = PROJ + tokv * INC + (m == 0 ? C_HGI : C_RTV) + h * 128 + (tid >> 5) * 8;
    r.va = *(const u32x4*)pv; r.vb = *(const u32x4*)(pv + INC);
    const bf16_t* st = (const bf16_t*)(pws(p) + WS_LAST) + (size_t)item * 16384;
#pragma unroll
    for (int i = 0; i < 4; ++i) r.st[i] = *(const u32x4*)(st + (i * 512 + tid) * 8);
}
DI void laC_commit(const TC tc, PRM p, int l, int item, const LaPreC& r, LAS unsigned char* lds) {
    int m, b, h, n; la_item(item, m, b, h, n);
    const int tid = tc.tid, c0 = (tid & 15) * 8;
    const float* tab = (const float*)(pws(p) + WS_TAB) + 16384;
    LAS bf16_t* Qs = (LAS bf16_t*)(lds + LA_Q); LAS bf16_t* Ks = (LAS bf16_t*)(lds + LA_K);
#pragma unroll
    for (int ps = 0; ps < 2; ++ps) {
        const int t = (tid >> 4) + 32 * ps;
        *(LAS u32x4*)(Qs + t * LA_QS + c0) = r.a[ps];
        if (m == 0) la_hg_kf(tab, l, h, c0, t, r.b[ps], lds);
        else *(LAS u32x4*)(Ks + t * LA_QS + c0) = r.b[ps];
    }
    la_vt_commit(tc, r.va, r.vb, lds);
    LAS bf16_t* STs = (LAS bf16_t*)(lds + LA_ST);
#pragma unroll
    for (int i = 0; i < 4; ++i) { const int e = (i * 512 + tid) * 8, v = e >> 7, k = e & 127; *(LAS u32x4*)(STs + v * LA_SS + k) = r.st[i]; }
    la_cumsum(tc, m, lds);
}

DI void la_phaseA(const TC tc, PRM p, int l, int item, LaPreA& pre, int next_item, LAS unsigned char* lds) {
    { TC t2 = tc; asm volatile("" : "+v"(t2.tid)); laA_commit(t2, p, l, item, pre, lds); }
    __builtin_amdgcn_sched_barrier(0);
    if (next_item >= 0) { TC t3 = tc; asm volatile("" : "+v"(t3.tid)); laA_issue(t3, p, next_item, pre); }
    __builtin_amdgcn_sched_barrier(0);
    const int tid = tc.tid, lane = tid & 63, w = tid >> 6, c0 = (tid & 15) * 8, tl = lane & 15, kg = lane >> 4;
    LAS bf16_t* Ks = (LAS bf16_t*)(lds + LA_K); LAS float* Bs = (LAS float*)(lds + LA_B); LAS bf16_t* VT = (LAS bf16_t*)(lds + LA_VT); LAS bf16_t* KT = (LAS bf16_t*)(lds + LA_ST);
    float bl[8];
    { const f32x4 a = *(const LAS f32x4*)(Bs + (LA_C - 1) * LA_BS + c0), c = *(const LAS f32x4*)(Bs + (LA_C - 1) * LA_BS + c0 + 4);
      bl[0] = a.x; bl[1] = a.y; bl[2] = a.z; bl[3] = a.w; bl[4] = c.x; bl[5] = c.y; bl[6] = c.z; bl[7] = c.w; }
#pragma unroll
    for (int ps = 0; ps < 2; ++ps) {
        const int t = (tid >> 4) + 32 * ps;
        float k[8]; unpack8(*(const LAS u32x4*)(Ks + t * LA_QS + c0), k);
        const f32x4 a = *(const LAS f32x4*)(Bs + t * LA_BS + c0), c = *(const LAS f32x4*)(Bs + t * LA_BS + c0 + 4);
        const float bt[8] = {a.x, a.y, a.z, a.w, c.x, c.y, c.z, c.w};
#pragma unroll
        for (int j = 0; j < 8; ++j) KT[(c0 + j) * LA_VS + ((((t >> 3) ^ ((c0 >> 4) & 7)) << 3) | (t & 7))] = (bf16_t)f2bf(k[j] * fexp(bl[j] - bt[j]));
    }
    if (tid < 128) ((float*)(pws(p) + WS_LADEC))[(size_t)item * 128 + tid] = fexp(Bs[(LA_C - 1) * LA_BS + tid]);
    __syncthreads();
    f32x4 acc[8];
#pragma unroll
    for (int cb = 0; cb < 8; ++cb) acc[cb] = (f32x4){0.f, 0.f, 0.f, 0.f};
#pragma unroll
    for (int ks = 0; ks < 2; ++ks) {
        const bf16x8 a = *(const LAS bf16x8*)(VT + (16 * w + tl) * LA_VS + ks * 32 + 8 * kg);
#pragma unroll
        for (int cb = 0; cb < 8; ++cb) {
            const bf16x8 bb = *(const LAS bf16x8*)(KT + (cb * 16 + tl) * LA_VS + 8 * ((ks * 4 + kg) ^ cb));
            acc[cb] = __builtin_amdgcn_mfma_f32_16x16x32_bf16(a, bb, acc[cb], 0, 0, 0);
        }
    }
    bf16_t* st = (bf16_t*)(pws(p) + WS_LAST) + (size_t)item * 16384;
#pragma unroll
    for (int cb = 0; cb < 8; ++cb)
#pragma unroll
        for (int r = 0; r < 4; ++r) st[(16 * w + kg * 4 + r) * 128 + cb * 16 + tl] = (bf16_t)f2bf(acc[cb][r]);
    __syncthreads();
}

DI void la_scan(const TC tc, PRM p) {
    bf16_t* ST = (bf16_t*)(pws(p) + WS_LAST); const float* DEC = (const float*)(pws(p) + WS_LADEC);
    for (int gid = tc.bid * 512 + tc.tid; gid < 16 * 8192; gid += tc.nb * 512) {
        const int seq = gid >> 13, e = (gid & 8191) * 2, k = e & 127;
        unsigned* st = (unsigned*)(ST + (size_t)seq * LA_NCH * 16384 + e); const float* dc = DEC + (size_t)seq * LA_NCH * 128 + k;
        float s0 = 0.f, s1 = 0.f;
        for (int n0 = 0; n0 < LA_NCH; n0 += 32) {
            unsigned kv[32]; float d0[32], d1[32];
#pragma unroll
            for (int u = 0; u < 32; ++u) { kv[u] = st[(size_t)(n0 + u) * 8192]; d0[u] = dc[(n0 + u) * 128]; d1[u] = dc[(n0 + u) * 128 + 1]; }
#pragma unroll
            for (int u = 0; u < 32; ++u) { if (tc.nostore && s0 == 12345.678f) st[0] = 1u; if (!tc.nostore) st[(size_t)(n0 + u) * 8192] = pk2(s0, s1); s0 = d0[u] * s0 + bflo(kv[u]); s1 = d1[u] * s1 + bfhi(kv[u]); }
        }
    }
}

DI void la_phaseC(const TC tc, PRM p, int l, int item, LaPreC& pre, int next_item, LAS unsigned char* lds) {
    const int n = item % LA_NCH, h = (item / LA_NCH) & 3, b = (item / (LA_NCH * 4)) & 1, m = item / (LA_NCH * 4 * NB);
    int tid = tc.tid; asm volatile("" : "+v"(tid));
    const int lane = tid & 63, w = tid >> 6, tl = lane & 15, kg = lane >> 4, rb = w >> 1, vh = w & 1;
    bf16_t gatev[4][4];
    {
        const bf16_t* pg = (const bf16_t*)(pws(p) + WS_PROJ) + ((size_t)b * SEQ + (size_t)n * LA_C + 16 * rb + kg * 4) * INC + (m == 0 ? C_HGG : C_RTG) + h * 128 + vh * 64 + tl;
#pragma unroll
        for (int r = 0; r < 4; ++r)
#pragma unroll
            for (int vb = 0; vb < 4; ++vb) gatev[r][vb] = pg[(size_t)r * INC + vb * 16];
    }
    { TC t2 = tc; asm volatile("" : "+v"(t2.tid)); laC_commit(t2, p, l, item, pre, lds); }
    __builtin_amdgcn_sched_barrier(0);
    if (next_item >= 0) { TC t3 = tc; asm volatile("" : "+v"(t3.tid)); laC_issue(t3, p, next_item, pre); }
    __builtin_amdgcn_sched_barrier(0);
    LAS bf16_t* Qs = (LAS bf16_t*)(lds + LA_Q); LAS bf16_t* Ks = (LAS bf16_t*)(lds + LA_K); LAS float* Bs = (LAS float*)(lds + LA_B); LAS bf16_t* VT = (LAS bf16_t*)(lds + LA_VT);
    LAS bf16_t* STs = (LAS bf16_t*)(lds + LA_ST); LAS bf16_t* Ps = (LAS bf16_t*)(lds + LA_P); LAS float* Xs = (LAS float*)(lds + LA_X);
    const float lgam = ((const float*)(pws(p) + WS_TAB))[16384 + 1024 + h];
    if (m == 0) {
        const int c0 = (tid & 15) * 8;
#pragma unroll
        for (int ps = 0; ps < 2; ++ps) {
            const int t = (tid >> 4) + 32 * ps, te = (t | 15);
            float k[8]; unpack8(*(const LAS u32x4*)(Ks + t * LA_QS + c0), k);
            const f32x4 a = *(const LAS f32x4*)(Bs + t * LA_BS + c0), c = *(const LAS f32x4*)(Bs + t * LA_BS + c0 + 4);
            const f32x4 ea = *(const LAS f32x4*)(Bs + te * LA_BS + c0), ec = *(const LAS f32x4*)(Bs + te * LA_BS + c0 + 4);
            const float bt[8] = {a.x, a.y, a.z, a.w, c.x, c.y, c.z, c.w}, be[8] = {ea.x, ea.y, ea.z, ea.w, ec.x, ec.y, ec.z, ec.w};
#pragma unroll
            for (int j = 0; j < 8; ++j) k[j] *= fexp(be[j] - bt[j]);
            *(LAS bf16x8*)(Ks + t * LA_QS + c0) = pack8(k);
        }
        __syncthreads();
    }
    f32x4 acc1[4];
#pragma unroll
    for (int vb = 0; vb < 4; ++vb) acc1[vb] = (f32x4){0.f, 0.f, 0.f, 0.f};
    if (m == 1) {
        bf16x8 qa[4];
#pragma unroll
        for (int ks = 0; ks < 4; ++ks) qa[ks] = *(const LAS bf16x8*)(Qs + (16 * rb + tl) * LA_QS + ks * 32 + 8 * kg);
#pragma unroll
        for (int ks = 0; ks < 4; ++ks)
#pragma unroll
            for (int vb = 0; vb < 4; ++vb) acc1[vb] = __builtin_amdgcn_mfma_f32_16x16x32_bf16(qa[ks], *(const LAS bf16x8*)(STs + (vh * 64 + vb * 16 + tl) * LA_SS + ks * 32 + 8 * kg), acc1[vb], 0, 0, 0);
#pragma unroll
        for (int r = 0; r < 4; ++r) { const float dq = fexp(lgam * (float)(16 * rb + kg * 4 + r + 1));
#pragma unroll
            for (int vb = 0; vb < 4; ++vb) acc1[vb][r] *= dq; }
        for (int cb = 0; cb <= rb; ++cb) {
            f32x4 sc = (f32x4){0.f, 0.f, 0.f, 0.f};
#pragma unroll
            for (int ks = 0; ks < 4; ++ks) sc = __builtin_amdgcn_mfma_f32_16x16x32_bf16(qa[ks], *(const LAS bf16x8*)(Ks + (cb * 16 + tl) * LA_QS + ks * 32 + 8 * kg), sc, 0, 0, 0);
#pragma unroll
            for (int r = 0; r < 4; ++r) { const int dts = (16 * rb + kg * 4 + r) - (cb * 16 + tl);
                const float v = dts >= 0 ? sc[r] * fexp(lgam * (float)dts) : 0.f; Ps[(16 * rb + kg * 4 + r) * LA_PS + cb * 16 + tl] = (bf16_t)f2bf(v); }
        }
    } else {
        bf16x8 qw[4], q0[4];
#pragma unroll
        for (int ks = 0; ks < 4; ++ks) {
            const int kc = ks * 32 + 8 * kg;
            float bw[8];
            if (rb > 0) { const f32x4 a = *(const LAS f32x4*)(Bs + (16 * rb - 1) * LA_BS + kc), c = *(const LAS f32x4*)(Bs + (16 * rb - 1) * LA_BS + kc + 4);
                bw[0] = a.x; bw[1] = a.y; bw[2] = a.z; bw[3] = a.w; bw[4] = c.x; bw[5] = c.y; bw[6] = c.z; bw[7] = c.w; }
            else {
#pragma unroll
                for (int j = 0; j < 8; ++j) bw[j] = 0.f; }
            float q[8]; unpack8(*(const LAS u32x4*)(Qs + (16 * rb + tl) * LA_QS + kc), q);
            const f32x4 a = *(const LAS f32x4*)(Bs + (16 * rb + tl) * LA_BS + kc), c = *(const LAS f32x4*)(Bs + (16 * rb + tl) * LA_BS + kc + 4);
            const float bt[8] = {a.x, a.y, a.z, a.w, c.x, c.y, c.z, c.w};
            float x0[8], x1[8];
#pragma unroll
            for (int j = 0; j < 8; ++j) { x1[j] = q[j] * fexp(bt[j] - bw[j]); x0[j] = q[j] * fexp(bt[j]); }
            q0[ks] = pack8(x0); qw[ks] = pack8(x1);
        }
#pragma unroll
        for (int ks = 0; ks < 4; ++ks)
#pragma unroll
            for (int vb = 0; vb < 4; ++vb) acc1[vb] = __builtin_amdgcn_mfma_f32_16x16x32_bf16(q0[ks], *(const LAS bf16x8*)(STs + (vh * 64 + vb * 16 + tl) * LA_SS + ks * 32 + 8 * kg), acc1[vb], 0, 0, 0);
        for (int cb = 0; cb <= rb; ++cb) {
            f32x4 sc = (f32x4){0.f, 0.f, 0.f, 0.f};
            if (cb == rb) {
#pragma unroll
                for (int ks = 0; ks < 4; ++ks) {
                    const int kc = ks * 32 + 8 * kg;
                    float q[8]; unpack8(*(const LAS u32x4*)(Qs + (16 * rb + tl) * LA_QS + kc), q);
                    const f32x4 a = *(const LAS f32x4*)(Bs + (16 * rb + tl) * LA_BS + kc), c = *(const LAS f32x4*)(Bs + (16 * rb + tl) * LA_BS + kc + 4);
                    const f32x4 na = *(const LAS f32x4*)(Bs + (16 * rb + 15) * LA_BS + kc), nc = *(const LAS f32x4*)(Bs + (16 * rb + 15) * LA_BS + kc + 4);
                    const float bt[8] = {a.x, a.y, a.z, a.w, c.x, c.y, c.z, c.w}, bn[8] = {na.x, na.y, na.z, na.w, nc.x, nc.y, nc.z, nc.w};
#pragma unroll
                    for (int j = 0; j < 8; ++j) q[j] *= fexp(fminf(bt[j] - bn[j], 80.0f));
                    sc = __builtin_amdgcn_mfma_f32_16x16x32_bf16(pack8(q), *(const LAS bf16x8*)(Ks + (cb * 16 + tl) * LA_QS + kc), sc, 0, 0, 0);
                }
            } else {
#pragma unroll
                for (int ks = 0; ks < 4; ++ks) {
                    const int kc = ks * 32 + 8 * kg;
                    bf16x8 af;
                    if (cb == rb - 1) af = qw[ks];
                    else {
                        float q[8]; unpack8(*(const LAS u32x4*)(Qs + (16 * rb + tl) * LA_QS + kc), q);
                        const f32x4 a = *(const LAS f32x4*)(Bs + (16 * rb + tl) * LA_BS + kc), c = *(const LAS f32x4*)(Bs + (16 * rb + tl) * LA_BS + kc + 4);
                        const f32x4 ea = *(const LAS f32x4*)(Bs + (16 * cb + 15) * LA_BS + kc), ec = *(const LAS f32x4*)(Bs + (16 * cb + 15) * LA_BS + kc + 4);
                        const float bt[8] = {a.x, a.y, a.z, a.w, c.x, c.y, c.z, c.w}, be[8] = {ea.x, ea.y, ea.z, ea.w, ec.x, ec.y, ec.z, ec.w};
#pragma unroll
                        for (int j = 0; j < 8; ++j) q[j] *= fexp(bt[j] - be[j]);
                        af = pack8(q);
                    }
                    sc = __builtin_amdgcn_mfma_f32_16x16x32_bf16(af, *(const LAS bf16x8*)(Ks + (cb * 16 + tl) * LA_QS + kc), sc, 0, 0, 0);
                }
            }
#pragma unroll
            for (int r = 0; r < 4; ++r) { const float v = (cb < rb || tl <= kg * 4 + r) ? sc[r] : 0.f; Ps[(16 * rb + kg * 4 + r) * LA_PS + cb * 16 + tl] = (bf16_t)f2bf(v); }
        }
    }
    if ((rb & 1) == 0) {
#pragma unroll
        for (int r = 0; r < 4; ++r) Ps[(16 * rb + kg * 4 + r) * LA_PS + (rb + 1) * 16 + tl] = (bf16_t)0;
    }
    const int nks = (rb >> 1) + 1;
    for (int ks = 0; ks < nks; ++ks) {
        const bf16x8 a = *(const LAS bf16x8*)(Ps + (16 * rb + tl) * LA_PS + ks * 32 + 8 * kg);
#pragma unroll
        for (int vb = 0; vb < 4; ++vb) acc1[vb] = __builtin_amdgcn_mfma_f32_16x16x32_bf16(a, *(const LAS bf16x8*)(VT + (vh * 64 + vb * 16 + tl) * LA_VS + ks * 32 + 8 * kg), acc1[vb], 0, 0, 0);
    }
    float s1[4], s2[4];
#pragma unroll
    for (int r = 0; r < 4; ++r) { float a = 0.f, q = 0.f;
#pragma unroll
        for (int vb = 0; vb < 4; ++vb) { acc1[vb][r] *= 0.08838834764831845f; a += acc1[vb][r]; q += acc1[vb][r] * acc1[vb][r]; }
        a += sx<1>(a); a += sx<2>(a); a += sx<4>(a); a += sx<8>(a);
        q += sx<1>(q); q += sx<2>(q); q += sx<4>(q); q += sx<8>(q);
        s1[r] = a; s2[r] = q;
        if (tl == 0) { Xs[((16 * rb + kg * 4 + r) * 2 + vh) * 2] = a; Xs[((16 * rb + kg * 4 + r) * 2 + vh) * 2 + 1] = q; } }
    __syncthreads();
    const bf16_t* PROJ = (const bf16_t*)(pws(p) + WS_PROJ);
    bf16_t* OBm = (bf16_t*)(pws(p) + WS_OB) + (size_t)(m == 0 ? 0 : 2) * T * 512;
    const float* hnorm = (const float*)pin(p, I_HG_NORM) + l * 512 + h * 128;
#pragma unroll
    for (int r = 0; r < 4; ++r) {
        const int t = 16 * rb + kg * 4 + r; const size_t tok = (size_t)b * SEQ + (size_t)n * LA_C + t;
        const float a = s1[r] + Xs[(t * 2 + (vh ^ 1)) * 2], q = s2[r] + Xs[(t * 2 + (vh ^ 1)) * 2 + 1];
        float mu = 0.f, rs;
        if (m == 0) rs = frsq(q * (1.0f / 128.0f) + EPS);
        else { mu = a * (1.0f / 128.0f); rs = frsq(fmaxf(q * (1.0f / 128.0f) - mu * mu, 0.f) + EPS); }
#pragma unroll
        for (int vb = 0; vb < 4; ++vb) {
            const int v = vh * 64 + vb * 16 + tl;
            const float gt = bf2f(gatev[r][vb]);
            float o = (acc1[vb][r] - mu) * rs * siluf_(gt);
            if (m == 0) o *= hnorm[v];
            OBm[tok * 512 + h * 128 + v] = (bf16_t)f2bf(o);
        }
    }
    __syncthreads();
}

DI void mixer_post(const TC tc, PRM p, int l) {
    const bf16_t* PROJ = (const bf16_t*)(pws(p) + WS_PROJ);
    const float* OT = (const float*)(pws(p) + WS_OTMP);
    bf16_t* OB = (bf16_t*)(pws(p) + WS_OB); bf16_t* YS5 = (bf16_t*)(pws(p) + WS_YS5);
    const float* hnorm = (const float*)pin(p, I_HG_NORM) + l * 512; const float* s5d = (const float*)pin(p, I_S5_D) + l * 512;
    const int lane = tc.tid & 63, gw = tc.bid * 8 + (tc.tid >> 6), NGW = tc.nb * 8, c0 = lane * 8;
    for (int t = gw; t < T; t += NGW) {
        const bf16_t* prow = PROJ + (size_t)t * INC;
        if (!LA_HG) {
            float o[8], g[8], r[8];
            const f32x4 a = *(const f32x4*)(OT + (size_t)t * 512 + c0), bq = *(const f32x4*)(OT + (size_t)t * 512 + c0 + 4);
            o[0] = a.x; o[1] = a.y; o[2] = a.z; o[3] = a.w; o[4] = bq.x; o[5] = bq.y; o[6] = bq.z; o[7] = bq.w;
            float ss = 0.f;
#pragma unroll
            for (int j = 0; j < 8; ++j) ss += o[j] * o[j];
            ss += sx<8>(ss); ss += sx<4>(ss); ss += sx<2>(ss); ss += sx<1>(ss);
            const float sc = 1.0f / sqrtf(ss * (1.0f / 128.0f) + EPS);
            load8_bf16(prow + C_HGG + c0, g);
#pragma unroll
            for (int j = 0; j < 8; ++j) r[j] = o[j] * sc * hnorm[c0 + j] * siluf_(g[j]);
            store8_bf16(OB + (size_t)t * 512 + c0, r);
        }
        if (!LA_RT) {
            float o[8], g[8], r[8];
            const float* src = OT + (size_t)2 * T * 512 + (size_t)t * 512 + c0;
            const f32x4 a = *(const f32x4*)src, bq = *(const f32x4*)(src + 4);
            o[0] = a.x; o[1] = a.y; o[2] = a.z; o[3] = a.w; o[4] = bq.x; o[5] = bq.y; o[6] = bq.z; o[7] = bq.w;
            float s = 0.f;
#pragma unroll
            for (int j = 0; j < 8; ++j) s += o[j];
            s += sx<8>(s); s += sx<4>(s); s += sx<2>(s); s += sx<1>(s);
            const float mu = s * (1.0f / 128.0f);
            float q = 0.f;
#pragma unroll
            for (int j = 0; j < 8; ++j) { o[j] -= mu; q += o[j] * o[j]; }
            q += sx<8>(q); q += sx<4>(q); q += sx<2>(q); q += sx<1>(q);
            const float sc = 1.0f / sqrtf(q * (1.0f / 128.0f) + EPS);
            load8_bf16(prow + C_RTG + c0, g);
#pragma unroll
            for (int j = 0; j < 8; ++j) r[j] = o[j] * sc * siluf_(g[j]);
            store8_bf16(OB + (size_t)2 * T * 512 + (size_t)t * 512 + c0, r);
        }
    }
}

DI unsigned f2key(float x) { const unsigned u = __float_as_uint(x); return u ^ ((u >> 31) ? 0xffffffffu : 0x80000000u); }
DI float key2f(unsigned k) { const unsigned u = (k >> 31) ? (k ^ 0x80000000u) : ~k; return __uint_as_float(u); }
#define CE_DESC(a, b) do { const unsigned _x = (a), _y = (b); (a) = _x > _y ? _x : _y; (b) = _x > _y ? _y : _x; } while (0)
DI void sort16_desc(unsigned (&v)[16]) {
#pragma unroll
    for (int k = 2; k <= 16; k <<= 1)
#pragma unroll
        for (int j = k >> 1; j > 0; j >>= 1)
#pragma unroll
            for (int i = 0; i < 16; ++i) { const int q = i ^ j; if (q > i) { if ((i & k) == 0) CE_DESC(v[i], v[q]); else CE_DESC(v[q], v[i]); } }
}
DI void merge16_desc(unsigned (&r)[16], const unsigned (&g)[16]) {
#pragma unroll
    for (int i = 0; i < 16; ++i) r[i] = r[i] > g[15 - i] ? r[i] : g[15 - i];
#pragma unroll
    for (int j = 8; j > 0; j >>= 1)
#pragma unroll
        for (int i = 0; i < 16; ++i) if ((i & j) == 0) CE_DESC(r[i], r[i + j]);
}
DI void top16_of_128(const unsigned short* row, unsigned (&r)[16]) {
    u32x4 nx[2];
#pragma unroll
    for (int q = 0; q < 2; ++q) nx[q] = *(const u32x4*)(row + q * 8);
#pragma unroll 1
    for (int gi = 0; gi < 8; ++gi) {
        unsigned g[16];
        f32x4 cv[4];
#pragma unroll
        for (int q = 0; q < 2; ++q) { const u32x4 w = nx[q];
            cv[2 * q] = (f32x4){h2f((unsigned short)w.x), h2f((unsigned short)(w.x >> 16)), h2f((unsigned short)w.y), h2f((unsigned short)(w.y >> 16))};
            cv[2 * q + 1] = (f32x4){h2f((unsigned short)w.z), h2f((unsigned short)(w.z >> 16)), h2f((unsigned short)w.w), h2f((unsigned short)(w.w >> 16))}; }
        if (gi < 7) {
#pragma unroll
            for (int q = 0; q < 2; ++q) nx[q] = *(const u32x4*)(row + (gi + 1) * 16 + q * 8); }
#pragma unroll
        for (int q = 0; q < 4; ++q) { const f32x4 v = cv[q]; const unsigned ib = 127u - (unsigned)(gi * 16 + q * 4);
            g[q * 4 + 0] = (f2key(v.x) & ~127u) | ib; g[q * 4 + 1] = (f2key(v.y) & ~127u) | (ib - 1u); g[q * 4 + 2] = (f2key(v.z) & ~127u) | (ib - 2u); g[q * 4 + 3] = (f2key(v.w) & ~127u) | (ib - 3u); }
        sort16_desc(g);
        if (gi == 0) {
#pragma unroll
            for (int i = 0; i < 16; ++i) r[i] = g[i];
        } else merge16_desc(r, g);
    }
}
DI void peer_route(const TC tc, PRM p, LAS unsigned char* lds) {
    const unsigned short* SC = (const unsigned short*)(pws(p) + WS_SC);
    float* GATE = (float*)(pws(p) + WS_GATE);
    LAS unsigned short* li = (LAS unsigned short*)lds;
    for (int it = tc.bid * 512 + tc.tid; it < T * 8; it += tc.nb * 512) {
        unsigned r1[16], r2[16];
        top16_of_128(SC + (size_t)it * 256, r1);
        top16_of_128(SC + (size_t)it * 256 + 128, r2);
        float s1[16], s2[16];
#pragma unroll
        for (int i = 0; i < 16; ++i) { li[i * 512 + tc.tid] = (unsigned short)(127u - (r1[i] & 127u)); li[(16 + i) * 512 + tc.tid] = (unsigned short)(127u - (r2[i] & 127u));
            s1[i] = key2f(r1[i] & ~127u); s2[i] = key2f(r2[i] & ~127u); }
        unsigned best[16];
#pragma unroll
        for (int gi = 0; gi < 4; ++gi) {
            unsigned g[16];
#pragma unroll
            for (int q = 0; q < 16; ++q) {
                constexpr int CI[64] = {0,0,0,0,0,0,0,0,0,0,0,0,0,0,0,0, 1,1,1,1,1,1,1,1, 2,2,2,2,2, 3,3,3,3, 4,4,4, 5,5, 6,6, 7,7, 8,9,10,11,12,13,14,15, -1,-1,-1,-1,-1,-1,-1,-1,-1,-1,-1,-1,-1,-1};
                constexpr int CJ[64] = {0,1,2,3,4,5,6,7,8,9,10,11,12,13,14,15, 0,1,2,3,4,5,6,7, 0,1,2,3,4, 0,1,2,3, 0,1,2, 0,1, 0,1, 0,1, 0,0,0,0,0,0,0,0, 0,0,0,0,0,0,0,0,0,0,0,0,0,0};
                const int ci = CI[gi * 16 + q], cj = CJ[gi * 16 + q];
                g[q] = ci < 0 ? 0u : ((f2key(s1[ci < 0 ? 0 : ci] + s2[cj]) & ~255u) | (255u - (unsigned)((ci < 0 ? 0 : ci) * 16 + cj)));
            }
            sort16_desc(g);
            if (gi == 0) {
#pragma unroll
                for (int i = 0; i < 16; ++i) best[i] = g[i];
            } else merge16_desc(best, g);
        }
        float e[16], sum = 0.f; const float m0 = key2f(best[0] & ~255u);
        int ids[16];
#pragma unroll
        for (int s = 0; s < 16; ++s) { const unsigned pos = 255u - (best[s] & 255u); const int i1 = li[(pos >> 4) * 512 + tc.tid], i2 = li[(16 + (pos & 15u)) * 512 + tc.tid];
            ids[s] = i1 * 128 + i2; e[s] = fexp(key2f(best[s] & ~255u) - m0); sum += e[s]; }
        const float inv = frcp(sum);
#pragma unroll
        for (int s = 0; s < 16; s += 4) {
            *(u32x2*)((unsigned short*)(pws(p) + WS_IDX16) + (size_t)it * 16 + s) = (u32x2){(unsigned)ids[s] | ((unsigned)ids[s + 1] << 16), (unsigned)ids[s + 2] | ((unsigned)ids[s + 3] << 16)};
            *(f32x4*)(GATE + (size_t)it * 16 + s) = (f32x4){e[s] * inv, e[s + 1] * inv, e[s + 2] * inv, e[s + 3] * inv};
        }
    }
}

DI void peer_convert(const TC tc, PRM p, int l) {
    const float* U = (const float*)pin(p, I_PEER_U) + (size_t)l * NEXP * D; const float* V = (const float*)pin(p, I_PEER_V) + (size_t)l * NEXP * D;
    unsigned char* UB = pws(p) + WS_PEERU; unsigned char* VB = pws(p) + WS_PEERV; float* SCL = (float*)(pws(p) + WS_PEERS);
    const int lane = tc.tid & 63, gw = tc.bid * 8 + (tc.tid >> 6), NGW = tc.nb * 8;
    f32x4 nx[4], ny[4];
#pragma unroll
    for (int q = 0; q < 4; ++q) { nx[q] = (f32x4){0.f, 0.f, 0.f, 0.f}; ny[q] = nx[q]; }
    if (gw < 2 * NEXP) { const float* s = (gw < NEXP ? U + (size_t)gw * D : V + (size_t)(gw - NEXP) * D) + lane * 16;
#pragma unroll
        for (int q = 0; q < 4; ++q) nx[q] = __builtin_nontemporal_load((const f32x4*)(s + 4 * q)); }
    if (gw + NGW < 2 * NEXP) { const int rn = gw + NGW; const float* s = (rn < NEXP ? U + (size_t)rn * D : V + (size_t)(rn - NEXP) * D) + lane * 16;
#pragma unroll
        for (int q = 0; q < 4; ++q) ny[q] = __builtin_nontemporal_load((const f32x4*)(s + 4 * q)); }
    for (int r = gw; r < 2 * NEXP; r += NGW) {
        f32x4 v[4];
#pragma unroll
        for (int q = 0; q < 4; ++q) { v[q] = nx[q]; nx[q] = ny[q]; }
        { const int rn = r + 2 * NGW;
          if (rn < 2 * NEXP) { const float* s = (rn < NEXP ? U + (size_t)rn * D : V + (size_t)(rn - NEXP) * D) + lane * 16;
#pragma unroll
              for (int q = 0; q < 4; ++q) ny[q] = __builtin_nontemporal_load((const f32x4*)(s + 4 * q)); } }
        float am = 0.f;
#pragma unroll
        for (int q = 0; q < 4; ++q) am = fmaxf(fmaxf(am, fmaxf(fabsf(v[q].x), fabsf(v[q].y))), fmaxf(fabsf(v[q].z), fabsf(v[q].w)));
        am = fmaxf(wave_max(am), 1e-30f);
        int ex = 8 - (int)((__float_as_uint(am) >> 23) & 0xffu) + 127;
        ex = ex > 120 ? 120 : (ex < -120 ? -120 : ex);
        float sc = __uint_as_float((unsigned)(ex + 127) << 23);
        if (am * sc > 448.0f) sc *= 0.5f;
        u32x4 w;
        int t0 = 0, t1 = 0, t2 = 0, t3 = 0;
        t0 = __builtin_amdgcn_cvt_pk_fp8_f32(v[0].x * sc, v[0].y * sc, t0, false); t0 = __builtin_amdgcn_cvt_pk_fp8_f32(v[0].z * sc, v[0].w * sc, t0, true);
        t1 = __builtin_amdgcn_cvt_pk_fp8_f32(v[1].x * sc, v[1].y * sc, t1, false); t1 = __builtin_amdgcn_cvt_pk_fp8_f32(v[1].z * sc, v[1].w * sc, t1, true);
        t2 = __builtin_amdgcn_cvt_pk_fp8_f32(v[2].x * sc, v[2].y * sc, t2, false); t2 = __builtin_amdgcn_cvt_pk_fp8_f32(v[2].z * sc, v[2].w * sc, t2, true);
        t3 = __builtin_amdgcn_cvt_pk_fp8_f32(v[3].x * sc, v[3].y * sc, t3, false); t3 = __builtin_amdgcn_cvt_pk_fp8_f32(v[3].z * sc, v[3].w * sc, t3, true);
        w.x = (unsigned)t0; w.y = (unsigned)t1; w.z = (unsigned)t2; w.w = (unsigned)t3;
        *(u32x4*)((r < NEXP ? UB : VB) + (size_t)(lane >> 3) * ((size_t)NEXP * 128) + (size_t)(r < NEXP ? r : r - NEXP) * 128 + (lane & 7) * 16) = w;
        if (lane == 0) SCL[r] = 1.0f / sc;
    }
}
DI void unpack_fp8x16(const u32x4 w, float (&o)[16]) {
    typedef float f32x2 __attribute__((ext_vector_type(2)));
    const unsigned ww[4] = {w.x, w.y, w.z, w.w};
#pragma unroll
    for (int q = 0; q < 4; ++q) { const f32x2 a = __builtin_amdgcn_cvt_pk_f32_fp8((int)ww[q], false), b = __builtin_amdgcn_cvt_pk_f32_fp8((int)ww[q], true);
        o[4 * q] = a.x; o[4 * q + 1] = a.y; o[4 * q + 2] = b.x; o[4 * q + 3] = b.y; }
}
typedef __amdgpu_buffer_rsrc_t brsrc_t;
DI brsrc_t mk_rsrc(const void* base) { return __builtin_amdgcn_make_buffer_rsrc((void*)base, 0, 0x7fffffff, 0x00020000); }
DI u32x4 bld4(brsrc_t r, unsigned voff, unsigned soff, int imm) { return __builtin_amdgcn_raw_buffer_load_b128(r, (int)voff + imm, (int)soff, 0); }
DI u32x2 bld2(brsrc_t r, unsigned voff, unsigned soff, int imm) { return __builtin_amdgcn_raw_buffer_load_b64(r, (int)voff + imm, (int)soff, 0); }
DI long pu_op(unsigned lo, unsigned hi) { u32x2 w; w.x = lo; w.y = hi; return __builtin_bit_cast(long, w); }
struct PuG { u32x4 g[16]; };
DI void pu_issue(brsrc_t ru, unsigned soff, unsigned vc, const u32x4 (&id)[2], PuG& G) {
#pragma unroll
    for (int n = 0; n < 16; ++n) { const unsigned w = id[n >> 3][(n >> 1) & 3]; const unsigned e7 = (n & 1) ? ((w >> 9) & 0x7fff80u) : ((w << 7) & 0x7fff80u); G.g[n] = bld4(ru, e7 + vc, soff, 0); }
}
DI void peer_experts_u(const TC tc, PRM p, int l, LAS unsigned char* lds) {
    const unsigned short* IDX16 = (const unsigned short*)(pws(p) + WS_IDX16); float* GATE = (float*)(pws(p) + WS_GATE); const float* SCL = (const float*)(pws(p) + WS_PEERS);
    const brsrc_t ru = mk_rsrc(pws(p) + WS_PEERU), ri = mk_rsrc(pws(p) + WS_IDX16), rh = mk_rsrc(pws(p) + WS_HQ);
    const int lane = tc.tid & 63, r16 = lane & 15, kg = lane >> 4, r8 = lane >> 3, c8 = lane & 7, xs = rfl(tc.bid & 7);
    const int wv = rfl(tc.tid >> 6), gw = rfl(tc.bid * 8 + wv), NGW = rfl(tc.nb * 8);
    const unsigned vid = (unsigned)r8 * 32u, vc = (unsigned)c8 * 16u, vh = (unsigned)kg * 8u;
    LAS unsigned char* wl = lds + wv * 16384;
    LAS unsigned char* wp = wl + r8 * 128 + ((c8 ^ r8) << 4);
    LAS unsigned char* rp[4];
#pragma unroll
    for (int s = 0; s < 4; ++s) rp[s] = wl + r16 * 128 + (((2 * s + (kg >> 1)) ^ (r16 & 7)) << 4) + (kg & 1) * 8;
    for (int tb = gw; tb < T; tb += NGW * 8) {
        f32x4 ah[8], al[8];
#pragma unroll
        for (int i = 0; i < 8; ++i) { ah[i] = (f32x4){0.f, 0.f, 0.f, 0.f}; al[i] = (f32x4){0.f, 0.f, 0.f, 0.f}; }
#define PU_TOK(i) ((unsigned)((tb + (i) * NGW) < T ? (tb + (i) * NGW) : T - 1))
#define PU_IDS(dst, i) do { const unsigned _o = PU_TOK(i) * 256u; dst[0] = bld4(ri, vid, _o, 0); dst[1] = bld4(ri, vid, _o, 16); } while (0)
#define PU_H(dst1, dst2, i, sl) do { const unsigned _o = PU_TOK(i) * (unsigned)D + (unsigned)(sl) * 128u; _Pragma("unroll") for (int _s = 0; _s < 4; ++_s) { dst1[_s] = bld2(rh, vh, _o, 32 * _s); \
        dst2[_s] = PEER_LO ? bld2(rh, vh, _o + (unsigned)(T * D), 32 * _s) : dst1[_s]; } } while (0)
        PuG G; u32x4 idn[2]; u32x2 hc1[4], hc2[4], hn1[4], hn2[4];
        { PU_IDS(idn, 0); PU_H(hc1, hc2, 0, xs); pu_issue(ru, (unsigned)xs * (unsigned)(NEXP * 128), vc, idn, G); PU_IDS(idn, 1); }
#pragma unroll 1
        for (int js = 0; js < 8; ++js) {
            const int sl = (tc.nostore && PROBE_SEL == 7) ? xs : ((js + xs) & 7), sln = (tc.nostore && PROBE_SEL == 7) ? xs : ((js + 1 + xs) & 7);
            const unsigned so = (unsigned)sl * (unsigned)(NEXP * 128), son = (unsigned)sln * (unsigned)(NEXP * 128);
#pragma unroll
            for (int i = 0; i < 8; ++i) {
#pragma unroll
                for (int n = 0; n < 16; ++n) *(LAS u32x4*)(wp + n * 1024) = G.g[n];
                pu_issue(ru, i == 7 ? son : so, vc, idn, G);
                PU_IDS(idn, (i + 2) & 7);
                PU_H(hn1, hn2, (i + 1) & 7, i == 7 ? sln : sl);
#pragma unroll
                for (int mb = 0; mb < 8; ++mb) {
                    const bool sel = (r16 == mb);
#pragma unroll
                    for (int s = 0; s < 4; ++s) {
                        const long ao = *(const LAS long*)(rp[s] + mb * 2048);
                        ah[i] = __builtin_amdgcn_mfma_f32_16x16x32_fp8_fp8(ao, pu_op(sel ? hc1[s].x : 0u, sel ? hc1[s].y : 0u), ah[i], 0, 0, 0);
                        if (PEER_LO) al[i] = __builtin_amdgcn_mfma_f32_16x16x32_fp8_fp8(ao, pu_op(sel ? hc2[s].x : 0u, sel ? hc2[s].y : 0u), al[i], 0, 0, 0);
                        asm volatile("s_nop 7");
                    }
                }
#pragma unroll
                for (int s = 0; s < 4; ++s) { hc1[s] = hn1[s]; hc2[s] = hn2[s]; }
            }
        }
        asm volatile("s_nop 15\n\ts_nop 15");
        unsigned char* AQ = pws(p) + WS_AQ; float* ASC = (float*)(pws(p) + WS_ASC);
#pragma unroll
        for (int i = 0; i < 8; ++i) {
            const int t = tb + i * NGW; const int tl = t < T ? t : T - 1;
            float act[4];
#pragma unroll
            for (int r = 0; r < 4; ++r) {
                const size_t o = (size_t)tl * 128 + 64 * (kg & 1) + 16 * r + 2 * (r16 & 7) + (kg >> 1);
                const int e = (int)IDX16[o]; const float a = (ah[i][r] + (PEER_LO ? al[i][r] * 0.0625f : 0.f)) * 0.125f * SCL[e];
                act[r] = (r16 < 8) ? gelu_tanh(a) * GATE[o] * SCL[NEXP + e] : 0.f;
            }
            float am = fmaxf(wave_max(fmaxf(fmaxf(fabsf(act[0]), fabsf(act[1])), fmaxf(fabsf(act[2]), fabsf(act[3])))), 1e-30f);
            int ex = 8 - (int)((__float_as_uint(am) >> 23) & 0xffu) + 127; ex = ex > 120 ? 120 : (ex < -120 ? -120 : ex);
            float sc = __uint_as_float((unsigned)(ex + 127) << 23); if (am * sc > 448.0f) sc *= 0.5f;
            typedef float f32x2 __attribute__((ext_vector_type(2)));
            const unsigned q1 = fp8x4(act[0] * sc, act[1] * sc, act[2] * sc, act[3] * sc);
            const f32x2 d0 = __builtin_amdgcn_cvt_pk_f32_fp8((int)q1, false), d1 = __builtin_amdgcn_cvt_pk_f32_fp8((int)q1, true);
            const unsigned q2 = fp8x4((act[0] * sc - d0.x) * 16.0f, (act[1] * sc - d0.y) * 16.0f, (act[2] * sc - d1.x) * 16.0f, (act[3] * sc - d1.y) * 16.0f);
            if (t < T && r16 < 8 && (!tc.nostore || q1 == 0x12345678u)) {
                unsigned char* d = AQ + (size_t)t * 256 + (2 * (r16 & 1) + (kg >> 1)) * 32 + (r16 >> 1) * 8 + 4 * (kg & 1);
                *(unsigned*)d = q1; *(unsigned*)(d + 128) = q2;
                if (lane == 0) ASC[t] = 1.0f / sc;
            }
        }
#undef PU_TOK
#undef PU_IDS
#undef PU_H
    }
}
DI void peer_experts_v(const TC tc, PRM p, LAS unsigned char* lds) {
    typedef int i32x2_ __attribute__((ext_vector_type(2)));
    const brsrc_t rv = mk_rsrc(pws(p) + WS_PEERV), ri = mk_rsrc(pws(p) + WS_IDX16), ra = mk_rsrc(pws(p) + WS_AQ);
    const float* ASC = (const float*)(pws(p) + WS_ASC); float* X = pout(p);
    const int lane = tc.tid & 63, r16 = lane & 15, kg = lane >> 4, r8 = lane >> 3, c8 = lane & 7;
    const int xs = rfl(tc.bid & 7), rank = rfl(tc.bid >> 3), nrank = rfl(tc.nb >> 3), wv = rfl(tc.tid >> 6), tstep = nrank * 8;
    if (rank >= nrank) return;
    const unsigned vid = (unsigned)r8 * 32u, vc = (unsigned)c8 * 16u, va = (unsigned)(r16 & 1) * 128u + (unsigned)kg * 32u, so = (unsigned)xs * (unsigned)(NEXP * 128);
    LAS unsigned char* wl = lds + wv * 16384;
    LAS unsigned char* wp = wl + r8 * 128 + ((c8 ^ r8) << 4);
    LAS unsigned char* tp[8];
#pragma unroll
    for (int cb = 0; cb < 8; ++cb) tp[cb] = wl + (8 * kg + (r16 >> 1)) * 128 + ((cb ^ (r16 >> 1)) << 4) + 8 * (r16 & 1);
#define PV_IDS(dst, t) do { const unsigned _o = (unsigned)(t) * 256u; dst[0] = bld4(ri, vid, _o, 0); dst[1] = bld4(ri, vid, _o, 16); } while (0)
    int t = rank * 8 + wv;
    PuG G0, G1; u32x4 idn[2]; u32x4 aq0, aq1; float asc;
    if (t < T) { PV_IDS(idn, t); pu_issue(rv, so, vc, idn, G0); aq0 = bld4(ra, va, (unsigned)t * 256u, 0); aq1 = bld4(ra, va, (unsigned)t * 256u, 16); asc = ASC[t];
                 if (t + tstep < T) { PV_IDS(idn, t + tstep); pu_issue(rv, so, vc, idn, G1); }
                 if (t + 2 * tstep < T) PV_IDS(idn, t + 2 * tstep); }
#define PV_STEP(G, tt) do { \
        _Pragma("unroll") for (int n = 0; n < 16; ++n) *(LAS u32x4*)(wp + n * 1024) = G.g[n]; \
        const u32x4 ca0 = aq0, ca1 = aq1; const float casc = asc; \
        const int tn = (tt) + tstep, tn2 = (tt) + 2 * tstep; \
        if (tn2 < T) { pu_issue(rv, so, vc, idn, G); if (tn2 + tstep < T) PV_IDS(idn, tn2 + tstep); } \
        if (tn < T) { aq0 = bld4(ra, va, (unsigned)tn * 256u, 0); aq1 = bld4(ra, va, (unsigned)tn * 256u, 16); asc = ASC[tn]; } \
        float* xr = X + (size_t)(tt) * D + xs * 128 + r16; \
        float xv[8]; \
        if (kg == 0) { _Pragma("unroll") for (int cb = 0; cb < 8; ++cb) xv[cb] = xr[cb * 16]; } \
        const bool sel = r16 < 2; \
        long aop[4]; \
        aop[0] = pu_op(sel ? ca0.x : 0u, sel ? ca0.y : 0u); aop[1] = pu_op(sel ? ca0.z : 0u, sel ? ca0.w : 0u); \
        aop[2] = pu_op(sel ? ca1.x : 0u, sel ? ca1.y : 0u); aop[3] = pu_op(sel ? ca1.z : 0u, sel ? ca1.w : 0u); \
        f32x4 acc[8]; \
        _Pragma("unroll") for (int cb = 0; cb < 8; ++cb) { \
            acc[cb] = (f32x4){0.f, 0.f, 0.f, 0.f}; \
            _Pragma("unroll") for (int s = 0; s < 4; ++s) { \
                const i32x2_ bv = __builtin_amdgcn_ds_read_tr8_b64_v2i32((LAS i32x2_*)(tp[cb] + s * 4096)); \
                acc[cb] = __builtin_amdgcn_mfma_f32_16x16x32_fp8_fp8(aop[s], __builtin_bit_cast(long, bv), acc[cb], 0, 0, 0); } \
            asm volatile("s_nop 7"); } \
        asm volatile("s_nop 15\n\ts_nop 15"); \
        if (kg == 0 && (!tc.nostore || acc[0][0] == 12345.678f)) {        \
            _Pragma("unroll") for (int cb = 0; cb < 8; ++cb) xr[cb * 16] = xv[cb] + (acc[cb][0] + acc[cb][1] * 0.0625f) * casc; } \
    } while (0)
    for (; t < T; t += 2 * tstep) {
        PV_STEP(G0, t);
        if (t + tstep < T) PV_STEP(G1, t + tstep);
    }
#undef PV_STEP
#undef PV_IDS
}

constexpr int PH_PRO = 3, PH_MAX = 48;
struct Prog { GemmDesc d[PH_MAX]; int n; };
constexpr GemmDesc gd0() { GemmDesc g{}; g.nz = 1; g.scale = 1.0f; g.M = T; g.bA = B_WS; g.bB = B_WS; g.bC = B_WS; g.bE0 = B_WS; g.bE1 = B_WS; g.bE2 = B_WS; return g; }
constexpr Prog make_prog() {
    Prog P{};
    for (int ph = 0; ph < PH_MAX; ++ph) P.d[ph] = gd0();
    P.d[0].kind = K_INIT;
    {
        GemmDesc& g = P.d[1]; GemmDesc& g2 = P.d[PH_MAX - 2]; g.alt = PH_MAX - 2; g.split = 32;
        g.kind = K_GEMM; g.oA = WS_MEMN; g.lda = D; g.zA_lo = (long)NB * MEM * D; g.oB = WS_WKV_T; g.ldb = D; g.zB_lo = (long)2 * D * D; g.M = NB * MEM; g.N = 2 * D; g.K = D; g.nz = DEPTH;
        g.oC = WS_KVB; g.ldc = 2 * D; g.zC_lo = (long)NB * MEM * 2 * D; g.epi = E_BF16;
        g2.kind = K_GEMM; g2.oA = WS_KBD; g2.lda = 256; g2.zA_l = 8 * 65536; g2.zA_hi = 4 * 65536; g2.zA_lo = 65536;
        g2.oB = WS_PWQB; g2.ldb = 2048; g2.zB_l = (long)D * 2048; g2.zB_hi = 4 * 256; g2.zB_lo = 256; g2.M = 256; g2.N = D; g2.K = 256; g2.nz = 16;
        g2.oC = WS_WPK_T; g2.ldc = D; g2.zC_l = (long)2048 * D; g2.zC_hi = (long)4 * 256 * D; g2.zC_lo = (long)256 * D; g2.epi = E_BF16;
    }
    {
        GemmDesc& g = P.d[2]; GemmDesc& g2 = P.d[PH_MAX - 1]; g.alt = PH_MAX - 1; g.split = 128;
        g.kind = K_GEMM; g.oA = WS_KVB; g.lda = 2 * D; g.zA_l = (long)NB * MEM * 2 * D; g.zA_hi = (long)MEM * 2 * D; g.zA_lo = 256;
        g.oB = WS_WQB; g.ldb = D; g.zB_l = (long)D * D; g.zB_hi = 0; g.zB_lo = 256; g.M = 256; g.N = D; g.K = 256; g.nz = 16;
        g.oC = WS_WQK_T; g.ldc = D; g.zC_l = (long)2 * D * D; g.zC_hi = (long)D * D; g.zC_lo = (long)256 * D; g.epi = E_BF16; g.scale = 0.0625f;
        g2.kind = K_GEMM; g2.oA = WS_WOT; g2.lda = D; g2.zA_l = (long)D * D; g2.zA_hi = 0; g2.zA_lo = 256;
        g2.oB = WS_KVB + (size_t)D * 2; g2.ldb = 2 * D; g2.zB_l = (long)NB * MEM * 2 * D; g2.zB_hi = (long)MEM * 2 * D; g2.zB_lo = 256; g2.M = D; g2.N = 256; g2.K = 256; g2.nz = 16;
        g2.oC = WS_VWO_T; g2.ldc = D; g2.zC_l = (long)2 * D * D; g2.zC_hi = (long)D * D; g2.zC_lo = 256; g2.epi = E_BF16;
    }
    int n = PH_PRO;
    for (int l = 0; l < DEPTH; ++l) {
        const int base = n;
        for (int s = 0; s < 16; ++s) P.d[base + s].layer = l;
        { GemmDesc& g = P.d[base + 0]; g.kind = K_RMS; g.bA = (l == 0 ? (int)I_X : (int)B_OUT); g.bB = I_NORM_MIX; g.oB = (long)l * D * 4; g.oC = WS_HN; g.epi = E_BF16; }
        { GemmDesc& g = P.d[base + 1]; g.kind = K_GEMM; g.oA = WS_HN; g.lda = D; g.oB = WS_WIN_T + (size_t)l * INC * D * 2; g.ldb = D; g.N = INC; g.K = D; g.oC = WS_PROJ; g.ldc = INC; g.epi = E_BF16; }
        P.d[base + 2].kind = K_MIX1;
        P.d[base + 3].kind = K_MIX2;
        P.d[base + 4].kind = K_MIX3;
        { GemmDesc& g = P.d[base + 5]; g.kind = K_GEMM; g.oA = WS_YS5; g.lda = 512; g.oB = WS_WGLU_T + (size_t)l * 512 * 512 * 2; g.ldb = 512; g.N = 512; g.K = 512;
          g.oC = WS_OB + (size_t)1 * T * 512 * 2; g.ldc = 512; g.epi = E_GLU; g.bE0 = I_S5_BGLU; g.oE0 = (long)l * 512 * 4; }
        { GemmDesc& g = P.d[base + 6];
          g.kind = K_GEMM; g.oA = WS_OB; g.lda = 512; g.zA_lo = (long)T * 512; g.oB = WS_WBR_T + (size_t)(l * 3) * D * 512 * 2; g.ldb = 512; g.zB_lo = (long)D * 512; g.N = D; g.K = 512; g.nz = 3; g.zinner = 1;
          g.oC = WS_MRG; g.ldc = D; g.epi = E_BRZ; g.oE0 = WS_PROJ + (size_t)C_GATE * 2; g.bE1 = I_B_GATE; g.oE1 = (long)(l * 3 * D) * 4; g.oE2 = WS_MF32; }
        { GemmDesc& g = P.d[base + 7]; g.kind = K_GEMM; g.oA = WS_MRG; g.lda = D; g.oB = WS_WOUT_T + (size_t)l * D * D * 2; g.ldb = D; g.N = D; g.K = D; g.bC = B_OUT; g.ldc = D; g.epi = E_ADDX; g.bE0 = (l == 0 ? (int)I_X : (int)B_OUT); g.oE0 = 0;   }
        { GemmDesc& g = P.d[base + 8]; g.kind = K_RMS; g.bA = B_OUT; g.bB = I_NORM_CROSS; g.oB = (long)l * D * 4; g.oC = WS_HN; g.epi = E_BF16; g.nz = 2;   }
        { GemmDesc& g = P.d[base + 9];
          g.kind = K_GEMM; g.oA = WS_HN; g.lda = D; g.zA_lo = (long)SEQ * D; g.oB = WS_WQK_T + (size_t)l * 2 * D * D * 2; g.ldb = D; g.zB_lo = (long)D * D; g.M = SEQ; g.N = D; g.K = D; g.nz = NB;
          g.oC = WS_P; g.ldc = D; g.zC_lo = (long)SEQ * D; g.epi = E_SOFTMAX; }
        { GemmDesc& g = P.d[base + 10];
          g.kind = K_GEMM; g.oA = WS_P; g.lda = D; g.zA_lo = (long)SEQ * D; g.oB = WS_VWO_T + (size_t)l * 2 * D * D * 2; g.ldb = D; g.zB_lo = (long)D * D; g.M = SEQ; g.N = D; g.K = D; g.nz = NB;
          g.bC = B_OUT; g.ldc = D; g.zC_lo = (long)SEQ * D; g.epi = E_ADDX; g.bE0 = B_OUT; g.oE0 = 0; }
        { GemmDesc& g = P.d[base + 11]; g.kind = K_RMS; g.bA = B_OUT; g.bB = I_NORM_FFN; g.oB = (long)l * D * 4; g.oC = WS_HN; g.epi = E_BF16; g.nz = 3;   }
        { GemmDesc& g = P.d[base + 12]; g.kind = K_GEMM; g.oA = WS_HN; g.lda = D; g.oB = WS_WPK_T + (size_t)l * 2048 * D * 2; g.ldb = D; g.N = 2048; g.K = D; g.oC = WS_SC; g.ldc = 2048; g.epi = E_F16; }
        P.d[base + 13].kind = K_ROUTE;
        P.d[base + 14].kind = K_EXPERTS;
        P.d[base + 15].kind = K_EXPERTS_V;
        n = base + 16;
    }
    { GemmDesc& g = P.d[n]; g.kind = K_RMS; g.bA = B_OUT; g.bB = I_NORM_FINAL; g.bC = B_OUT; g.epi = E_F32; g.M = T; ++n; }
    P.n = n;
    return P;
}
__constant__ Prog PROG = make_prog();
constexpr int NPH = make_prog().n;

DI void init_phase(const TC tc, PRM p, unsigned char* lds) {
        unsigned char* ws = pws(p); float* X = pout(p);
        prep_weights(tc, p, (LAS unsigned char*)lds);
        {
            const int* pos = (const int*)pin(p, I_POS); float* rt = (float*)(ws + WS_ROPE);
            for (int i = tc.bid * 512 + tc.tid; i < T * 64; i += tc.nb * 512) { const int tok = i >> 6, d = i & 63;
                const float ang = (float)pos[tok] * powf(10000.0f, -(float)d * (1.0f / 64.0f)); float sn, cs; sincosf(ang, &sn, &cs); rt[(size_t)tok * 128 + d] = cs; rt[(size_t)tok * 128 + 64 + d] = sn; }
        }
        {
            float* tb = (float*)(ws + WS_TAB);
            for (int i = tc.bid * 512 + tc.tid; i < DEPTH * 32 * 64; i += tc.nb * 512) s5_disc_init(p, i, tb + (size_t)i * 4);
            {
                bf16_t* bbf = (bf16_t*)(ws + WS_TAB + 256 * 1024); bf16_t* cmf = (bf16_t*)(ws + WS_TAB + 512 * 1024);
                const float* Bre = (const float*)pin(p, I_S5_BRE); const float* Bim = (const float*)pin(p, I_S5_BIM); const float* Cre = (const float*)pin(p, I_S5_CRE); const float* Cim = (const float*)pin(p, I_S5_CIM);
                for (int i = tc.bid * 512 + tc.tid; i < DEPTH * 32 * 128 * 16; i += tc.nb * 512) {
                    const int c = i & 15, n = (i >> 4) & 127, lg = i >> 11, ri = n >> 6, pp = n & 63;
                    float d4[4]; s5_disc_init(p, lg * 64 + pp, d4);
                    const float br = Bre[((size_t)lg * 64 + pp) * 16 + c], bi = Bim[((size_t)lg * 64 + pp) * 16 + c];
                    bbf[i] = (bf16_t)f2bf(ri == 0 ? d4[2] * br - d4[3] * bi : d4[2] * bi + d4[3] * br);
                    const int c2 = i >> 7 & 15, k2 = i & 127, lg2 = i >> 11, ri2 = k2 >> 6, p2 = k2 & 63;
                    cmf[i] = (bf16_t)f2bf(ri2 == 0 ? Cre[((size_t)lg2 * 16 + c2) * 64 + p2] : -Cim[((size_t)lg2 * 16 + c2) * 64 + p2]);
                }
            }
            const float* hl = (const float*)pin(p, I_HG_LB);
            for (int i = tc.bid * 512 + tc.tid; i < 512; i += tc.nb * 512) { const float a0 = hl[i], a1 = hl[512 + i], mx = fmaxf(a0, a1), e0 = expf(a0 - mx), e1 = expf(a1 - mx);
                tb[16384 + i] = 0.f; tb[16384 + 512 + i] = e1 / (e0 + e1); }
            if (tc.bid == 0 && tc.tid < 4) tb[16384 + 1024 + tc.tid] = log1pf(-exp2f(-5.0f - (float)tc.tid));
        }
        rms_rows(tc, (const float*)pin(p, I_MEM), (const float*)pin(p, I_NORM_MEM), (bf16_t*)(ws + WS_MEMN), nullptr, NB * MEM);
        rms_rows(tc, (const float*)pin(p, I_MEM), (const float*)pin(p, I_NORM_MEM) + D, (bf16_t*)(ws + WS_MEMN) + (size_t)NB * MEM * D, nullptr, NB * MEM);
    }

DI void run_phase(const TC tc, PRM p, int ph, unsigned char* lds, LAS unsigned char* lds_raw) {
    const GemmDesc& g = PROG.d[ph];
    const int kind = g.kind, l = g.layer;
    if (kind == K_GEMM) {
        const int alt = g.alt, split = g.split < tc.nb ? g.split : tc.nb / 2; const bool second = alt != 0 && tc.bid >= split;
        const GemmDesc& gg = PROG.d[rfl(second ? alt : ph)];
        TC t2 = tc; t2.bid = second ? tc.bid - split : tc.bid; t2.nb = alt != 0 ? (second ? tc.nb - split : split) : tc.nb;
        mgemm(t2, p, gg, (LAS unsigned char*)lds, lds_raw);
    }
    else if (kind == K_RMS) { rms_rows(tc, GPTR(const float*, bA, oA), GPTR(const float*, bB, oB), g.epi == E_BF16 ? GPTR(bf16_t*, bC, oC) : nullptr, g.epi == E_F32 ? GPTR(float*, bC, oC) : nullptr, g.M, g.nz == 3 ? pws(p) + WS_HQ : nullptr);
        if (g.nz == 2) peer_convert(tc, p, l); }
    else if (kind == K_MIX1) {
        constexpr int N_S5 = NB * 32 * S5_NCH / 8;
        for (int it = tc.bid; it < N_S5; it += tc.nb) s5_chunk_mfma<1>(tc, p, l, it * 8 + (tc.tid >> 6), (LAS unsigned char*)lds);
        __syncthreads();
        LaPreA pre; int it = tc.bid;
        if (it < LA_ITEMS) laA_issue(tc, p, it, pre);
        for (; it < LA_ITEMS; it += tc.nb) { const int nx = it + tc.nb; la_phaseA(tc, p, l, it, pre, nx < LA_ITEMS ? nx : -1, (LAS unsigned char*)lds); }
    }
    else if (kind == K_MIX2) { s5_scan(tc, p, l); la_scan(tc, p); }
    else if (kind == K_MIX3) {
        constexpr int N_S5 = NB * 32 * S5_NCH / 8;
        if (!(tc.nostore && PROBE_SEL == 1)) for (int it = tc.bid; it < N_S5; it += tc.nb) s5_chunk_mfma<3>(tc, p, l, it * 8 + (tc.tid >> 6), (LAS unsigned char*)lds);
        __syncthreads();
        if (!(tc.nostore && PROBE_SEL == 2)) {
            LaPreC pre; int it = tc.bid;
            if (it < LA_ITEMS) laC_issue(tc, p, it, pre);
            for (; it < LA_ITEMS; it += tc.nb) { const int nx = it + tc.nb; la_phaseC(tc, p, l, it, pre, nx < LA_ITEMS ? nx : -1, (LAS unsigned char*)lds); }
        }
    }
    else if (kind == K_ROUTE) peer_route(tc, p, (LAS unsigned char*)lds);
    else if (kind == K_EXPERTS) peer_experts_u(tc, p, l, (LAS unsigned char*)lds);
    else if (kind == K_EXPERTS_V) peer_experts_v(tc, p, (LAS unsigned char*)lds);

}

__global__ void __launch_bounds__(512, 2) mega(Params p) {
    extern __shared__ __attribute__((aligned(16))) unsigned char lds[];
    {
        volatile LAS unsigned* MISC = (volatile LAS unsigned*)((LAS unsigned char*)lds + LDS_BYTES - 64);
        if (threadIdx.x < 16) MISC[threadIdx.x] = 0u;
        LAS Params* lp = (LAS Params*)((LAS unsigned char*)lds + LDS_BYTES - 1024);
        if (threadIdx.x == 0) {
#pragma unroll
            for (int i = 0; i < 31; ++i) lp->in[i] = p.in[i];
            lp->out = p.out; lp->ws = p.ws; lp->lo = p.lo; lp->hi = p.hi;
        }
        __syncthreads();
        if (p.hi - p.lo > 1 && threadIdx.x == 0) (void)xb_add((unsigned*)(p.ws + WS_CTL) + 4096 + XB_XCNT(xb_xcc_id()), 1u);
    }
    int hi = rfl(p.hi), ph = rfl(p.lo);
    if (ph == 0) {
        TC tc; tc.tid = threadIdx.x; tc.bid = blockIdx.x; tc.nb = gridDim.x; tc.nostore = 0;
        PRM lp0 = *(LAS Params*)((LAS unsigned char*)lds + LDS_BYTES - 1024);
        init_phase(tc, lp0, lds);
        if (hi > 1) { XcdBarrier b0; b0.bar = (unsigned*)(pws(lp0) + WS_CTL) + 4096; b0.x = xb_xcc_id(); b0.st = (volatile LAS unsigned*)((LAS unsigned char*)lds + LDS_BYTES - 64); xcd_barrier(b0); }
        ph = 1;
    }
    int wave_s = __builtin_amdgcn_readfirstlane(threadIdx.x >> 6);
    int dup = 0;
    for (; ph < hi; ph = rfl(ph + ((PROBE_MASK != 0ull && ((PROBE_MASK >> ph) & 1ull) && dup < PROBE_REP) ? (++dup, 0) : (dup = 0, 1)))) {
        unsigned ones = ~0u; asm volatile("" : "+s"(ones), "+s"(hi), "+s"(ph), "+s"(wave_s));
        TC tc; tc.tid = wave_s * 64 + (int)__builtin_amdgcn_mbcnt_hi(ones, __builtin_amdgcn_mbcnt_lo(ones, 0u)); tc.bid = blockIdx.x; tc.nb = gridDim.x;
        tc.nostore = (PROBE_MASK != 0ull && ((PROBE_MASK >> ph) & 1ull) && dup < PROBE_REP) ? 1 : 0;
        asm volatile("" : "+v"(tc.tid), "+s"(tc.bid), "+s"(tc.nb));
        int lz = 0; asm volatile("" : "+v"(lz));
        LAS unsigned char* L = (LAS unsigned char*)lds + lz;
        PRM lp = *(LAS Params*)(L + LDS_BYTES - 1024);
        run_phase(tc, lp, rfl(ph), (unsigned char*)L, (LAS unsigned char*)lds);
        if (ph + 1 < hi) {
            XcdBarrier b2; b2.bar = (unsigned*)(pws(lp) + WS_CTL) + 4096; b2.x = xb_xcc_id(); b2.st = (volatile LAS unsigned*)(L + LDS_BYTES - 64);
            xcd_barrier(b2);
#if PROBE_BAR
            if (ph == PROBE_BAR) for (int k = 0; k < 10; ++k) xcd_barrier(b2);
#endif
        }
    }
}

extern "C" void kernel_launch(void* const* d_in, const int* in_sizes, int n_in, void* d_out, int out_size, void* d_ws, size_t ws_size, hipStream_t stream) {
    static int grid = 0;
    if (grid == 0) {
        if (n_in != 31 || out_size != T * D || ws_size < WS_END) { fprintf(stderr, "kernel_launch: unexpected shapes n_in %d out %d ws %zu (need %zu)\n", n_in, out_size, ws_size, (size_t)WS_END); grid = -1; return; }
        int dev = 0, cus = 0;
        if (hipGetDevice(&dev) != hipSuccess || hipDeviceGetAttribute(&cus, hipDeviceAttributeMultiprocessorCount, dev) != hipSuccess) { grid = -1; return; }
        if (hipFuncSetAttribute((const void*)mega, hipFuncAttributeMaxDynamicSharedMemorySize, LDS_BYTES) != hipSuccess) { fprintf(stderr, "kernel_launch: hipFuncSetAttribute failed\n"); grid = -1; return; }
        int per_cu = 0;
        if (hipOccupancyMaxActiveBlocksPerMultiprocessor(&per_cu, (const void*)mega, 512, LDS_BYTES) != hipSuccess || per_cu < 1) fprintf(stderr, "kernel_launch: occupancy query says %d\n", per_cu);
        (void)hipGetLastError();
        grid = cus;
    }
    if (grid < 0) return;
    (void)hipMemsetAsync((char*)d_ws + WS_CTL, 0, 32768, stream);
    Params p{};
    for (int i = 0; i < 31; ++i) p.in[i] = d_in[i];
    p.out = (float*)d_out; p.ws = (unsigned char*)d_ws;
#if ONE_LAUNCH
    p.lo = 0; p.hi = NPH;
    hipLaunchKernelGGL(mega, dim3(grid), dim3(512), LDS_BYTES, stream, p);
#else
    for (int ph = 0; ph < NPH; ++ph) { p.lo = ph; p.hi = ph + 1; hipLaunchKernelGGL(mega, dim3(grid), dim3(512), LDS_BYTES, stream, p); }
#endif
}
```

```cpp
#include <hip/hip_runtime.h>
#include <stdint.h>
#include <stdio.h>

#ifndef LA_HG
#define LA_HG 1
#endif
#ifndef LA_RT
#define LA_RT 1
#endif
#ifndef PEER_LO
#define PEER_LO 0
#endif
#ifndef PROBE_MASK
#define PROBE_MASK 0ull
#endif
#ifndef PROBE_REP
#define PROBE_REP 1
#endif
#ifndef PROBE_BAR
#define PROBE_BAR 0
#endif
#ifndef PROBE_SEL
#define PROBE_SEL 0
#endif
#ifndef ONE_LAUNCH
#define ONE_LAUNCH 1
#endif

typedef unsigned short bf16_t;
typedef float f32x4 __attribute__((ext_vector_type(4)));
typedef unsigned u32x4 __attribute__((ext_vector_type(4)));
typedef unsigned u32x2 __attribute__((ext_vector_type(2)));
#define DI __device__ __forceinline__
#define LAS __attribute__((address_space(3)))

constexpr int NB = 2, SEQ = 8192, T = NB * SEQ, D = 1024, DEPTH = 2;
constexpr int INC = 7680;
constexpr int C_HGQ = 0, C_HGF = 512, C_HGI = 1024, C_HGG = 1536, C_S5U = 2048, C_RTQ = 2560, C_RTK = 3072, C_RTV = 3584, C_RTG = 4096, C_GATE = 4608;
constexpr int MEM = 256, NEXP = 16384;
constexpr float EPS = 1e-6f;

constexpr size_t MiB = 1u << 20;
constexpr size_t WS_CTL = 0, CTL_BYTES = 1 * MiB;
constexpr size_t WS_HN = 1 * MiB;
constexpr size_t WS_OB = 33 * MiB;
constexpr size_t WS_YS5 = 81 * MiB;
constexpr size_t WS_WIN_T = 97 * MiB;
constexpr size_t WS_WBR_T = 127 * MiB;
constexpr size_t WS_WOUT_T = 133 * MiB;
constexpr size_t WS_WGLU_T = 137 * MiB;
constexpr size_t WS_WPK_T = 138 * MiB;
constexpr size_t WS_WQK_T = 146 * MiB;
constexpr size_t WS_VWO_T = 154 * MiB;
constexpr size_t WS_R = 162 * MiB;
constexpr size_t WS_PROJ = WS_R;
constexpr size_t WS_OTMP = WS_R + 240 * MiB;
constexpr size_t WS_LAST = WS_OTMP;
constexpr size_t WS_LADEC = WS_R + 344 * MiB;
constexpr size_t WS_S5X = WS_R + 345 * MiB;
constexpr size_t WS_MF32 = WS_OTMP;
constexpr size_t WS_MRG = WS_OTMP + 64 * MiB;
constexpr size_t WS_RQ = WS_OTMP + 64 * MiB;
constexpr size_t WS_RK = WS_OTMP + 80 * MiB;
constexpr size_t WS_MEMN = WS_R;
constexpr size_t WS_WKV_T = WS_R + 2 * MiB;
constexpr size_t WS_WOT = WS_R + 10 * MiB;
constexpr size_t WS_WQB = WS_R + 14 * MiB;
constexpr size_t WS_PWQB = WS_R + 18 * MiB;
constexpr size_t WS_KBD = WS_R + 26 * MiB;
constexpr size_t WS_KVB = WS_R + 28 * MiB;
constexpr size_t WS_P = WS_R;
constexpr size_t WS_SC = WS_R;
constexpr size_t WS_PEERU = WS_R + 176 * MiB;
constexpr size_t WS_PEERV = WS_R + 192 * MiB;
constexpr size_t WS_PEERS = WS_R + 208 * MiB;
constexpr size_t WS_HQ = WS_R + 128 * MiB;
constexpr size_t WS_AQ = WS_R + 210 * MiB;
constexpr size_t WS_ASC = WS_R + 216 * MiB;
constexpr size_t WS_IDX16 = WS_R + 218 * MiB;
constexpr size_t WS_IDX = WS_R + 160 * MiB;
constexpr size_t WS_GATE = WS_R + 168 * MiB;
constexpr size_t WS_ROPE = WS_R + 336 * MiB;
constexpr size_t WS_TAB = WS_R + 347 * MiB;
constexpr size_t WS_END = WS_ROPE + 12 * MiB;

constexpr int LDS_BYTES = 147456;
constexpr int LDS_GD = 131072 + 8192;

DI float bf2f(bf16_t v) { return __uint_as_float((unsigned)v << 16); }
DI float bflo(unsigned w) { return __uint_as_float(w << 16); }
DI float bfhi(unsigned w) { return __uint_as_float(w & 0xffff0000u); }
DI unsigned f2bf(float f) { unsigned u = __float_as_uint(f); return (u + 0x7fffu + ((u >> 16) & 1u)) >> 16; }
typedef float f32x2_ __attribute__((ext_vector_type(2)));
typedef __bf16 bf16x2_ __attribute__((ext_vector_type(2)));
DI unsigned pk2(float lo, float hi) { const f32x2_ v = {lo, hi}; return __builtin_bit_cast(unsigned, __builtin_convertvector(v, bf16x2_)); }
template <int M> DI float sx(float v) { return __int_as_float(__builtin_amdgcn_ds_swizzle(__float_as_int(v), (M << 10) | 0x1f)); }
DI void halves(float v, float& lo, float& hi) { const auto r = __builtin_amdgcn_permlane32_swap(__float_as_uint(v), __float_as_uint(v), false, false); lo = __uint_as_float(r[0]); hi = __uint_as_float(r[1]); }
DI float wave_sum(float v) { v += sx<1>(v); v += sx<2>(v); v += sx<4>(v); v += sx<8>(v); v += sx<16>(v); float lo, hi; halves(v, lo, hi); return lo + hi; }
DI float wave_max(float v) { v = fmaxf(v, sx<1>(v)); v = fmaxf(v, sx<2>(v)); v = fmaxf(v, sx<4>(v)); v = fmaxf(v, sx<8>(v)); v = fmaxf(v, sx<16>(v)); float lo, hi; halves(v, lo, hi); return fmaxf(lo, hi); }
DI float fexp(float x) { return __builtin_amdgcn_exp2f(x * 1.4426950408889634f); }
DI float flog(float x) { return __builtin_amdgcn_logf(x) * 0.6931471805599453f; }
DI float frcp(float x) { return __builtin_amdgcn_rcpf(x); }
DI float frsq(float x) { return __builtin_amdgcn_rsqf(x); }
DI float sigmoidf_(float x) { return frcp(1.0f + fexp(-x)); }
DI float siluf_(float x) { return x * frcp(1.0f + fexp(-x)); }
DI float gelu_tanh(float x) { const float u = 0.7978845608028654f * (x + 0.044715f * x * x * x); return x - x * frcp(1.0f + fexp(2.0f * u)); }

#define XB_TMO      128
#define XB_XCNT(j)  (256  + 64 * (j))
#define XB_XSUB(j)  (1280 + 64 * (j))
#define XB_XGEN(j)  (2304 + 64 * (j))
#define XB_TOP      3328
#define XB_TOPGEN   3392
#define XCD_BAR_WORDS 3456
#define XB_SPIN_CAP (1u << 22)
DI unsigned xb_ld(unsigned* p) { return __hip_atomic_load(p, __ATOMIC_RELAXED, __HIP_MEMORY_SCOPE_AGENT); }
DI unsigned xb_add(unsigned* p, unsigned v) { return __hip_atomic_fetch_add(p, v, __ATOMIC_RELAXED, __HIP_MEMORY_SCOPE_AGENT); }
DI unsigned xb_xcc_id() { return (unsigned)__builtin_amdgcn_s_getreg((3 << 11) | 20) & 0xFu; }
#define XB_SPIN(cond, bar) do { unsigned _sp = 0; while (cond) { __builtin_amdgcn_s_sleep(1); \
    if ((++_sp & 255u) == 0u) { if (xb_ld(&(bar)[XB_TMO])) break; if (_sp > XB_SPIN_CAP) { atomicAdd(&(bar)[XB_TMO], 1u); break; } } } } while (0)
struct XcdBarrier { unsigned* bar; unsigned x; volatile LAS unsigned* st; };
DI XcdBarrier xcd_barrier_post(unsigned* bar, volatile LAS unsigned* st) {
    XcdBarrier b; b.bar = bar; b.x = xb_xcc_id(); b.st = st;
    if (threadIdx.x == 0) (void)xb_add(&bar[XB_XCNT(b.x)], 1u);
    return b;
}
DI void xcd_barrier_complete(unsigned* bar, unsigned x, unsigned& nloc, unsigned& nx) {
    const unsigned G = gridDim.x * gridDim.y * gridDim.z;
    unsigned sum, cnt, mine, sp = 0u;
    for (;;) {
        sum = 0u; cnt = 0u; mine = 0u;
#pragma unroll
        for (unsigned j = 0; j < 16; ++j) { const unsigned c = xb_ld(&bar[XB_XCNT(j)]); sum += c; cnt += (c > 0u) ? 1u : 0u; mine = (j == x) ? c : mine; }
        if (sum == G) break;
        __builtin_amdgcn_s_sleep(1);
        if ((++sp & 255u) == 0u) { if (xb_ld(&bar[XB_TMO])) break; if (sp > XB_SPIN_CAP) { atomicAdd(&bar[XB_TMO], 1u); break; } }
    }
    nloc = mine > 0u ? mine : 1u; nx = cnt > 0u ? cnt : 1u;
}
DI void xcd_barrier(const XcdBarrier& b) {
    asm volatile("s_waitcnt vmcnt(0)" ::: "memory");
    __syncthreads();
    if (threadIdx.x == 0) {
        unsigned* bar = b.bar;
        __builtin_amdgcn_s_waitcnt(0);
        unsigned nloc = b.st[0], nx = b.st[1];
        if (nloc == 0u) { xcd_barrier_complete(bar, b.x, nloc, nx); b.st[0] = nloc; b.st[1] = nx; }
        const unsigned old = xb_add(&bar[XB_XSUB(b.x)], 1u);
        const unsigned gen = old / nloc;
        if (old + 1u == (gen + 1u) * nloc) {
            __builtin_amdgcn_fence(__ATOMIC_RELEASE, "agent");
            asm volatile("s_waitcnt vmcnt(0)" ::: "memory");
            __builtin_amdgcn_fence(__ATOMIC_ACQUIRE, "agent");
            const unsigned og = xb_add(&bar[XB_TOP], 1u);
            const unsigned tg = og / nx;
            if (og + 1u == (tg + 1u) * nx) xb_add(&bar[XB_TOPGEN], 1u);
            else XB_SPIN(xb_ld(&bar[XB_TOPGEN]) == tg, bar);
            asm volatile("s_waitcnt vmcnt(0)" ::: "memory");
            xb_add(&bar[XB_XGEN(b.x)], 1u);
            asm volatile("s_waitcnt vmcnt(0)" ::: "memory");
        } else {
            __builtin_amdgcn_fence(__ATOMIC_ACQUIRE, "agent");
            XB_SPIN(xb_ld(&bar[XB_XGEN(b.x)]) == gen, bar);
            asm volatile("s_waitcnt vmcnt(0)" ::: "memory");
        }
    }
    __syncthreads();
}

struct Params { const void* in[31]; float* out; unsigned char* ws; int lo, hi; };
typedef const LAS Params& PRM;
DI unsigned long long rfl64(unsigned long long v) { const unsigned lo = __builtin_amdgcn_readfirstlane((unsigned)v), hi = __builtin_amdgcn_readfirstlane((unsigned)(v >> 32)); return ((unsigned long long)hi << 32) | lo; }
DI int rfl(int v) { return __builtin_amdgcn_readfirstlane(v); }
#define GLOBAL_AS __attribute__((address_space(1)))
DI const void* pin(PRM p, int i) { return (const void*)(const GLOBAL_AS char*)rfl64((unsigned long long)p.in[i]); }
DI unsigned char* pws(PRM p) { return (unsigned char*)(GLOBAL_AS unsigned char*)rfl64((unsigned long long)p.ws); }
DI float* pout(PRM p) { return (float*)(GLOBAL_AS float*)rfl64((unsigned long long)p.out); }

enum { I_X = 0, I_MEM, I_POS, I_NORM_MIX, I_W_IN, I_B_GATE, I_HG_LB, I_HG_NORM, I_S5_LRE, I_S5_LIM, I_S5_LOGSTEP, I_S5_BRE, I_S5_BIM, I_S5_CRE, I_S5_CIM,
       I_S5_D, I_S5_WGLU, I_S5_BGLU, I_W_BRANCH, I_W_OUT, I_NORM_CROSS, I_NORM_MEM, I_XA_WQ, I_XA_WKV, I_XA_WO, I_NORM_FFN, I_PEER_WQ, I_PEER_KEYS,
       I_PEER_U, I_PEER_V, I_NORM_FINAL };

struct TC { int tid, bid, nb, nostore; };
enum { E_BF16 = 0, E_F32, E_GLU, E_BR0, E_BR1, E_BR2, E_ADDX, E_SOFTMAX, E_BRZ, E_F16 };
enum { K_NONE = 0, K_GEMM, K_RMS, K_MIX1, K_MIX2, K_MIX3, K_ROUTE, K_EXPERTS, K_EXPERTS_V, K_INIT };
enum { B_OUT = 31, B_WS = 32 };
struct GemmDesc {
    int kind, epi, layer, alt;
    int bA, bB, bC, bE0, bE1, bE2, zinner, split;
    long oA, oB, oC, oE0, oE1, oE2;
    long zA_l, zA_hi, zA_lo, zB_l, zB_hi, zB_lo, zC_l, zC_hi, zC_lo;
    int lda, ldb, ldc, M, N, K, nz; float scale;
};
DI const void* base_ptr(PRM p, int id) { const unsigned long long v = rfl64(id < 31 ? (unsigned long long)p.in[id] : (id == 31 ? (unsigned long long)p.out : (unsigned long long)p.ws)); return (const void*)(const GLOBAL_AS char*)v; }
typedef const GemmDesc& GD;
#define GI(f) (g.f)
#define GL(f) (g.f)
#define GPTR(ty, bf, of) ((ty)((const char*)base_ptr(p, g.bf) + g.of))
#define ZOFF(g, X, zi) ((size_t)(((zi) >> 3) * GL(z##X##_l) + (((zi) >> 2) & 1) * GL(z##X##_hi) + ((zi) & 3) * GL(z##X##_lo)))
DI unsigned pkh2(float lo, float hi) { typedef float f32x2h __attribute__((ext_vector_type(2))); typedef _Float16 f16x2h __attribute__((ext_vector_type(2)));
    return __builtin_bit_cast(unsigned, __builtin_convertvector((f32x2h){lo, hi}, f16x2h)); }
DI float h2f(unsigned short h) { return (float)__builtin_bit_cast(_Float16, h); }
DI void store8_bf16(bf16_t* p, const float (&v)[8]) {
    u32x4 w; w.x = pk2(v[0], v[1]); w.y = pk2(v[2], v[3]); w.z = pk2(v[4], v[5]); w.w = pk2(v[6], v[7]);
    *(u32x4*)p = w;
}
DI void unpack8(const u32x4 w, float (&v)[8]) { v[0] = bflo(w.x); v[1] = bfhi(w.x); v[2] = bflo(w.y); v[3] = bfhi(w.y); v[4] = bflo(w.z); v[5] = bfhi(w.z); v[6] = bflo(w.w); v[7] = bfhi(w.w); }
DI void load8_bf16(const bf16_t* p, float (&v)[8]) {
    const u32x4 w = *(const u32x4*)p;
    v[0] = bflo(w.x); v[1] = bfhi(w.x); v[2] = bflo(w.y); v[3] = bfhi(w.y); v[4] = bflo(w.z); v[5] = bfhi(w.z); v[6] = bflo(w.w); v[7] = bfhi(w.w);
}
struct EpiU { int epi, ldc; size_t zo, zx; unsigned char* C; const unsigned char* A; const unsigned char* e0; const unsigned char* e1; unsigned char* e2; float scale; };
struct EpiL { u32x4 a, b; };
DI EpiU epi_unit(PRM p, GD g, int z) {
    EpiU u; u.ldc = GI(ldc); u.epi = GI(epi); u.zx = 0;
    if (u.epi == E_BRZ) { u.epi = E_BR0 + z; u.zx = (size_t)z * D; }
    u.zo = ZOFF(g, C, z); u.C = GPTR(unsigned char*, bC, oC); u.A = GPTR(const unsigned char*, bA, oA); u.e0 = GPTR(const unsigned char*, bE0, oE0); u.e1 = GPTR(const unsigned char*, bE1, oE1);
    u.e2 = GPTR(unsigned char*, bE2, oE2); u.scale = g.scale; return u;
}
DI void epi_load(const EpiU& u, int row, int col, EpiL& L) {
    const size_t co = u.zo + (size_t)row * u.ldc + col;
    switch (u.epi) {
    case E_GLU: L.a = *(const u32x4*)((const bf16_t*)u.A + (size_t)row * 512 + col); break;
    case E_BR0: L.a = *(const u32x4*)((const bf16_t*)u.e0 + u.zx + (size_t)row * INC + col); break;
    case E_BR1: case E_BR2: { L.a = *(const u32x4*)((const bf16_t*)u.e0 + u.zx + (size_t)row * INC + col); L.b = *(const u32x4*)((const bf16_t*)u.C + co); } break;
    case E_ADDX: { const float* x = (const float*)u.e0 + co; L.a = *(const u32x4*)x; L.b = *(const u32x4*)(x + 4); } break;
    default: break;
    }
}
DI void epi_finish(const int nostore, const EpiU& u, int row, int col, float (&v)[8], const EpiL& L) {
    const size_t co = u.zo + (size_t)row * u.ldc + col;
    switch (u.epi) {
    case E_BF16: {
#pragma unroll
        for (int j = 0; j < 8; ++j) v[j] *= u.scale;
        store8_bf16((bf16_t*)u.C + co, v); } break;
    case E_F32: { float* c = (float*)u.C + co; *(f32x4*)c = (f32x4){v[0], v[1], v[2], v[3]}; *(f32x4*)(c + 4) = (f32x4){v[4], v[5], v[6], v[7]}; } break;
    case E_F16: { u32x4 w; w.x = pkh2(v[0], v[1]); w.y = pkh2(v[2], v[3]); w.z = pkh2(v[4], v[5]); w.w = pkh2(v[6], v[7]); *(u32x4*)((unsigned short*)u.C + co) = w; } break;
    case E_GLU: {
        float y[8], o[8]; unpack8(L.a, y); const float* bias = (const float*)u.e0;
#pragma unroll
        for (int j = 0; j < 8; ++j) o[j] = y[j] * sigmoidf_(v[j] + bias[col + j]);
        store8_bf16((bf16_t*)u.C + co, o); } break;
    case E_BR0: case E_BR1: case E_BR2: {
        float lg[8], o[8]; unpack8(L.a, lg); const float* bg = (const float*)u.e1 + u.zx;
#pragma unroll
        for (int j = 0; j < 8; ++j) { o[j] = sigmoidf_(lg[j] + bg[col + j]) * v[j]; }
        if (u.epi != E_BR0) { float pr[8]; unpack8(L.b, pr);
#pragma unroll
            for (int j = 0; j < 8; ++j) o[j] += pr[j]; }
        if (nostore && o[0] != 12345.678f) break;
        store8_bf16((bf16_t*)u.C + co, o); } break;
    case E_ADDX: { float* x = (float*)u.C + co; f32x4 x0 = __builtin_bit_cast(f32x4, L.a), x1 = __builtin_bit_cast(f32x4, L.b);
        x0 += (f32x4){v[0], v[1], v[2], v[3]}; x1 += (f32x4){v[4], v[5], v[6], v[7]}; if (nostore && x0.x != 12345.678f) break; *(f32x4*)x = x0; *(f32x4*)(x + 4) = x1; } break;
    default: break;
    }
}
typedef short bf16x8 __attribute__((ext_vector_type(8)));
namespace mgk {
constexpr int BM = 256, BK = 64, HALF = 128, HTB = HALF * BK * 2, NXCD = 8, WGM = 8;
DI int lds_byte(int r, int c) { const int st = (r >> 4) * 2 + (c >> 5), rr = r & 15, cc = c & 31, ob = rr * 64 + cc * 2; return st * 1024 + (ob ^ (((ob >> 9) & 1) << 5)); }
DI void stage_rc(int b, int& R, int& C) { const int st = b / 1024, sb = b % 1024, swz = sb ^ (((sb >> 9) & 1) << 5); R = (st >> 1) * 16 + swz / 64; C = (st & 1) * 32 + (swz % 64) / 2; }
DI int perm32(int rho) { const int n = rho >> 4, i = rho & 15; return 8 * (i >> 2) + 4 * n + (i & 3); }
struct Unit { int pm, pn, z; };
DI bool next_unit(GD g, int i, int G, int c, Unit& u) {
    const int nM = GI(M) / BM, nN = GI(N) / BM, nwg = nM * nN;
    long L = (long)i * G + c; int zz;
    if (GI(zinner)) { const int nz = GI(nz); zz = i % nz; L = (long)(i / nz) * G + c; if (L >= nwg) return false; }
    else { if (L >= (long)nwg * GI(nz)) return false; zz = (int)(L / nwg); }
    u.z = zz; int wgid = (int)(L % nwg);
    { const int q = nwg / NXCD, r = nwg % NXCD, xcd = wgid % NXCD, off = wgid / NXCD; wgid = (xcd < r ? xcd * (q + 1) : r * (q + 1) + (xcd - r) * q) + off; }
    const int nig = WGM * nN, gid = wgid / nig, fm = gid * WGM, gsz = (nM - fm) < WGM ? (nM - fm) : WGM;
    u.pm = rfl(fm + ((wgid % nig) % gsz)); u.pn = rfl((wgid % nig) / gsz); u.z = rfl(u.z); return true;
}
}

DI void mgemm(const TC tc, PRM p, GD g, LAS unsigned char* lds, LAS unsigned char* lds_dma) {
    using namespace mgk;
    const int tid = tc.tid, wid = __builtin_amdgcn_readfirstlane(tid >> 6), lane = tid & 63, wr = wid >> 2, wc = wid & 3, fr = lane & 15, fq = lane >> 4;
    const int nt = (tc.nostore && PROBE_SEL == 6) ? 2 : GI(K) / BK, lda = GI(lda), ldb = GI(ldb);
    unsigned voffA[2], voffB[2];
#pragma unroll
    for (int i = 0; i < 2; ++i) { int R, C; stage_rc(tid * 16 + i * 8192, R, C); const int Rb = (R & ~31) + perm32(R & 31);
        voffA[i] = (unsigned)(R * lda + C) * 2u; voffB[i] = (unsigned)(Rb * ldb + C) * 2u; }
    const size_t kstep = (size_t)(BK * 2);
    const size_t hstepA = (size_t)HALF * lda * 2, hstepB = (size_t)HALF * ldb * 2;
    const unsigned ldsw = (unsigned)wid * 1024u;
    const unsigned ldsm0 = (unsigned)__builtin_amdgcn_readfirstlane((int)((unsigned)(size_t)lds_dma + ldsw));
    LAS unsigned char* aB = lds + lds_byte(wr * 64 + fr, fq * 8); LAS unsigned char* bB = lds + 4 * HTB + lds_byte(wc * 32 + fr, fq * 8);
    asm volatile("" : "+v"(aB), "+v"(bB));
#define MG_SA(b, h) (((b) * 2 + (h)) * HTB)
#define MG_SB(b, h) ((4 + (b) * 2 + (h)) * HTB)
#ifndef MG_ASM_DMA
#define MG_ASM_DMA 0
#endif
#if MG_ASM_DMA
#define MG_STAGE(bufoff, gbase, voff) do { _Pragma("unroll") for (int _i = 0; _i < 2; ++_i) \
        asm volatile("s_mov_b32 m0, %0\n\ts_nop 0\n\tglobal_load_lds_dwordx4 %1, %2" :: "s"(ldsm0 + (unsigned)((bufoff) + _i * 8192)), "v"((voff)[_i]), "s"((const char*)(gbase)) : "m0", "memory"); } while (0)
#else
#define MG_STAGE(bufoff, gbase, voff) do { _Pragma("unroll") for (int _i = 0; _i < 2; ++_i) \
        __builtin_amdgcn_global_load_lds((const unsigned*)((const char*)(gbase) + (voff)[_i]), (LAS unsigned*)(lds_dma + (bufoff) + ldsw + _i * 8192), 16, 0, 0); } while (0)
#endif
#define MG_LDA(dst, b, h) do { _Pragma("unroll") for (int m = 0; m < 4; ++m) _Pragma("unroll") for (int k = 0; k < 2; ++k) dst[m][k] = *(const LAS bf16x8*)(aB + MG_SA(b, h) + m * 2048 + k * 1024); } while (0)
#define MG_LDB(dst, b, h) do { _Pragma("unroll") for (int n = 0; n < 2; ++n) _Pragma("unroll") for (int k = 0; k < 2; ++k) dst[n][k] = *(const LAS bf16x8*)(bB + (MG_SB(b, h) - 4 * HTB) + n * 2048 + k * 1024); } while (0)
#define MG_MMA(ai, bj, At, Bt) do { __builtin_amdgcn_s_setprio(1); _Pragma("unroll") for (int m = 0; m < 4; ++m) _Pragma("unroll") for (int n = 0; n < 2; ++n) _Pragma("unroll") for (int k = 0; k < 2; ++k) \
        acc[ai][bj][m][n] = __builtin_amdgcn_mfma_f32_16x16x32_bf16(Bt[n][k], At[m][k], acc[ai][bj][m][n], 0, 0, 0); __builtin_amdgcn_s_setprio(0); } while (0)
#define MG_WAIT_V(n) asm volatile("s_waitcnt vmcnt(" #n ")" ::: "memory")
#define MG_WAIT_L(n) asm volatile("s_waitcnt lgkmcnt(" #n ")" ::: "memory")
#define MG_BAR __builtin_amdgcn_s_barrier()
#define MG_SCHED __builtin_amdgcn_sched_barrier(0)
    const int G = rfl(tc.nb), cidx = rfl(tc.bid);
    Unit cur, nxt; int ui = 0;
    if (!next_unit(g, 0, G, cidx, cur)) return;
    {
        const int nun = (GI(M) / BM) * (GI(N) / BM) * GI(nz), full = nun / G, rem = nun - full * G;
        if (rem != 0 && full >= 4 && cidx >= rem && !GI(zinner)) { const int steps = (cidx - rem) & 15; for (int k = 0; k < steps; ++k) __builtin_amdgcn_s_sleep(64); }
    }
    f32x4 acc[2][2][4][2];
#pragma unroll
    for (int a = 0; a < 2; ++a)
#pragma unroll
        for (int b = 0; b < 2; ++b)
#pragma unroll
            for (int m = 0; m < 4; ++m)
#pragma unroll
                for (int n = 0; n < 2; ++n) acc[a][b][m][n] = (f32x4){0.f, 0.f, 0.f, 0.f};
    bf16x8 At[4][2], B0[2][2], B1[2][2];
    const bf16_t* const Abase = GPTR(const bf16_t*, bA, oA); const bf16_t* const Bbase = GPTR(const bf16_t*, bB, oB);
    const char* cA = (const char*)(Abase + ZOFF(g, A, cur.z) + (size_t)cur.pm * BM * lda);
    const char* cB = (const char*)(Bbase + ZOFF(g, B, cur.z) + (size_t)cur.pn * BM * ldb);
    MG_STAGE(MG_SB(0, 0), cB, voffB); MG_STAGE(MG_SB(0, 1), cB + hstepB, voffB); MG_STAGE(MG_SA(0, 0), cA, voffA); MG_STAGE(MG_SA(0, 1), cA + hstepA, voffA);
    if (wr == 1) MG_BAR;
    MG_WAIT_V(2); MG_BAR;
    MG_STAGE(MG_SB(1, 0), cB + kstep, voffB); MG_STAGE(MG_SA(1, 0), cA + kstep, voffA); MG_STAGE(MG_SB(1, 1), cB + hstepB + kstep, voffB);
    MG_WAIT_V(6); MG_BAR;
    for (;;) {
        const bool has_next = next_unit(g, ui + 1, G, cidx, nxt);
        const char* nA = has_next ? (const char*)(Abase + ZOFF(g, A, nxt.z) + (size_t)nxt.pm * BM * GI(lda)) : cA;
        const char* nB = has_next ? (const char*)(Bbase + ZOFF(g, B, nxt.z) + (size_t)nxt.pn * BM * GI(ldb)) : cB;
        for (int t = 0; t < nt; t += 2) {
            const bool last = (t == nt - 2);
            const char* a1 = cA + (size_t)(t + 1) * kstep;
            const char* a2 = last ? nA : cA + (size_t)(t + 2) * kstep; const char* b2 = last ? nB : cB + (size_t)(t + 2) * kstep;
            const char* a3 = a2 + kstep; const char* b3 = b2 + kstep;
            MG_LDB(B0, 0, 0); MG_LDB(B1, 0, 1); MG_SCHED; MG_LDA(At, 0, 0); MG_STAGE(MG_SA(1, 1), a1 + hstepA, voffA);
            MG_WAIT_V(8); MG_WAIT_L(0); MG_BAR; MG_MMA(0, 0, At, B0); MG_MMA(0, 1, At, B1); MG_BAR; MG_SCHED;
            MG_LDA(At, 0, 1); MG_STAGE(MG_SB(0, 0), b2, voffB); MG_STAGE(MG_SB(0, 1), b2 + hstepB, voffB); MG_STAGE(MG_SA(0, 0), a2, voffA);
            MG_WAIT_V(8); MG_WAIT_L(0); MG_BAR; MG_MMA(1, 0, At, B0); MG_MMA(1, 1, At, B1); MG_BAR; MG_SCHED;
            MG_LDB(B0, 1, 0); MG_LDB(B1, 1, 1); MG_SCHED; MG_LDA(At, 1, 0); MG_STAGE(MG_SA(0, 1), a2 + hstepA, voffA);
            MG_WAIT_V(8); MG_WAIT_L(0); MG_BAR; MG_MMA(0, 0, At, B0); MG_MMA(0, 1, At, B1); MG_BAR; MG_SCHED;
            MG_LDA(At, 1, 1); MG_STAGE(MG_SB(1, 0), b3, voffB); MG_STAGE(MG_SB(1, 1), b3 + hstepB, voffB); MG_STAGE(MG_SA(1, 0), a3, voffA);
            MG_WAIT_V(8); MG_WAIT_L(0); MG_BAR; MG_MMA(1, 0, At, B0); MG_MMA(1, 1, At, B1); MG_BAR; MG_SCHED;
        }
        if (wr == 0) MG_BAR;
        int fr_e = fr, fq_e = fq, ez = 0;
        asm volatile("" : "+v"(fr_e), "+v"(fq_e), "+v"(ez));
        PRM pe = *(const LAS Params*)((const LAS unsigned char*)&p + ez);
#define p pe
#define fr fr_e
#define fq fq_e
        if (tc.nostore && PROBE_SEL == 5) {   }
        else if (GI(epi) == E_SOFTMAX) {
            LAS float* red = (LAS float*)(lds + 131072);
#pragma unroll
            for (int ai = 0; ai < 2; ++ai)
#pragma unroll
                for (int m = 0; m < 4; ++m) {
                    float mx = -INFINITY;
#pragma unroll
                    for (int bj = 0; bj < 2; ++bj)
#pragma unroll
                        for (int n = 0; n < 2; ++n)
#pragma unroll
                            for (int j = 0; j < 4; ++j) mx = fmaxf(mx, acc[ai][bj][m][n][j]);
                    mx = fmaxf(mx, sx<16>(mx)); { float lo_, hi_; halves(mx, lo_, hi_); mx = fmaxf(lo_, hi_); }
                    float s = 0.f;
#pragma unroll
                    for (int bj = 0; bj < 2; ++bj)
#pragma unroll
                        for (int n = 0; n < 2; ++n)
#pragma unroll
                            for (int j = 0; j < 4; ++j) { const float e = fexp(acc[ai][bj][m][n][j] - mx); acc[ai][bj][m][n][j] = e; s += e; }
                    s += sx<16>(s); { float lo_, hi_; halves(s, lo_, hi_); s = lo_ + hi_; }
                    if (fq == 0) { const int rl = ai * HALF + wr * 64 + m * 16 + fr; red[(rl * 4 + wc) * 2] = mx; red[(rl * 4 + wc) * 2 + 1] = s; }
                }
            asm volatile("s_waitcnt lgkmcnt(0)" ::: "memory"); __builtin_amdgcn_s_barrier(); asm volatile("" ::: "memory");
            bf16_t* Cb = GPTR(bf16_t*, bC, oC) + ZOFF(g, C, cur.z); const int ldc = GI(ldc);
#pragma unroll
            for (int ai = 0; ai < 2; ++ai)
#pragma unroll
                for (int m = 0; m < 4; ++m) {
                    const int rl = ai * HALF + wr * 64 + m * 16 + fr;
                    const f32x4 p0 = *(const LAS f32x4*)(red + rl * 8), p1 = *(const LAS f32x4*)(red + rl * 8 + 4);
                    const float M_ = fmaxf(fmaxf(p0.x, p0.z), fmaxf(p1.x, p1.z));
                    const float tot = p0.y * fexp(p0.x - M_) + p0.w * fexp(p0.z - M_) + p1.y * fexp(p1.x - M_) + p1.w * fexp(p1.z - M_);
                    const float sc = fexp(red[(rl * 4 + wc) * 2] - M_) * frcp(tot);
                    bf16_t* rowp = Cb + (size_t)(cur.pm * BM + rl) * ldc + cur.pn * BM + wc * 32 + 8 * fq;
#pragma unroll
                    for (int bj = 0; bj < 2; ++bj) {
                        float v[8];
#pragma unroll
                        for (int j = 0; j < 4; ++j) { v[j] = acc[ai][bj][m][0][j] * sc; v[4 + j] = acc[ai][bj][m][1][j] * sc; }
                        store8_bf16(rowp + bj * HALF, v);
                    }
                }
        } else {
            const int row0 = cur.pm * BM + wr * 64 + fr, col0 = cur.pn * BM + wc * 32 + 8 * fq;
            const EpiU eu = epi_unit(p, g, cur.z);
#pragma unroll
            for (int ai = 0; ai < 2; ++ai)
#pragma unroll
                for (int m = 0; m < 4; ++m) {
                    EpiL L[2];
#pragma unroll
                    for (int bj = 0; bj < 2; ++bj) epi_load(eu, row0 + ai * HALF + m * 16, col0 + bj * HALF, L[bj]);
#pragma unroll
                    for (int bj = 0; bj < 2; ++bj) {
                        float v[8];
#pragma unroll
                        for (int j = 0; j < 4; ++j) { v[j] = acc[ai][bj][m][0][j]; v[4 + j] = acc[ai][bj][m][1][j]; }
                        epi_finish(tc.nostore, eu, row0 + ai * HALF + m * 16, col0 + bj * HALF, v, L[bj]);
                    }
                }
        }
#undef fr
#undef fq
#undef p
        if (!has_next) break;
#pragma unroll
        for (int a = 0; a < 2; ++a)
#pragma unroll
            for (int b = 0; b < 2; ++b)
#pragma unroll
                for (int m = 0; m < 4; ++m)
#pragma unroll
                    for (int n = 0; n < 2; ++n) acc[a][b][m][n] = (f32x4){0.f, 0.f, 0.f, 0.f};
        cur = nxt; cA = nA; cB = nB; ++ui;
        if (wr == 1) MG_BAR;
    }
    MG_WAIT_V(0);
    MG_BAR;
#undef MG_SA
#undef MG_SB
#undef MG_STAGE
#undef MG_LDA
#undef MG_LDB
#undef MG_MMA
#undef MG_WAIT_V
#undef MG_WAIT_L
#undef MG_BAR
#undef MG_SCHED
}

DI void transpose_item(const float* W, int K, int N, bf16_t* WT, LAS float* scr, int item, int lane) {
    const int nblk = N / 32, kb = item / nblk, nb = item % nblk, k0 = 64 * kb, n0 = 32 * nb;
#pragma unroll 8
    for (int i = 0; i < 32; ++i) { const int kk = 2 * i + (lane >> 5); scr[kk * 33 + (lane & 31)] = W[(size_t)(k0 + kk) * N + n0 + (lane & 31)]; }
    asm volatile("s_waitcnt lgkmcnt(0)" ::: "memory");
    const int c = lane & 7;
#pragma unroll
    for (int j = 0; j < 4; ++j) { const int n = (lane >> 3) + 8 * j; const LAS float* s = scr + (8 * c) * 33 + n;
        u32x4 o; o.x = pk2(s[0 * 33], s[1 * 33]); o.y = pk2(s[2 * 33], s[3 * 33]); o.z = pk2(s[4 * 33], s[5 * 33]); o.w = pk2(s[6 * 33], s[7 * 33]);
        *(u32x4*)(WT + (size_t)(n0 + n) * K + k0 + 8 * c) = o; }
    asm volatile("s_waitcnt lgkmcnt(0)" ::: "memory");
}
DI void prep_weights(const TC tc, PRM p, LAS unsigned char* lds) {
    const int lane = tc.tid & 63, wave = tc.tid >> 6, gw = tc.bid * 8 + wave, NGW = tc.nb * 8;
    LAS float* scr = (LAS float*)(lds + wave * 16384);
    unsigned char* ws = pws(p);
    constexpr int I_IN = (D / 64) * (INC / 32), I_BR = (512 / 64) * (D / 32), I_OUT = (D / 64) * (D / 32), I_GLU = (512 / 64) * (512 / 32), I_KV = (D / 64) * (2 * D / 32), I_WO = (D / 64) * (D / 32);
    constexpr int PER_L = I_IN + 3 * I_BR + I_OUT + I_GLU + I_KV + I_WO;
    for (int it = gw; it < DEPTH * PER_L; it += NGW) {
        const int l = it / PER_L; int r = it % PER_L;
        if (r < I_IN) { transpose_item((const float*)pin(p, I_W_IN) + (size_t)l * D * INC, D, INC, (bf16_t*)(ws + WS_WIN_T) + (size_t)l * INC * D, scr, r, lane); continue; } r -= I_IN;
        if (r < 3 * I_BR) { const int br = r / I_BR; transpose_item((const float*)pin(p, I_W_BRANCH) + (size_t)l * 1536 * D + (size_t)br * 512 * D, 512, D, (bf16_t*)(ws + WS_WBR_T) + (size_t)(l * 3 + br) * D * 512, scr, r % I_BR, lane); continue; } r -= 3 * I_BR;
        if (r < I_OUT) { transpose_item((const float*)pin(p, I_W_OUT) + (size_t)l * D * D, D, D, (bf16_t*)(ws + WS_WOUT_T) + (size_t)l * D * D, scr, r, lane); continue; } r -= I_OUT;
        if (r < I_GLU) { transpose_item((const float*)pin(p, I_S5_WGLU) + (size_t)l * 512 * 512, 512, 512, (bf16_t*)(ws + WS_WGLU_T) + (size_t)l * 512 * 512, scr, r, lane); continue; } r -= I_GLU;
        if (r < I_KV) { transpose_item((const float*)pin(p, I_XA_WKV) + (size_t)l * D * 2 * D, D, 2 * D, (bf16_t*)(ws + WS_WKV_T) + (size_t)l * 2 * D * D, scr, r, lane); continue; } r -= I_KV;
        transpose_item((const float*)pin(p, I_XA_WO) + (size_t)l * D * D, D, D, (bf16_t*)(ws + WS_WOT) + (size_t)l * D * D, scr, r, lane);
    }
    {
        const size_t n_wq = (size_t)DEPTH * D * D / 8, n_pq = (size_t)DEPTH * D * 2048 / 8;
        const float* wq = (const float*)pin(p, I_XA_WQ); const float* pq = (const float*)pin(p, I_PEER_WQ);
        bf16_t* wqb = (bf16_t*)(ws + WS_WQB); bf16_t* pqb = (bf16_t*)(ws + WS_PWQB);
        for (size_t i = (size_t)tc.bid * 512 + tc.tid; i < n_wq + n_pq; i += (size_t)tc.nb * 512) {
            const float* s = i < n_wq ? wq + i * 8 : pq + (i - n_wq) * 8; bf16_t* d = i < n_wq ? wqb + i * 8 : pqb + (i - n_wq) * 8;
            const f32x4 a = *(const f32x4*)s, b = *(const f32x4*)(s + 4);
            u32x4 w; w.x = pk2(a.x, a.y); w.y = pk2(a.z, a.w); w.z = pk2(b.x, b.y); w.w = pk2(b.z, b.w); *(u32x4*)d = w;
        }
    }
    {
        const float* keys = (const float*)pin(p, I_PEER_KEYS); bf16_t* kbd = (bf16_t*)(ws + WS_KBD);
        const size_t n = (size_t)DEPTH * 8 * 256 * 256 / 8;
        for (size_t i = (size_t)tc.bid * 512 + tc.tid; i < n; i += (size_t)tc.nb * 512) {
            const size_t e = i * 8; const int c = (int)(e & 255), r = (int)((e >> 8) & 255); const size_t lh = e >> 16;
            const int pr = r >> 7, key = r & 127, pc = c >> 7, d = c & 127;
            u32x4 w = (u32x4){0u, 0u, 0u, 0u};
            if (pr == pc) { const float* s = keys + ((lh * 2 + pr) * 128 + key) * 128 + d; const f32x4 a = *(const f32x4*)s, b = *(const f32x4*)(s + 4);
                w.x = pk2(a.x, a.y); w.y = pk2(a.z, a.w); w.z = pk2(b.x, b.y); w.w = pk2(b.z, b.w); }
            *(u32x4*)(kbd + e) = w;
        }
    }
}

DI unsigned fp8x4(float a, float b, float c, float d) {
    a = fminf(fmaxf(a, -448.f), 448.f); b = fminf(fmaxf(b, -448.f), 448.f); c = fminf(fmaxf(c, -448.f), 448.f); d = fminf(fmaxf(d, -448.f), 448.f);
    int t = 0; t = __builtin_amdgcn_cvt_pk_fp8_f32(a, b, t, false); t = __builtin_amdgcn_cvt_pk_fp8_f32(c, d, t, true); return (unsigned)t;
}
DI void rms_rows(const TC tc, const float* X, const float* gain, bf16_t* ob, float* of, int rows, unsigned char* oq = nullptr) {
    const int lane = tc.tid & 63, gw = tc.bid * 8 + (tc.tid >> 6), NGW = tc.nb * 8;
    f32x4 n0[4], n1[4];
#pragma unroll
    for (int j = 0; j < 4; ++j) { n0[j] = (f32x4){0.f, 0.f, 0.f, 0.f}; n1[j] = n0[j]; }
    if (gw < rows) {
#pragma unroll
        for (int j = 0; j < 4; ++j) n0[j] = ((const f32x4*)(X + (size_t)gw * D) + lane)[64 * j]; }
    if (gw + NGW < rows) {
#pragma unroll
        for (int j = 0; j < 4; ++j) n1[j] = ((const f32x4*)(X + (size_t)(gw + NGW) * D) + lane)[64 * j]; }
    for (int r = gw; r < rows; r += NGW) {
        f32x4 v[4]; float ss = 0.f;
#pragma unroll
        for (int j = 0; j < 4; ++j) { v[j] = n0[j]; n0[j] = n1[j]; }
        if (r + 2 * NGW < rows) {
#pragma unroll
            for (int j = 0; j < 4; ++j) n1[j] = ((const f32x4*)(X + (size_t)(r + 2 * NGW) * D) + lane)[64 * j]; }
#pragma unroll
        for (int j = 0; j < 4; ++j) ss += v[j].x * v[j].x + v[j].y * v[j].y + v[j].z * v[j].z + v[j].w * v[j].w;
        const float sc = frsq(wave_sum(ss) * (1.0f / D) + EPS);
#pragma unroll
        for (int j = 0; j < 4; ++j) {
            const f32x4 g = ((const f32x4*)gain)[lane + 64 * j];
            const f32x4 o = v[j] * sc * g;
            if (ob) { u32x2 w; w.x = pk2(o.x, o.y); w.y = pk2(o.z, o.w); *((u32x2*)(ob + (size_t)r * D) + lane + 64 * j) = w; }
            if (of) ((f32x4*)(of + (size_t)r * D))[lane + 64 * j] = o;
            if (oq) {
                typedef float f32x2 __attribute__((ext_vector_type(2)));
                const f32x4 o8 = o * 8.0f; const unsigned q1 = fp8x4(o8.x, o8.y, o8.z, o8.w);
                const f32x2 d0 = __builtin_amdgcn_cvt_pk_f32_fp8((int)q1, false), d1 = __builtin_amdgcn_cvt_pk_f32_fp8((int)q1, true);
                ((unsigned*)(oq + (size_t)r * D))[lane + 64 * j] = q1;
                if (PEER_LO) { const unsigned q2 = fp8x4((o8.x - d0.x) * 16.0f, (o8.y - d0.y) * 16.0f, (o8.z - d1.x) * 16.0f, (o8.w - d1.y) * 16.0f);
                    ((unsigned*)(oq + (size_t)T * D + (size_t)r * D))[lane + 64 * j] = q2; }
            }
        }
    }
}

template <bool RET>
DI void seq_linattn(const TC tc, PRM p, int l, int item) {
    const bf16_t* PROJ = (const bf16_t*)(pws(p) + WS_PROJ);
    float* OT = (float*)(pws(p) + WS_OTMP) + (size_t)(RET ? 2 : 0) * T * 512;
    const int b = item >> 5, h = (item >> 3) & 3, jg = item & 7;
    const int tid = tc.tid, j = tid >> 5, ks = tid & 31, k0 = ks * 4;
    const int qoff = (RET ? C_RTQ : C_HGQ) + h * 128, foff = (RET ? C_RTK : C_HGF) + h * 128, voff = (RET ? C_RTV : C_HGI) + h * 128 + jg * 16 + j;
    const int* pos = (const int*)pin(p, I_POS) + b * SEQ;
    float lb[4], inv[4];
    float gam = 1.0f;
    if (RET) {
        gam = 1.0f - exp2f(-5.0f - (float)h);
#pragma unroll
        for (int i = 0; i < 4; ++i) inv[i] = powf(10000.0f, -(float)((k0 + i) & 63) * (1.0f / 64.0f));
    } else {
        const float* hl = (const float*)pin(p, I_HG_LB);
#pragma unroll
        for (int i = 0; i < 4; ++i) {
            const int c = h * 128 + k0 + i;
            if (l == 0) lb[i] = 0.f;
            else { const float a0 = hl[c], a1 = hl[512 + c], m = fmaxf(a0, a1), e0 = expf(a0 - m), e1 = expf(a1 - m); lb[i] = e1 / (e0 + e1); }
        }
    }
    float S[4] = {0.f, 0.f, 0.f, 0.f};
    const bf16_t* base = PROJ + (size_t)b * SEQ * INC;
    const int pk0 = k0 ^ 64;
    for (int t0 = 0; t0 < SEQ; t0 += 4) {
        u32x2 q4[4], f4[4], qp4[4], fp4[4]; bf16_t vv[4]; int ps[4];
#pragma unroll
        for (int u = 0; u < 4; ++u) {
            const bf16_t* row = base + (size_t)(t0 + u) * INC;
            q4[u] = *(const u32x2*)(row + qoff + k0); f4[u] = *(const u32x2*)(row + foff + k0); vv[u] = row[voff];
            if (RET) { qp4[u] = *(const u32x2*)(row + qoff + pk0); fp4[u] = *(const u32x2*)(row + foff + pk0); ps[u] = pos[t0 + u]; }
        }
#pragma unroll
        for (int u = 0; u < 4; ++u) {
            const float qv[4] = {bflo(q4[u].x), bfhi(q4[u].x), bflo(q4[u].y), bfhi(q4[u].y)};
            const float fv[4] = {bflo(f4[u].x), bfhi(f4[u].x), bflo(f4[u].y), bfhi(f4[u].y)};
            const float v = bf2f(vv[u]);
            float part = 0.f;
            if (RET) {
                const float qpv[4] = {bflo(qp4[u].x), bfhi(qp4[u].x), bflo(qp4[u].y), bfhi(qp4[u].y)};
                const float fpv[4] = {bflo(fp4[u].x), bfhi(fp4[u].x), bflo(fp4[u].y), bfhi(fp4[u].y)};
                const float pf = (float)ps[u];
#pragma unroll
                for (int i = 0; i < 4; ++i) {
                    const float ang = pf * inv[i]; float sn, cs; sincosf(ang, &sn, &cs);
                    float qr, kr;
                    if (k0 < 64) { qr = qv[i] * cs - qpv[i] * sn; kr = fv[i] * cs - fpv[i] * sn; }
                    else { qr = qpv[i] * sn + qv[i] * cs; kr = fpv[i] * sn + fv[i] * cs; }
                    kr *= 0.08838834764831845f;
                    S[i] = gam * S[i] + kr * v;
                    part += S[i] * qr;
                }
            } else {
#pragma unroll
                for (int i = 0; i < 4; ++i) {
                    const float z = fv[i];
                    const float sg = 1.0f / (1.0f + expf(-z));
                    float f = lb[i] + (1.0f - lb[i]) * sg; f = fminf(fmaxf(f, 1e-6f), 1.0f);
                    const float kk = (1.0f - lb[i]) / (1.0f + expf(z));
                    S[i] = f * S[i] + kk * v;
                    part += S[i] * (qv[i] * 0.08838834764831845f);
                }
            }
            part += sx<16>(part); part += sx<8>(part); part += sx<4>(part); part += sx<2>(part); part += sx<1>(part);
            if (ks == 0) OT[(size_t)(b * SEQ + t0 + u) * 512 + h * 128 + jg * 16 + j] = part;
        }
    }
}

DI float reduce16(float (&v)[16], int lane) {
    const bool h4 = lane & 16, h3 = lane & 8, h2 = lane & 4, h1 = lane & 2;
#pragma unroll
    for (int i = 0; i < 8; ++i) { const float send = h4 ? v[i] : v[i + 8], keep = h4 ? v[i + 8] : v[i]; v[i] = keep + sx<16>(send); }
#pragma unroll
    for (int i = 0; i < 4; ++i) { const float send = h3 ? v[i] : v[i + 4], keep = h3 ? v[i + 4] : v[i]; v[i] = keep + sx<8>(send); }
#pragma unroll
    for (int i = 0; i < 2; ++i) { const float send = h2 ? v[i] : v[i + 2], keep = h2 ? v[i + 2] : v[i]; v[i] = keep + sx<4>(send); }
    { const float send = h1 ? v[0] : v[1], keep = h1 ? v[1] : v[0]; v[0] = keep + sx<2>(send); }
    float r = v[0]; r += sx<1>(r);
    float lo, hi; halves(r, lo, hi);
    return lo + hi;
}

constexpr int S5_LC = 128, S5_NCH = SEQ / S5_LC;
struct S5Const { float a_re, a_im; };
DI void s5_disc_init(PRM p, int idx, float* out) {
    const int l = idx >> 11, g = (idx >> 6) & 31, lane = idx & 63;
    const float lr = fminf(((const float*)pin(p, I_S5_LRE))[(l * 32 + g) * 64 + lane], -1e-4f);
    const float li = ((const float*)pin(p, I_S5_LIM))[(l * 32 + g) * 64 + lane];
    const float dt = expf(((const float*)pin(p, I_S5_LOGSTEP))[l * 32 + g]);
    const float mag = expf(lr * dt);
    const float a_re = mag * cosf(li * dt), a_im = mag * sinf(li * dt);
    const float den = lr * lr + li * li;
    out[0] = a_re; out[1] = a_im; out[2] = ((a_re - 1.0f) * lr + a_im * li) / den; out[3] = (a_im * lr - (a_re - 1.0f) * li) / den;
}
DI S5Const s5_disc(PRM p, int l, int g, int lane, float& z_re, float& z_im) {
    const f32x4 v = *(const f32x4*)((const float*)(pws(p) + WS_TAB) + (size_t)((l * 32 + g) * 64 + lane) * 4);
    S5Const c; c.a_re = v.x; c.a_im = v.y; z_re = v.z; z_im = v.w; return c;
}
template <int MODE>
DI void s5_chunk(const TC tc, PRM p, int l, int item) {
    const bf16_t* PROJ = (const bf16_t*)(pws(p) + WS_PROJ);
    float* XEND = (float*)(pws(p) + WS_S5X);
    const int b = item / (32 * S5_NCH), g = (item / S5_NCH) & 31, n = item % S5_NCH, lane = tc.tid & 63;
    float z_re, z_im; const S5Const cc = s5_disc(p, l, g, lane, z_re, z_im);
    const float a_re = cc.a_re, a_im = cc.a_im;
    float bbr[16], bbi[16];
    const float* Bre = (const float*)pin(p, I_S5_BRE) + ((size_t)(l * 32 + g) * 64 + lane) * 16;
    const float* Bim = (const float*)pin(p, I_S5_BIM) + ((size_t)(l * 32 + g) * 64 + lane) * 16;
#pragma unroll
    for (int c = 0; c < 16; ++c) { const float br = Bre[c], bi = Bim[c]; bbr[c] = z_re * br - z_im * bi; bbi[c] = z_re * bi + z_im * br; }
    float cr[16], ci[16]; float dch = 0.f;
    const int cch = ((lane >> 4) & 1) * 8 + ((lane >> 3) & 1) * 4 + ((lane >> 2) & 1) * 2 + ((lane >> 1) & 1);
    if (MODE == 3) {
        const float* Cre = (const float*)pin(p, I_S5_CRE) + (size_t)(l * 32 + g) * 16 * 64 + lane;
        const float* Cim = (const float*)pin(p, I_S5_CIM) + (size_t)(l * 32 + g) * 16 * 64 + lane;
#pragma unroll
        for (int c = 0; c < 16; ++c) { cr[c] = Cre[c * 64]; ci[c] = Cim[c * 64]; }
        dch = ((const float*)pin(p, I_S5_D))[l * 512 + g * 16 + cch];
    }
    float* xe = XEND + ((size_t)((b * 32 + g) * S5_NCH + n) * 64 + lane) * 2;
    float xr = 0.f, xi = 0.f;
    if (MODE == 3) { xr = xe[0]; xi = xe[1]; }
    const bf16_t* base = PROJ + (size_t)(b * SEQ + n * S5_LC) * INC + C_S5U + g * 16;
    bf16_t* yo = (bf16_t*)(pws(p) + WS_YS5) + (size_t)(b * SEQ + n * S5_LC) * 512 + g * 16 + cch;
    for (int t0 = 0; t0 < S5_LC; t0 += 4) {
        u32x4 ua[4], ub[4];
#pragma unroll
        for (int u = 0; u < 4; ++u) { const bf16_t* row = base + (size_t)(t0 + u) * INC; ua[u] = *(const u32x4*)row; ub[u] = *(const u32x4*)(row + 8); }
#pragma unroll
        for (int u = 0; u < 4; ++u) {
            const float uu[16] = {bflo(ua[u].x), bfhi(ua[u].x), bflo(ua[u].y), bfhi(ua[u].y), bflo(ua[u].z), bfhi(ua[u].z), bflo(ua[u].w), bfhi(ua[u].w),
                                  bflo(ub[u].x), bfhi(ub[u].x), bflo(ub[u].y), bfhi(ub[u].y), bflo(ub[u].z), bfhi(ub[u].z), bflo(ub[u].w), bfhi(ub[u].w)};
            float br = 0.f, bi = 0.f;
#pragma unroll
            for (int c = 0; c < 16; ++c) { br += bbr[c] * uu[c]; bi += bbi[c] * uu[c]; }
            const float nr = a_re * xr - a_im * xi + br, ni = a_re * xi + a_im * xr + bi;
            xr = nr; xi = ni;
            if (MODE == 3) {
                float pv[16];
#pragma unroll
                for (int c = 0; c < 16; ++c) pv[c] = cr[c] * xr - ci[c] * xi;
                float y = reduce16(pv, lane);
                float uc = 0.f;
#pragma unroll
                for (int c = 0; c < 16; ++c) uc = (cch == c) ? uu[c] : uc;
                y = gelu_tanh(y + dch * uc);
                if ((lane & 33) == 0) yo[(size_t)(t0 + u) * 512] = (bf16_t)f2bf(y);
            }
        }
    }
    if (MODE == 1) { xe[0] = xr; xe[1] = xi; }
}
constexpr int S5W_BU = 0, S5W_X = 10240, S5W_BYTES = 16384, S5W_XS = 24  ;
template <int MODE>
DI void s5_chunk_mfma(const TC tc, PRM p, int l, int item, LAS unsigned char* lds) {
    const bf16_t* PROJ = (const bf16_t*)(pws(p) + WS_PROJ);
    float* XEND = (float*)(pws(p) + WS_S5X);
    const int b = item / (32 * S5_NCH), g = (item / S5_NCH) & 31, n = item % S5_NCH, lane = tc.tid & 63, w = tc.tid >> 6, tl = lane & 15, kg = lane >> 4;
    LAS float* BUs = (LAS float*)(lds + w * S5W_BYTES + S5W_BU); LAS bf16_t* Xs = (LAS bf16_t*)(lds + w * S5W_BYTES + S5W_X);
    float z_re, z_im; const S5Const cc = s5_disc(p, l, g, lane, z_re, z_im);
    const float a_re = cc.a_re, a_im = cc.a_im;
    const bf16_t* BBF = (const bf16_t*)(pws(p) + WS_TAB + 256 * 1024) + (size_t)(l * 32 + g) * 128 * 16;
    const bf16_t* CMF = (const bf16_t*)(pws(p) + WS_TAB + 512 * 1024) + (size_t)(l * 32 + g) * 16 * 128;
    bf16x8 bbf[8], cmf[4];
    const bf16x8 zf = {0, 0, 0, 0, 0, 0, 0, 0};
#pragma unroll
    for (int nt = 0; nt < 8; ++nt) bbf[nt] = (kg < 2) ? *(const bf16x8*)(BBF + (nt * 16 + tl) * 16 + 8 * kg) : zf;
    float dch = 0.f;
    if (MODE == 3) {
#pragma unroll
        for (int ks = 0; ks < 4; ++ks) cmf[ks] = *(const bf16x8*)(CMF + tl * 128 + ks * 32 + 8 * kg);
        dch = ((const float*)pin(p, I_S5_D))[l * 512 + g * 16 + tl];
    }
    float* xe = XEND + ((size_t)((b * 32 + g) * S5_NCH + n) * 64 + lane) * 2;
    float xr = 0.f, xi = 0.f;
    if (MODE == 3) { xr = xe[0]; xi = xe[1]; }
    const size_t tok0 = (size_t)b * SEQ + (size_t)n * S5_LC;
    const bf16_t* ub = PROJ + tok0 * INC + C_S5U + g * 16;
    bf16_t* yo = (bf16_t*)(pws(p) + WS_YS5) + tok0 * 512 + g * 16 + tl;
    bf16x8 un = (kg < 2) ? *(const bf16x8*)(ub + (size_t)tl * INC + 8 * kg) : zf;
    bf16_t uon[4] = {0, 0, 0, 0};
    if (MODE == 3) {
#pragma unroll
        for (int r = 0; r < 4; ++r) uon[r] = ub[(size_t)(kg * 4 + r) * INC + tl]; }
#pragma unroll 1
    for (int t0 = 0; t0 < S5_LC; t0 += 16) {
        const bf16x8 ua = un;
        bf16_t uo[4];
#pragma unroll
        for (int r = 0; r < 4; ++r) uo[r] = uon[r];
        if (t0 + 16 < S5_LC) { un = (kg < 2) ? *(const bf16x8*)(ub + (size_t)(t0 + 16 + tl) * INC + 8 * kg) : zf;
            if (MODE == 3) {
#pragma unroll
                for (int r = 0; r < 4; ++r) uon[r] = ub[(size_t)(t0 + 16 + kg * 4 + r) * INC + tl]; } }
        f32x4 bu[8];
#pragma unroll
        for (int nt = 0; nt < 8; ++nt) bu[nt] = __builtin_amdgcn_mfma_f32_16x16x32_bf16(ua, bbf[nt], (f32x4){0.f, 0.f, 0.f, 0.f}, 0, 0, 0);
        __builtin_amdgcn_sched_barrier(0); asm volatile("s_nop 15\n\ts_nop 15" ::: "memory"); __builtin_amdgcn_sched_barrier(0);
#pragma unroll
        for (int nt = 0; nt < 8; ++nt) *(LAS f32x4*)(BUs + (nt * 16 + tl) * 20 + kg * 4) = bu[nt];
        float brv[16], biv[16];
#pragma unroll
        for (int j = 0; j < 4; ++j) { const f32x4 a = *(const LAS f32x4*)(BUs + lane * 20 + 4 * j), c = *(const LAS f32x4*)(BUs + (64 + lane) * 20 + 4 * j);
            brv[4 * j] = a.x; brv[4 * j + 1] = a.y; brv[4 * j + 2] = a.z; brv[4 * j + 3] = a.w; biv[4 * j] = c.x; biv[4 * j + 1] = c.y; biv[4 * j + 2] = c.z; biv[4 * j + 3] = c.w; }
        __builtin_amdgcn_sched_barrier(0);
#pragma unroll
        for (int t = 0; t < 16; ++t) {
            const float br = brv[t], bi = biv[t];
            const float nr = a_re * xr - a_im * xi + br, ni = a_re * xi + a_im * xr + bi;
            xr = nr; xi = ni;
            if (MODE == 3) { brv[t] = xr; biv[t] = xi; }
        }
        if (MODE == 3) {
#pragma unroll
            for (int j = 0; j < 2; ++j) {
                u32x4 wr_, wi_;
                wr_.x = pk2(brv[8 * j], brv[8 * j + 1]); wr_.y = pk2(brv[8 * j + 2], brv[8 * j + 3]); wr_.z = pk2(brv[8 * j + 4], brv[8 * j + 5]); wr_.w = pk2(brv[8 * j + 6], brv[8 * j + 7]);
                wi_.x = pk2(biv[8 * j], biv[8 * j + 1]); wi_.y = pk2(biv[8 * j + 2], biv[8 * j + 3]); wi_.z = pk2(biv[8 * j + 4], biv[8 * j + 5]); wi_.w = pk2(biv[8 * j + 6], biv[8 * j + 7]);
                *(LAS u32x4*)(Xs + lane * S5W_XS + 8 * j) = wr_; *(LAS u32x4*)(Xs + (64 + lane) * S5W_XS + 8 * j) = wi_;
            }
            f32x4 y = (f32x4){0.f, 0.f, 0.f, 0.f};
            typedef short i16x4_ __attribute__((ext_vector_type(4)));
#pragma unroll
            for (int ks = 0; ks < 4; ++ks) {
                const LAS bf16_t* rp0 = Xs + (ks * 32 + 8 * kg + (tl >> 2)) * S5W_XS + 4 * (tl & 3);
                const i16x4_ lo4 = __builtin_amdgcn_ds_read_tr16_b64_v4i16((LAS i16x4_*)rp0), hi4 = __builtin_amdgcn_ds_read_tr16_b64_v4i16((LAS i16x4_*)(rp0 + 4 * S5W_XS));
                const bf16x8 af = {lo4.x, lo4.y, lo4.z, lo4.w, hi4.x, hi4.y, hi4.z, hi4.w};
                y = __builtin_amdgcn_mfma_f32_16x16x32_bf16(af, cmf[ks], y, 0, 0, 0);
            }
#pragma unroll
            for (int r = 0; r < 4; ++r) { const int t = t0 + kg * 4 + r; const float u = bf2f(uo[r]);
                yo[(size_t)t * 512] = (bf16_t)f2bf(gelu_tanh(y[r] + dch * u)); }
        }
    }
    if (MODE == 1) { xe[0] = xr; xe[1] = xi; }
}

DI void s5_scan(const TC tc, PRM p, int l) {
    float* XEND = (float*)(pws(p) + WS_S5X);
    for (int it = tc.bid * 512 + tc.tid; it < NB * 32 * 64; it += tc.nb * 512) {
        const int bg = it >> 6, lane = it & 63, g = bg & 31;
        float z_re, z_im; const S5Const cc = s5_disc(p, l, g, lane, z_re, z_im);
        float pr = cc.a_re, pi = cc.a_im;
#pragma unroll
        for (int i = 0; i < 7; ++i) { const float nr = pr * pr - pi * pi, ni = 2.0f * pr * pi; pr = nr; pi = ni; }
        float* xe = XEND + ((size_t)bg * S5_NCH * 64 + lane) * 2;
        float sr = 0.f, si = 0.f; asm volatile("" : "+v"(sr), "+v"(si));
        for (int n0 = 0; n0 < S5_NCH; n0 += 32) {
            float er[32], ei[32];
#pragma unroll
            for (int u = 0; u < 32; ++u) { er[u] = xe[(size_t)(n0 + u) * 128]; ei[u] = xe[(size_t)(n0 + u) * 128 + 1]; }
#pragma unroll
            for (int u = 0; u < 32; ++u) {
                if (!tc.nostore) { xe[(size_t)(n0 + u) * 128] = sr; xe[(size_t)(n0 + u) * 128 + 1] = si; }
                const float nr = pr * sr - pi * si + er[u], ni = pr * si + pi * sr + ei[u]; sr = nr; si = ni;
            }
        }
    }
}

constexpr int LA_C = 64, LA_NCH = SEQ / LA_C, LA_ITEMS = 2 * NB * 4 * LA_NCH;
constexpr int LA_QS = 144, LA_BS = 132, LA_VS = 80, LA_SS = 144, LA_PS = 80;
constexpr int LA_Q = 0, LA_K = LA_Q + 64 * LA_QS * 2, LA_B = LA_K + 64 * LA_QS * 2, LA_VT = LA_B + 64 * LA_BS * 4, LA_ST = LA_VT + 128 * LA_VS * 2, LA_P = LA_ST + 128 * LA_SS * 2,
              LA_X = LA_P + 64 * LA_PS * 2;
static_assert(LA_X + 2048 <= 144 * 1024 - 1024 && (LA_K | LA_B | LA_VT | LA_ST | LA_P | LA_X) % 16 == 0, "linear-attention LDS layout");
DI bf16x8 pack8(const float (&v)[8]) { u32x4 w; w.x = pk2(v[0], v[1]); w.y = pk2(v[2], v[3]); w.z = pk2(v[4], v[5]); w.w = pk2(v[6], v[7]); return __builtin_bit_cast(bf16x8, w); }

DI void la_item(int item, int& m, int& b, int& h, int& n) { n = item % LA_NCH; h = (item / LA_NCH) & 3; b = (item / (LA_NCH * 4)) & 1; m = item / (LA_NCH * 4 * NB); }
DI void la_vt_commit(const TC tc, const u32x4 va, const u32x4 vb, LAS unsigned char* lds) {
    const int t2 = tc.tid & 31, cv = (tc.tid >> 5) * 8; LAS unsigned* VT32 = (LAS unsigned*)(lds + LA_VT);
    VT32[((cv + 0) * LA_VS) / 2 + t2] = (va.x & 0xffffu) | (vb.x << 16); VT32[((cv + 1) * LA_VS) / 2 + t2] = (va.x >> 16) | (vb.x & 0xffff0000u);
    VT32[((cv + 2) * LA_VS) / 2 + t2] = (va.y & 0xffffu) | (vb.y << 16); VT32[((cv + 3) * LA_VS) / 2 + t2] = (va.y >> 16) | (vb.y & 0xffff0000u);
    VT32[((cv + 4) * LA_VS) / 2 + t2] = (va.z & 0xffffu) | (vb.z << 16); VT32[((cv + 5) * LA_VS) / 2 + t2] = (va.z >> 16) | (vb.z & 0xffff0000u);
    VT32[((cv + 6) * LA_VS) / 2 + t2] = (va.w & 0xffffu) | (vb.w << 16); VT32[((cv + 7) * LA_VS) / 2 + t2] = (va.w >> 16) | (vb.w & 0xffff0000u);
}
DI void la_hg_kf(const float* tab, int l, int h, int c0, int t, const u32x4 zraw, LAS unsigned char* lds) {
    LAS bf16_t* Ks = (LAS bf16_t*)(lds + LA_K); LAS float* Bs = (LAS float*)(lds + LA_B);
    float z[8], kk[8], lf[8]; unpack8(zraw, z);
#pragma unroll
    for (int j = 0; j < 8; ++j) { const float lb = tab[l * 512 + h * 128 + c0 + j]; const float sg = frcp(1.0f + fexp(-z[j])); float f = lb + (1.0f - lb) * sg; f = fminf(fmaxf(f, 1e-6f), 1.0f);
        lf[j] = flog(f); kk[j] = (1.0f - lb) * frcp(1.0f + fexp(z[j])); }
    *(LAS bf16x8*)(Ks + t * LA_QS + c0) = pack8(kk);
    *(LAS f32x4*)(Bs + t * LA_BS + c0) = (f32x4){lf[0], lf[1], lf[2], lf[3]}; *(LAS f32x4*)(Bs + t * LA_BS + c0 + 4) = (f32x4){lf[4], lf[5], lf[6], lf[7]};
}
DI void la_cumsum(const TC tc, int m, LAS unsigned char* lds) {
    LAS float* Bs = (LAS float*)(lds + LA_B);
    __syncthreads();
    if (m == 0) {
        LAS float* Xs = (LAS float*)(lds + LA_X);
        const int k = tc.tid & 127, sg = tc.tid >> 7;
        float v[16]; float tot = 0.f;
#pragma unroll
        for (int i = 0; i < 16; ++i) { v[i] = Bs[(sg * 16 + i) * LA_BS + k]; tot += v[i]; }
        Xs[sg * 128 + k] = tot;
        __syncthreads();
        float run = 0.f;
#pragma unroll
        for (int s = 0; s < 3; ++s) run += (s < sg) ? Xs[s * 128 + k] : 0.f;
#pragma unroll
        for (int i = 0; i < 16; ++i) { run += v[i]; Bs[(sg * 16 + i) * LA_BS + k] = run; }
    }
    __syncthreads();
}
struct LaPreA { u32x4 q[2], qp[2], k[2], kp[2]; f32x4 cs[2][2], sn[2][2]; u32x4 va, vb; };
DI void laA_issue(const TC tc, PRM p, int item, LaPreA& r) {
    int m, b, h, n; la_item(item, m, b, h, n);
    const bf16_t* PROJ = (const bf16_t*)(pws(p) + WS_PROJ); const int tid = tc.tid, c0 = (tid & 15) * 8;
#pragma unroll
    for (int ps = 0; ps < 2; ++ps) {
        const size_t tok = (size_t)b * SEQ + (size_t)n * LA_C + (tid >> 4) + 32 * ps; const bf16_t* prow = PROJ + tok * INC;
        if (m == 0) r.k[ps] = *(const u32x4*)(prow + C_HGF + h * 128 + c0);
        else {
            r.q[ps] = *(const u32x4*)(prow + C_RTQ + h * 128 + c0); r.qp[ps] = *(const u32x4*)(prow + C_RTQ + h * 128 + (c0 ^ 64));
            r.k[ps] = *(const u32x4*)(prow + C_RTK + h * 128 + c0); r.kp[ps] = *(const u32x4*)(prow + C_RTK + h * 128 + (c0 ^ 64));
            const float* rt = (const float*)(pws(p) + WS_ROPE) + tok * 128 + (c0 & 63);
            r.cs[ps][0] = *(const f32x4*)rt; r.cs[ps][1] = *(const f32x4*)(rt + 4); r.sn[ps][0] = *(const f32x4*)(rt + 64); r.sn[ps][1] = *(const f32x4*)(rt + 68);
        }
    }
    const size_t tokv = (size_t)b * SEQ + (size_t)n * LA_C + 2 * (tid & 31);
    const bf16_t* pv = PROJ + tokv * INC + (m == 0 ? C_HGI : C_RTV) + h * 128 + (tid >> 5) * 8;
    r.va = *(const u32x4*)pv; r.vb = *(const u32x4*)(pv + INC);
}
DI void laA_commit(const TC tc, PRM p, int l, int item, const LaPreA& r, LAS unsigned char* lds) {
    int m, b, h, n; la_item(item, m, b, h, n);
    const int tid = tc.tid, c0 = (tid & 15) * 8;
    const float* tab = (const float*)(pws(p) + WS_TAB) + 16384;
    LAS bf16_t* Ks = (LAS bf16_t*)(lds + LA_K); LAS float* Bs = (LAS float*)(lds + LA_B);
#pragma unroll
    for (int ps = 0; ps < 2; ++ps) {
        const int t = (tid >> 4) + 32 * ps; const size_t tok = (size_t)b * SEQ + (size_t)n * LA_C + t;
        if (m == 0) la_hg_kf(tab, l, h, c0, t, r.k[ps], lds);
        else {
            float q[8], qp[8], k[8], kp[8]; unpack8(r.q[ps], q); unpack8(r.qp[ps], qp); unpack8(r.k[ps], k); unpack8(r.kp[ps], kp);
            const float cs[8] = {r.cs[ps][0].x, r.cs[ps][0].y, r.cs[ps][0].z, r.cs[ps][0].w, r.cs[ps][1].x, r.cs[ps][1].y, r.cs[ps][1].z, r.cs[ps][1].w};
            const float sn[8] = {r.sn[ps][0].x, r.sn[ps][0].y, r.sn[ps][0].z, r.sn[ps][0].w, r.sn[ps][1].x, r.sn[ps][1].y, r.sn[ps][1].z, r.sn[ps][1].w};
            float qr[8], kr[8];
#pragma unroll
            for (int j = 0; j < 8; ++j) {
                if (c0 < 64) { qr[j] = q[j] * cs[j] - qp[j] * sn[j]; kr[j] = k[j] * cs[j] - kp[j] * sn[j]; }
                else { qr[j] = qp[j] * sn[j] + q[j] * cs[j]; kr[j] = kp[j] * sn[j] + k[j] * cs[j]; }
            }
            const bf16x8 qb = pack8(qr), kb = pack8(kr);
            *(bf16x8*)((bf16_t*)(pws(p) + WS_RQ) + tok * 512 + h * 128 + c0) = qb; *(bf16x8*)((bf16_t*)(pws(p) + WS_RK) + tok * 512 + h * 128 + c0) = kb;
            *(LAS bf16x8*)(Ks + t * LA_QS + c0) = kb;
            const float bt = (float)(t + 1) * tab[1024 + h];
            *(LAS f32x4*)(Bs + t * LA_BS + c0) = (f32x4){bt, bt, bt, bt}; *(LAS f32x4*)(Bs + t * LA_BS + c0 + 4) = (f32x4){bt, bt, bt, bt};
        }
    }
    la_vt_commit(tc, r.va, r.vb, lds);
    la_cumsum(tc, m, lds);
}
struct LaPreC { u32x4 a[2], b[2], va, vb, st[4]; };
DI void laC_issue(const TC tc, PRM p, int item, LaPreC& r) {
    int m, b, h, n; la_item(item, m, b, h, n);
    const bf16_t* PROJ = (const bf16_t*)(pws(p) + WS_PROJ); const int tid = tc.tid, c0 = (tid & 15) * 8;
#pragma unroll
    for (int ps = 0; ps < 2; ++ps) {
        const size_t tok = (size_t)b * SEQ + (size_t)n * LA_C + (tid >> 4) + 32 * ps;
        if (m == 0) { r.a[ps] = *(const u32x4*)(PROJ + tok * INC + C_HGQ + h * 128 + c0); r.b[ps] = *(const u32x4*)(PROJ + tok * INC + C_HGF + h * 128 + c0); }
        else { r.a[ps] = *(const u32x4*)((const bf16_t*)(pws(p) + WS_RQ) + tok * 512 + h * 128 + c0); r.b[ps] = *(const u32x4*)((const bf16_t*)(pws(p) + WS_RK) + tok * 512 + h * 128 + c0); }
    }
    const size_t tokv = (size_t)b * SEQ + (size_t)n * LA_C + 2 * (tid & 31);
    const bf16_t* pv = PROJ + tokv * INC + (m == 0 ? C_HGI : C_RTV) + h * 128 + (tid >> 5) * 8;
    r.va = *(const u32x4*)pv; r.vb = *(const u32x4*)(pv + INC);
    const bf16_t* st = (const bf16_t*)(pws(p) + WS_LAST) + (size_t)item * 16384;
#pragma unroll
    for (int i = 0; i < 4; ++i) r.st[i] = *(const u32x4*)(st + (i * 512 + tid) * 8);
}
DI void laC_commit(const TC tc, PRM p, int l, int item, const LaPreC& r, LAS unsigned char* lds) {
    int m, b, h, n; la_item(item, m, b, h, n);
    const int tid = tc.tid, c0 = (tid & 15) * 8;
    const float* tab = (const float*)(pws(p) + WS_TAB) + 16384;
    LAS bf16_t* Qs = (LAS bf16_t*)(lds + LA_Q); LAS bf16_t* Ks = (LAS bf16_t*)(lds + LA_K);
#pragma unroll
    for (int ps = 0; ps < 2; ++ps) {
        const int t = (tid >> 4) + 32 * ps;
        *(LAS u32x4*)(Qs + t * LA_QS + c0) = r.a[ps];
        if (m == 0) la_hg_kf(tab, l, h, c0, t, r.b[ps], lds);
        else *(LAS u32x4*)(Ks + t * LA_QS + c0) = r.b[ps];
    }
    la_vt_commit(tc, r.va, r.vb, lds);
    LAS bf16_t* STs = (LAS bf16_t*)(lds + LA_ST);
#pragma unroll
    for (int i = 0; i < 4; ++i) { const int e = (i * 512 + tid) * 8, v = e >> 7, k = e & 127; *(LAS u32x4*)(STs + v * LA_SS + k) = r.st[i]; }
    la_cumsum(tc, m, lds);
}

DI void la_phaseA(const TC tc, PRM p, int l, int item, LaPreA& pre, int next_item, LAS unsigned char* lds) {
    { TC t2 = tc; asm volatile("" : "+v"(t2.tid)); laA_commit(t2, p, l, item, pre, lds); }
    __builtin_amdgcn_sched_barrier(0);
    if (next_item >= 0) { TC t3 = tc; asm volatile("" : "+v"(t3.tid)); laA_issue(t3, p, next_item, pre); }
    __builtin_amdgcn_sched_barrier(0);
    const int tid = tc.tid, lane = tid & 63, w = tid >> 6, c0 = (tid & 15) * 8, tl = lane & 15, kg = lane >> 4;
    LAS bf16_t* Ks = (LAS bf16_t*)(lds + LA_K); LAS float* Bs = (LAS float*)(lds + LA_B); LAS bf16_t* VT = (LAS bf16_t*)(lds + LA_VT); LAS bf16_t* KT = (LAS bf16_t*)(lds + LA_ST);
    float bl[8];
    { const f32x4 a = *(const LAS f32x4*)(Bs + (LA_C - 1) * LA_BS + c0), c = *(const LAS f32x4*)(Bs + (LA_C - 1) * LA_BS + c0 + 4);
      bl[0] = a.x; bl[1] = a.y; bl[2] = a.z; bl[3] = a.w; bl[4] = c.x; bl[5] = c.y; bl[6] = c.z; bl[7] = c.w; }
#pragma unroll
    for (int ps = 0; ps < 2; ++ps) {
        const int t = (tid >> 4) + 32 * ps;
        float k[8]; unpack8(*(const LAS u32x4*)(Ks + t * LA_QS + c0), k);
        const f32x4 a = *(const LAS f32x4*)(Bs + t * LA_BS + c0), c = *(const LAS f32x4*)(Bs + t * LA_BS + c0 + 4);
        const float bt[8] = {a.x, a.y, a.z, a.w, c.x, c.y, c.z, c.w};
#pragma unroll
        for (int j = 0; j < 8; ++j) KT[(c0 + j) * LA_VS + ((((t >> 3) ^ ((c0 >> 4) & 7)) << 3) | (t & 7))] = (bf16_t)f2bf(k[j] * fexp(bl[j] - bt[j]));
    }
    if (tid < 128) ((float*)(pws(p) + WS_LADEC))[(size_t)item * 128 + tid] = fexp(Bs[(LA_C - 1) * LA_BS + tid]);
    __syncthreads();
    f32x4 acc[8];
#pragma unroll
    for (int cb = 0; cb < 8; ++cb) acc[cb] = (f32x4){0.f, 0.f, 0.f, 0.f};
#pragma unroll
    for (int ks = 0; ks < 2; ++ks) {
        const bf16x8 a = *(const LAS bf16x8*)(VT + (16 * w + tl) * LA_VS + ks * 32 + 8 * kg);
#pragma unroll
        for (int cb = 0; cb < 8; ++cb) {
            const bf16x8 bb = *(const LAS bf16x8*)(KT + (cb * 16 + tl) * LA_VS + 8 * ((ks * 4 + kg) ^ cb));
            acc[cb] = __builtin_amdgcn_mfma_f32_16x16x32_bf16(a, bb, acc[cb], 0, 0, 0);
        }
    }
    bf16_t* st = (bf16_t*)(pws(p) + WS_LAST) + (size_t)item * 16384;
#pragma unroll
    for (int cb = 0; cb < 8; ++cb)
#pragma unroll
        for (int r = 0; r < 4; ++r) st[(16 * w + kg * 4 + r) * 128 + cb * 16 + tl] = (bf16_t)f2bf(acc[cb][r]);
    __syncthreads();
}

DI void la_scan(const TC tc, PRM p) {
    bf16_t* ST = (bf16_t*)(pws(p) + WS_LAST); const float* DEC = (const float*)(pws(p) + WS_LADEC);
    for (int gid = tc.bid * 512 + tc.tid; gid < 16 * 8192; gid += tc.nb * 512) {
        const int seq = gid >> 13, e = (gid & 8191) * 2, k = e & 127;
        unsigned* st = (unsigned*)(ST + (size_t)seq * LA_NCH * 16384 + e); const float* dc = DEC + (size_t)seq * LA_NCH * 128 + k;
        float s0 = 0.f, s1 = 0.f;
        for (int n0 = 0; n0 < LA_NCH; n0 += 32) {
            unsigned kv[32]; float d0[32], d1[32];
#pragma unroll
            for (int u = 0; u < 32; ++u) { kv[u] = st[(size_t)(n0 + u) * 8192]; d0[u] = dc[(n0 + u) * 128]; d1[u] = dc[(n0 + u) * 128 + 1]; }
#pragma unroll
            for (int u = 0; u < 32; ++u) { if (tc.nostore && s0 == 12345.678f) st[0] = 1u; if (!tc.nostore) st[(size_t)(n0 + u) * 8192] = pk2(s0, s1); s0 = d0[u] * s0 + bflo(kv[u]); s1 = d1[u] * s1 + bfhi(kv[u]); }
        }
    }
}

DI void la_phaseC(const TC tc, PRM p, int l, int item, LaPreC& pre, int next_item, LAS unsigned char* lds) {
    const int n = item % LA_NCH, h = (item / LA_NCH) & 3, b = (item / (LA_NCH * 4)) & 1, m = item / (LA_NCH * 4 * NB);
    int tid = tc.tid; asm volatile("" : "+v"(tid));
    const int lane = tid & 63, w = tid >> 6, tl = lane & 15, kg = lane >> 4, rb = w >> 1, vh = w & 1;
    bf16_t gatev[4][4];
    {
        const bf16_t* pg = (const bf16_t*)(pws(p) + WS_PROJ) + ((size_t)b * SEQ + (size_t)n * LA_C + 16 * rb + kg * 4) * INC + (m == 0 ? C_HGG : C_RTG) + h * 128 + vh * 64 + tl;
#pragma unroll
        for (int r = 0; r < 4; ++r)
#pragma unroll
            for (int vb = 0; vb < 4; ++vb) gatev[r][vb] = pg[(size_t)r * INC + vb * 16];
    }
    { TC t2 = tc; asm volatile("" : "+v"(t2.tid)); laC_commit(t2, p, l, item, pre, lds); }
    __builtin_amdgcn_sched_barrier(0);
    if (next_item >= 0) { TC t3 = tc; asm volatile("" : "+v"(t3.tid)); laC_issue(t3, p, next_item, pre); }
    __builtin_amdgcn_sched_barrier(0);
    LAS bf16_t* Qs = (LAS bf16_t*)(lds + LA_Q); LAS bf16_t* Ks = (LAS bf16_t*)(lds + LA_K); LAS float* Bs = (LAS float*)(lds + LA_B); LAS bf16_t* VT = (LAS bf16_t*)(lds + LA_VT);
    LAS bf16_t* STs = (LAS bf16_t*)(lds + LA_ST); LAS bf16_t* Ps = (LAS bf16_t*)(lds + LA_P); LAS float* Xs = (LAS float*)(lds + LA_X);
    const float lgam = ((const float*)(pws(p) + WS_TAB))[16384 + 1024 + h];
    if (m == 0) {
        const int c0 = (tid & 15) * 8;
#pragma unroll
        for (int ps = 0; ps < 2; ++ps) {
            const int t = (tid >> 4) + 32 * ps, te = (t | 15);
            float k[8]; unpack8(*(const LAS u32x4*)(Ks + t * LA_QS + c0), k);
            const f32x4 a = *(const LAS f32x4*)(Bs + t * LA_BS + c0), c = *(const LAS f32x4*)(Bs + t * LA_BS + c0 + 4);
            const f32x4 ea = *(const LAS f32x4*)(Bs + te * LA_BS + c0), ec = *(const LAS f32x4*)(Bs + te * LA_BS + c0 + 4);
            const float bt[8] = {a.x, a.y, a.z, a.w, c.x, c.y, c.z, c.w}, be[8] = {ea.x, ea.y, ea.z, ea.w, ec.x, ec.y, ec.z, ec.w};
#pragma unroll
            for (int j = 0; j < 8; ++j) k[j] *= fexp(be[j] - bt[j]);
            *(LAS bf16x8*)(Ks + t * LA_QS + c0) = pack8(k);
        }
        __syncthreads();
    }
    f32x4 acc1[4];
#pragma unroll
    for (int vb = 0; vb < 4; ++vb) acc1[vb] = (f32x4){0.f, 0.f, 0.f, 0.f};
    if (m == 1) {
        bf16x8 qa[4];
#pragma unroll
        for (int ks = 0; ks < 4; ++ks) qa[ks] = *(const LAS bf16x8*)(Qs + (16 * rb + tl) * LA_QS + ks * 32 + 8 * kg);
#pragma unroll
        for (int ks = 0; ks < 4; ++ks)
#pragma unroll
            for (int vb = 0; vb < 4; ++vb) acc1[vb] = __builtin_amdgcn_mfma_f32_16x16x32_bf16(qa[ks], *(const LAS bf16x8*)(STs + (vh * 64 + vb * 16 + tl) * LA_SS + ks * 32 + 8 * kg), acc1[vb], 0, 0, 0);
#pragma unroll
        for (int r = 0; r < 4; ++r) { const float dq = fexp(lgam * (float)(16 * rb + kg * 4 + r + 1));
#pragma unroll
            for (int vb = 0; vb < 4; ++vb) acc1[vb][r] *= dq; }
        for (int cb = 0; cb <= rb; ++cb) {
            f32x4 sc = (f32x4){0.f, 0.f, 0.f, 0.f};
#pragma unroll
            for (int ks = 0; ks < 4; ++ks) sc = __builtin_amdgcn_mfma_f32_16x16x32_bf16(qa[ks], *(const LAS bf16x8*)(Ks + (cb * 16 + tl) * LA_QS + ks * 32 + 8 * kg), sc, 0, 0, 0);
#pragma unroll
            for (int r = 0; r < 4; ++r) { const int dts = (16 * rb + kg * 4 + r) - (cb * 16 + tl);
                const float v = dts >= 0 ? sc[r] * fexp(lgam * (float)dts) : 0.f; Ps[(16 * rb + kg * 4 + r) * LA_PS + cb * 16 + tl] = (bf16_t)f2bf(v); }
        }
    } else {
        bf16x8 qw[4], q0[4];
#pragma unroll
        for (int ks = 0; ks < 4; ++ks) {
            const int kc = ks * 32 + 8 * kg;
            float bw[8];
            if (rb > 0) { const f32x4 a = *(const LAS f32x4*)(Bs + (16 * rb - 1) * LA_BS + kc), c = *(const LAS f32x4*)(Bs + (16 * rb - 1) * LA_BS + kc + 4);
                bw[0] = a.x; bw[1] = a.y; bw[2] = a.z; bw[3] = a.w; bw[4] = c.x; bw[5] = c.y; bw[6] = c.z; bw[7] = c.w; }
            else {
#pragma unroll
                for (int j = 0; j < 8; ++j) bw[j] = 0.f; }
            float q[8]; unpack8(*(const LAS u32x4*)(Qs + (16 * rb + tl) * LA_QS + kc), q);
            const f32x4 a = *(const LAS f32x4*)(Bs + (16 * rb + tl) * LA_BS + kc), c = *(const LAS f32x4*)(Bs + (16 * rb + tl) * LA_BS + kc + 4);
            const float bt[8] = {a.x, a.y, a.z, a.w, c.x, c.y, c.z, c.w};
            float x0[8], x1[8];
#pragma unroll
            for (int j = 0; j < 8; ++j) { x1[j] = q[j] * fexp(bt[j] - bw[j]); x0[j] = q[j] * fexp(bt[j]); }
            q0[ks] = pack8(x0); qw[ks] = pack8(x1);
        }
#pragma unroll
        for (int ks = 0; ks < 4; ++ks)
#pragma unroll
            for (int vb = 0; vb < 4; ++vb) acc1[vb] = __builtin_amdgcn_mfma_f32_16x16x32_bf16(q0[ks], *(const LAS bf16x8*)(STs + (vh * 64 + vb * 16 + tl) * LA_SS + ks * 32 + 8 * kg), acc1[vb], 0, 0, 0);
        for (int cb = 0; cb <= rb; ++cb) {
            f32x4 sc = (f32x4){0.f, 0.f, 0.f, 0.f};
            if (cb == rb) {
#pragma unroll
                for (int ks = 0; ks < 4; ++ks) {
                    const int kc = ks * 32 + 8 * kg;
                    float q[8]; unpack8(*(const LAS u32x4*)(Qs + (16 * rb + tl) * LA_QS + kc), q);
                    const f32x4 a = *(const LAS f32x4*)(Bs + (16 * rb + tl) * LA_BS + kc), c = *(const LAS f32x4*)(Bs + (16 * rb + tl) * LA_BS + kc + 4);
                    const f32x4 na = *(const LAS f32x4*)(Bs + (16 * rb + 15) * LA_BS + kc), nc = *(const LAS f32x4*)(Bs + (16 * rb + 15) * LA_BS + kc + 4);
                    const float bt[8] = {a.x, a.y, a.z, a.w, c.x, c.y, c.z, c.w}, bn[8] = {na.x, na.y, na.z, na.w, nc.x, nc.y, nc.z, nc.w};
#pragma unroll
                    for (int j = 0; j < 8; ++j) q[j] *= fexp(fminf(bt[j] - bn[j], 80.0f));
                    sc = __builtin_amdgcn_mfma_f32_16x16x32_bf16(pack8(q), *(const LAS bf16x8*)(Ks + (cb * 16 + tl) * LA_QS + kc), sc, 0, 0, 0);
                }
            } else {
#pragma unroll
                for (int ks = 0; ks < 4; ++ks) {
                    const int kc = ks * 32 + 8 * kg;
                    bf16x8 af;
                    if (cb == rb - 1) af = qw[ks];
                    else {
                        float q[8]; unpack8(*(const LAS u32x4*)(Qs + (16 * rb + tl) * LA_QS + kc), q);
                        const f32x4 a = *(const LAS f32x4*)(Bs + (16 * rb + tl) * LA_BS + kc), c = *(const LAS f32x4*)(Bs + (16 * rb + tl) * LA_BS + kc + 4);
                        const f32x4 ea = *(const LAS f32x4*)(Bs + (16 * cb + 15) * LA_BS + kc), ec = *(const LAS f32x4*)(Bs + (16 * cb + 15) * LA_BS + kc + 4);
                        const float bt[8] = {a.x, a.y, a.z, a.w, c.x, c.y, c.z, c.w}, be[8] = {ea.x, ea.y, ea.z, ea.w, ec.x, ec.y, ec.z, ec.w};
#pragma unroll
                        for (int j = 0; j < 8; ++j) q[j] *= fexp(bt[j] - be[j]);
                        af = pack8(q);
                    }
                    sc = __builtin_amdgcn_mfma_f32_16x16x32_bf16(af, *(const LAS bf16x8*)(Ks + (cb * 16 + tl) * LA_QS + kc), sc, 0, 0, 0);
                }
            }
#pragma unroll
            for (int r = 0; r < 4; ++r) { const float v = (cb < rb || tl <= kg * 4 + r) ? sc[r] : 0.f; Ps[(16 * rb + kg * 4 + r) * LA_PS + cb * 16 + tl] = (bf16_t)f2bf(v); }
        }
    }
    if ((rb & 1) == 0) {
#pragma unroll
        for (int r = 0; r < 4; ++r) Ps[(16 * rb + kg * 4 + r) * LA_PS + (rb + 1) * 16 + tl] = (bf16_t)0;
    }
    const int nks = (rb >> 1) + 1;
    for (int ks = 0; ks < nks; ++ks) {
        const bf16x8 a = *(const LAS bf16x8*)(Ps + (16 * rb + tl) * LA_PS + ks * 32 + 8 * kg);
#pragma unroll
        for (int vb = 0; vb < 4; ++vb) acc1[vb] = __builtin_amdgcn_mfma_f32_16x16x32_bf16(a, *(const LAS bf16x8*)(VT + (vh * 64 + vb * 16 + tl) * LA_VS + ks * 32 + 8 * kg), acc1[vb], 0, 0, 0);
    }
    float s1[4], s2[4];
#pragma unroll
    for (int r = 0; r < 4; ++r) { float a = 0.f, q = 0.f;
#pragma unroll
        for (int vb = 0; vb < 4; ++vb) { acc1[vb][r] *= 0.08838834764831845f; a += acc1[vb][r]; q += acc1[vb][r] * acc1[vb][r]; }
        a += sx<1>(a); a += sx<2>(a); a += sx<4>(a); a += sx<8>(a);
        q += sx<1>(q); q += sx<2>(q); q += sx<4>(q); q += sx<8>(q);
        s1[r] = a; s2[r] = q;
        if (tl == 0) { Xs[((16 * rb + kg * 4 + r) * 2 + vh) * 2] = a; Xs[((16 * rb + kg * 4 + r) * 2 + vh) * 2 + 1] = q; } }
    __syncthreads();
    const bf16_t* PROJ = (const bf16_t*)(pws(p) + WS_PROJ);
    bf16_t* OBm = (bf16_t*)(pws(p) + WS_OB) + (size_t)(m == 0 ? 0 : 2) * T * 512;
    const float* hnorm = (const float*)pin(p, I_HG_NORM) + l * 512 + h * 128;
#pragma unroll
    for (int r = 0; r < 4; ++r) {
        const int t = 16 * rb + kg * 4 + r; const size_t tok = (size_t)b * SEQ + (size_t)n * LA_C + t;
        const float a = s1[r] + Xs[(t * 2 + (vh ^ 1)) * 2], q = s2[r] + Xs[(t * 2 + (vh ^ 1)) * 2 + 1];
        float mu = 0.f, rs;
        if (m == 0) rs = frsq(q * (1.0f / 128.0f) + EPS);
        else { mu = a * (1.0f / 128.0f); rs = frsq(fmaxf(q * (1.0f / 128.0f) - mu * mu, 0.f) + EPS); }
#pragma unroll
        for (int vb = 0; vb < 4; ++vb) {
            const int v = vh * 64 + vb * 16 + tl;
            const float gt = bf2f(gatev[r][vb]);
            float o = (acc1[vb][r] - mu) * rs * siluf_(gt);
            if (m == 0) o *= hnorm[v];
            OBm[tok * 512 + h * 128 + v] = (bf16_t)f2bf(o);
        }
    }
    __syncthreads();
}

DI void mixer_post(const TC tc, PRM p, int l) {
    const bf16_t* PROJ = (const bf16_t*)(pws(p) + WS_PROJ);
    const float* OT = (const float*)(pws(p) + WS_OTMP);
    bf16_t* OB = (bf16_t*)(pws(p) + WS_OB); bf16_t* YS5 = (bf16_t*)(pws(p) + WS_YS5);
    const float* hnorm = (const float*)pin(p, I_HG_NORM) + l * 512; const float* s5d = (const float*)pin(p, I_S5_D) + l * 512;
    const int lane = tc.tid & 63, gw = tc.bid * 8 + (tc.tid >> 6), NGW = tc.nb * 8, c0 = lane * 8;
    for (int t = gw; t < T; t += NGW) {
        const bf16_t* prow = PROJ + (size_t)t * INC;
        if (!LA_HG) {
            float o[8], g[8], r[8];
            const f32x4 a = *(const f32x4*)(OT + (size_t)t * 512 + c0), bq = *(const f32x4*)(OT + (size_t)t * 512 + c0 + 4);
            o[0] = a.x; o[1] = a.y; o[2] = a.z; o[3] = a.w; o[4] = bq.x; o[5] = bq.y; o[6] = bq.z; o[7] = bq.w;
            float ss = 0.f;
#pragma unroll
            for (int j = 0; j < 8; ++j) ss += o[j] * o[j];
            ss += sx<8>(ss); ss += sx<4>(ss); ss += sx<2>(ss); ss += sx<1>(ss);
            const float sc = 1.0f / sqrtf(ss * (1.0f / 128.0f) + EPS);
            load8_bf16(prow + C_HGG + c0, g);
#pragma unroll
            for (int j = 0; j < 8; ++j) r[j] = o[j] * sc * hnorm[c0 + j] * siluf_(g[j]);
            store8_bf16(OB + (size_t)t * 512 + c0, r);
        }
        if (!LA_RT) {
            float o[8], g[8], r[8];
            const float* src = OT + (size_t)2 * T * 512 + (size_t)t * 512 + c0;
            const f32x4 a = *(const f32x4*)src, bq = *(const f32x4*)(src + 4);
            o[0] = a.x; o[1] = a.y; o[2] = a.z; o[3] = a.w; o[4] = bq.x; o[5] = bq.y; o[6] = bq.z; o[7] = bq.w;
            float s = 0.f;
#pragma unroll
            for (int j = 0; j < 8; ++j) s += o[j];
            s += sx<8>(s); s += sx<4>(s); s += sx<2>(s); s += sx<1>(s);
            const float mu = s * (1.0f / 128.0f);
            float q = 0.f;
#pragma unroll
            for (int j = 0; j < 8; ++j) { o[j] -= mu; q += o[j] * o[j]; }
            q += sx<8>(q); q += sx<4>(q); q += sx<2>(q); q += sx<1>(q);
            const float sc = 1.0f / sqrtf(q * (1.0f / 128.0f) + EPS);
            load8_bf16(prow + C_RTG + c0, g);
#pragma unroll
            for (int j = 0; j < 8; ++j) r[j] = o[j] * sc * siluf_(g[j]);
            store8_bf16(OB + (size_t)2 * T * 512 + (size_t)t * 512 + c0, r);
        }
    }
}

DI unsigned f2key(float x) { const unsigned u = __float_as_uint(x); return u ^ ((u >> 31) ? 0xffffffffu : 0x80000000u); }
DI float key2f(unsigned k) { const unsigned u = (k >> 31) ? (k ^ 0x80000000u) : ~k; return __uint_as_float(u); }
#define CE_DESC(a, b) do { const unsigned _x = (a), _y = (b); (a) = _x > _y ? _x : _y; (b) = _x > _y ? _y : _x; } while (0)
DI void sort16_desc(unsigned (&v)[16]) {
#pragma unroll
    for (int k = 2; k <= 16; k <<= 1)
#pragma unroll
        for (int j = k >> 1; j > 0; j >>= 1)
#pragma unroll
            for (int i = 0; i < 16; ++i) { const int q = i ^ j; if (q > i) { if ((i & k) == 0) CE_DESC(v[i], v[q]); else CE_DESC(v[q], v[i]); } }
}
DI void merge16_desc(unsigned (&r)[16], const unsigned (&g)[16]) {
#pragma unroll
    for (int i = 0; i < 16; ++i) r[i] = r[i] > g[15 - i] ? r[i] : g[15 - i];
#pragma unroll
    for (int j = 8; j > 0; j >>= 1)
#pragma unroll
        for (int i = 0; i < 16; ++i) if ((i & j) == 0) CE_DESC(r[i], r[i + j]);
}
DI void top16_of_128(const unsigned short* row, unsigned (&r)[16]) {
    u32x4 nx[2];
#pragma unroll
    for (int q = 0; q < 2; ++q) nx[q] = *(const u32x4*)(row + q * 8);
#pragma unroll 1
    for (int gi = 0; gi < 8; ++gi) {
        unsigned g[16];
        f32x4 cv[4];
#pragma unroll
        for (int q = 0; q < 2; ++q) { const u32x4 w = nx[q];
            cv[2 * q] = (f32x4){h2f((unsigned short)w.x), h2f((unsigned short)(w.x >> 16)), h2f((unsigned short)w.y), h2f((unsigned short)(w.y >> 16))};
            cv[2 * q + 1] = (f32x4){h2f((unsigned short)w.z), h2f((unsigned short)(w.z >> 16)), h2f((unsigned short)w.w), h2f((unsigned short)(w.w >> 16))}; }
        if (gi < 7) {
#pragma unroll
            for (int q = 0; q < 2; ++q) nx[q] = *(const u32x4*)(row + (gi + 1) * 16 + q * 8); }
#pragma unroll
        for (int q = 0; q < 4; ++q) { const f32x4 v = cv[q]; const unsigned ib = 127u - (unsigned)(gi * 16 + q * 4);
            g[q * 4 + 0] = (f2key(v.x) & ~127u) | ib; g[q * 4 + 1] = (f2key(v.y) & ~127u) | (ib - 1u); g[q * 4 + 2] = (f2key(v.z) & ~127u) | (ib - 2u); g[q * 4 + 3] = (f2key(v.w) & ~127u) | (ib - 3u); }
        sort16_desc(g);
        if (gi == 0) {
#pragma unroll
            for (int i = 0; i < 16; ++i) r[i] = g[i];
        } else merge16_desc(r, g);
    }
}
DI void peer_route(const TC tc, PRM p, LAS unsigned char* lds) {
    const unsigned short* SC = (const unsigned short*)(pws(p) + WS_SC);
    float* GATE = (float*)(pws(p) + WS_GATE);
    LAS unsigned short* li = (LAS unsigned short*)lds;
    for (int it = tc.bid * 512 + tc.tid; it < T * 8; it += tc.nb * 512) {
        unsigned r1[16], r2[16];
        top16_of_128(SC + (size_t)it * 256, r1);
        top16_of_128(SC + (size_t)it * 256 + 128, r2);
        float s1[16], s2[16];
#pragma unroll
        for (int i = 0; i < 16; ++i) { li[i * 512 + tc.tid] = (unsigned short)(127u - (r1[i] & 127u)); li[(16 + i) * 512 + tc.tid] = (unsigned short)(127u - (r2[i] & 127u));
            s1[i] = key2f(r1[i] & ~127u); s2[i] = key2f(r2[i] & ~127u); }
        unsigned best[16];
#pragma unroll
        for (int gi = 0; gi < 4; ++gi) {
            unsigned g[16];
#pragma unroll
            for (int q = 0; q < 16; ++q) {
                constexpr int CI[64] = {0,0,0,0,0,0,0,0,0,0,0,0,0,0,0,0, 1,1,1,1,1,1,1,1, 2,2,2,2,2, 3,3,3,3, 4,4,4, 5,5, 6,6, 7,7, 8,9,10,11,12,13,14,15, -1,-1,-1,-1,-1,-1,-1,-1,-1,-1,-1,-1,-1,-1};
                constexpr int CJ[64] = {0,1,2,3,4,5,6,7,8,9,10,11,12,13,14,15, 0,1,2,3,4,5,6,7, 0,1,2,3,4, 0,1,2,3, 0,1,2, 0,1, 0,1, 0,1, 0,0,0,0,0,0,0,0, 0,0,0,0,0,0,0,0,0,0,0,0,0,0};
                const int ci = CI[gi * 16 + q], cj = CJ[gi * 16 + q];
                g[q] = ci < 0 ? 0u : ((f2key(s1[ci < 0 ? 0 : ci] + s2[cj]) & ~255u) | (255u - (unsigned)((ci < 0 ? 0 : ci) * 16 + cj)));
            }
            sort16_desc(g);
            if (gi == 0) {
#pragma unroll
                for (int i = 0; i < 16; ++i) best[i] = g[i];
            } else merge16_desc(best, g);
        }
        float e[16], sum = 0.f; const float m0 = key2f(best[0] & ~255u);
        int ids[16];
#pragma unroll
        for (int s = 0; s < 16; ++s) { const unsigned pos = 255u - (best[s] & 255u); const int i1 = li[(pos >> 4) * 512 + tc.tid], i2 = li[(16 + (pos & 15u)) * 512 + tc.tid];
            ids[s] = i1 * 128 + i2; e[s] = fexp(key2f(best[s] & ~255u) - m0); sum += e[s]; }
        const float inv = frcp(sum);
#pragma unroll
        for (int s = 0; s < 16; s += 4) {
            *(u32x2*)((unsigned short*)(pws(p) + WS_IDX16) + (size_t)it * 16 + s) = (u32x2){(unsigned)ids[s] | ((unsigned)ids[s + 1] << 16), (unsigned)ids[s + 2] | ((unsigned)ids[s + 3] << 16)};
            *(f32x4*)(GATE + (size_t)it * 16 + s) = (f32x4){e[s] * inv, e[s + 1] * inv, e[s + 2] * inv, e[s + 3] * inv};
        }
    }
}

DI void peer_convert(const TC tc, PRM p, int l) {
    const float* U = (const float*)pin(p, I_PEER_U) + (size_t)l * NEXP * D; const float* V = (const float*)pin(p, I_PEER_V) + (size_t)l * NEXP * D;
    unsigned char* UB = pws(p) + WS_PEERU; unsigned char* VB = pws(p) + WS_PEERV; float* SCL = (float*)(pws(p) + WS_PEERS);
    const int lane = tc.tid & 63, gw = tc.bid * 8 + (tc.tid >> 6), NGW = tc.nb * 8;
    f32x4 nx[4], ny[4];
#pragma unroll
    for (int q = 0; q < 4; ++q) { nx[q] = (f32x4){0.f, 0.f, 0.f, 0.f}; ny[q] = nx[q]; }
    if (gw < 2 * NEXP) { const float* s = (gw < NEXP ? U + (size_t)gw * D : V + (size_t)(gw - NEXP) * D) + lane * 16;
#pragma unroll
        for (int q = 0; q < 4; ++q) nx[q] = __builtin_nontemporal_load((const f32x4*)(s + 4 * q)); }
    if (gw + NGW < 2 * NEXP) { const int rn = gw + NGW; const float* s = (rn < NEXP ? U + (size_t)rn * D : V + (size_t)(rn - NEXP) * D) + lane * 16;
#pragma unroll
        for (int q = 0; q < 4; ++q) ny[q] = __builtin_nontemporal_load((const f32x4*)(s + 4 * q)); }
    for (int r = gw; r < 2 * NEXP; r += NGW) {
        f32x4 v[4];
#pragma unroll
        for (int q = 0; q < 4; ++q) { v[q] = nx[q]; nx[q] = ny[q]; }
        { const int rn = r + 2 * NGW;
          if (rn < 2 * NEXP) { const float* s = (rn < NEXP ? U + (size_t)rn * D : V + (size_t)(rn - NEXP) * D) + lane * 16;
#pragma unroll
              for (int q = 0; q < 4; ++q) ny[q] = __builtin_nontemporal_load((const f32x4*)(s + 4 * q)); } }
        float am = 0.f;
#pragma unroll
        for (int q = 0; q < 4; ++q) am = fmaxf(fmaxf(am, fmaxf(fabsf(v[q].x), fabsf(v[q].y))), fmaxf(fabsf(v[q].z), fabsf(v[q].w)));
        am = fmaxf(wave_max(am), 1e-30f);
        int ex = 8 - (int)((__float_as_uint(am) >> 23) & 0xffu) + 127;
        ex = ex > 120 ? 120 : (ex < -120 ? -120 : ex);
        float sc = __uint_as_float((unsigned)(ex + 127) << 23);
        if (am * sc > 448.0f) sc *= 0.5f;
        u32x4 w;
        int t0 = 0, t1 = 0, t2 = 0, t3 = 0;
        t0 = __builtin_amdgcn_cvt_pk_fp8_f32(v[0].x * sc, v[0].y * sc, t0, false); t0 = __builtin_amdgcn_cvt_pk_fp8_f32(v[0].z * sc, v[0].w * sc, t0, true);
        t1 = __builtin_amdgcn_cvt_pk_fp8_f32(v[1].x * sc, v[1].y * sc, t1, false); t1 = __builtin_amdgcn_cvt_pk_fp8_f32(v[1].z * sc, v[1].w * sc, t1, true);
        t2 = __builtin_amdgcn_cvt_pk_fp8_f32(v[2].x * sc, v[2].y * sc, t2, false); t2 = __builtin_amdgcn_cvt_pk_fp8_f32(v[2].z * sc, v[2].w * sc, t2, true);
        t3 = __builtin_amdgcn_cvt_pk_fp8_f32(v[3].x * sc, v[3].y * sc, t3, false); t3 = __builtin_amdgcn_cvt_pk_fp8_f32(v[3].z * sc, v[3].w * sc, t3, true);
        w.x = (unsigned)t0; w.y = (unsigned)t1; w.z = (unsigned)t2; w.w = (unsigned)t3;
        *(u32x4*)((r < NEXP ? UB : VB) + (size_t)(lane >> 3) * ((size_t)NEXP * 128) + (size_t)(r < NEXP ? r : r - NEXP) * 128 + (lane & 7) * 16) = w;
        if (lane == 0) SCL[r] = 1.0f / sc;
    }
}
DI void unpack_fp8x16(const u32x4 w, float (&o)[16]) {
    typedef float f32x2 __attribute__((ext_vector_type(2)));
    const unsigned ww[4] = {w.x, w.y, w.z, w.w};
#pragma unroll
    for (int q = 0; q < 4; ++q) { const f32x2 a = __builtin_amdgcn_cvt_pk_f32_fp8((int)ww[q], false), b = __builtin_amdgcn_cvt_pk_f32_fp8((int)ww[q], true);
        o[4 * q] = a.x; o[4 * q + 1] = a.y; o[4 * q + 2] = b.x; o[4 * q + 3] = b.y; }
}
typedef __amdgpu_buffer_rsrc_t brsrc_t;
DI brsrc_t mk_rsrc(const void* base) { return __builtin_amdgcn_make_buffer_rsrc((void*)base, 0, 0x7fffffff, 0x00020000); }
DI u32x4 bld4(brsrc_t r, unsigned voff, unsigned soff, int imm) { return __builtin_amdgcn_raw_buffer_load_b128(r, (int)voff + imm, (int)soff, 0); }
DI u32x2 bld2(brsrc_t r, unsigned voff, unsigned soff, int imm) { return __builtin_amdgcn_raw_buffer_load_b64(r, (int)voff + imm, (int)soff, 0); }
DI long pu_op(unsigned lo, unsigned hi) { u32x2 w; w.x = lo; w.y = hi; return __builtin_bit_cast(long, w); }
struct PuG { u32x4 g[16]; };
DI void pu_issue(brsrc_t ru, unsigned soff, unsigned vc, const u32x4 (&id)[2], PuG& G) {
#pragma unroll
    for (int n = 0; n < 16; ++n) { const unsigned w = id[n >> 3][(n >> 1) & 3]; const unsigned e7 = (n & 1) ? ((w >> 9) & 0x7fff80u) : ((w << 7) & 0x7fff80u); G.g[n] = bld4(ru, e7 + vc, soff, 0); }
}
DI void peer_experts_u(const TC tc, PRM p, int l, LAS unsigned char* lds) {
    const unsigned short* IDX16 = (const unsigned short*)(pws(p) + WS_IDX16); float* GATE = (float*)(pws(p) + WS_GATE); const float* SCL = (const float*)(pws(p) + WS_PEERS);
    const brsrc_t ru = mk_rsrc(pws(p) + WS_PEERU), ri = mk_rsrc(pws(p) + WS_IDX16), rh = mk_rsrc(pws(p) + WS_HQ);
    const int lane = tc.tid & 63, r16 = lane & 15, kg = lane >> 4, r8 = lane >> 3, c8 = lane & 7, xs = rfl(tc.bid & 7);
    const int wv = rfl(tc.tid >> 6), gw = rfl(tc.bid * 8 + wv), NGW = rfl(tc.nb * 8);
    const unsigned vid = (unsigned)r8 * 32u, vc = (unsigned)c8 * 16u, vh = (unsigned)kg * 8u;
    LAS unsigned char* wl = lds + wv * 16384;
    LAS unsigned char* wp = wl + r8 * 128 + ((c8 ^ r8) << 4);
    LAS unsigned char* rp[4];
#pragma unroll
    for (int s = 0; s < 4; ++s) rp[s] = wl + r16 * 128 + (((2 * s + (kg >> 1)) ^ (r16 & 7)) << 4) + (kg & 1) * 8;
    for (int tb = gw; tb < T; tb += NGW * 8) {
        f32x4 ah[8], al[8];
#pragma unroll
        for (int i = 0; i < 8; ++i) { ah[i] = (f32x4){0.f, 0.f, 0.f, 0.f}; al[i] = (f32x4){0.f, 0.f, 0.f, 0.f}; }
#define PU_TOK(i) ((unsigned)((tb + (i) * NGW) < T ? (tb + (i) * NGW) : T - 1))
#define PU_IDS(dst, i) do { const unsigned _o = PU_TOK(i) * 256u; dst[0] = bld4(ri, vid, _o, 0); dst[1] = bld4(ri, vid, _o, 16); } while (0)
#define PU_H(dst1, dst2, i, sl) do { const unsigned _o = PU_TOK(i) * (unsigned)D + (unsigned)(sl) * 128u; _Pragma("unroll") for (int _s = 0; _s < 4; ++_s) { dst1[_s] = bld2(rh, vh, _o, 32 * _s); \
        dst2[_s] = PEER_LO ? bld2(rh, vh, _o + (unsigned)(T * D), 32 * _s) : dst1[_s]; } } while (0)
        PuG G; u32x4 idn[2]; u32x2 hc1[4], hc2[4], hn1[4], hn2[4];
        { PU_IDS(idn, 0); PU_H(hc1, hc2, 0, xs); pu_issue(ru, (unsigned)xs * (unsigned)(NEXP * 128), vc, idn, G); PU_IDS(idn, 1); }
#pragma unroll 1
        for (int js = 0; js < 8; ++js) {
            const int sl = (tc.nostore && PROBE_SEL == 7) ? xs : ((js + xs) & 7), sln = (tc.nostore && PROBE_SEL == 7) ? xs : ((js + 1 + xs) & 7);
            const unsigned so = (unsigned)sl * (unsigned)(NEXP * 128), son = (unsigned)sln * (unsigned)(NEXP * 128);
#pragma unroll
            for (int i = 0; i < 8; ++i) {
#pragma unroll
                for (int n = 0; n < 16; ++n) *(LAS u32x4*)(wp + n * 1024) = G.g[n];
                pu_issue(ru, i == 7 ? son : so, vc, idn, G);
                PU_IDS(idn, (i + 2) & 7);
                PU_H(hn1, hn2, (i + 1) & 7, i == 7 ? sln : sl);
#pragma unroll
                for (int mb = 0; mb < 8; ++mb) {
                    const bool sel = (r16 == mb);
#pragma unroll
                    for (int s = 0; s < 4; ++s) {
                        const long ao = *(const LAS long*)(rp[s] + mb * 2048);
                        ah[i] = __builtin_amdgcn_mfma_f32_16x16x32_fp8_fp8(ao, pu_op(sel ? hc1[s].x : 0u, sel ? hc1[s].y : 0u), ah[i], 0, 0, 0);
                        if (PEER_LO) al[i] = __builtin_amdgcn_mfma_f32_16x16x32_fp8_fp8(ao, pu_op(sel ? hc2[s].x : 0u, sel ? hc2[s].y : 0u), al[i], 0, 0, 0);
                        asm volatile("s_nop 7");
                    }
                }
#pragma unroll
                for (int s = 0; s < 4; ++s) { hc1[s] = hn1[s]; hc2[s] = hn2[s]; }
            }
        }
        asm volatile("s_nop 15\n\ts_nop 15");
        unsigned char* AQ = pws(p) + WS_AQ; float* ASC = (float*)(pws(p) + WS_ASC);
#pragma unroll
        for (int i = 0; i < 8; ++i) {
            const int t = tb + i * NGW; const int tl = t < T ? t : T - 1;
            float act[4];
#pragma unroll
            for (int r = 0; r < 4; ++r) {
                const size_t o = (size_t)tl * 128 + 64 * (kg & 1) + 16 * r + 2 * (r16 & 7) + (kg >> 1);
                const int e = (int)IDX16[o]; const float a = (ah[i][r] + (PEER_LO ? al[i][r] * 0.0625f : 0.f)) * 0.125f * SCL[e];
                act[r] = (r16 < 8) ? gelu_tanh(a) * GATE[o] * SCL[NEXP + e] : 0.f;
            }
            float am = fmaxf(wave_max(fmaxf(fmaxf(fabsf(act[0]), fabsf(act[1])), fmaxf(fabsf(act[2]), fabsf(act[3])))), 1e-30f);
            int ex = 8 - (int)((__float_as_uint(am) >> 23) & 0xffu) + 127; ex = ex > 120 ? 120 : (ex < -120 ? -120 : ex);
            float sc = __uint_as_float((unsigned)(ex + 127) << 23); if (am * sc > 448.0f) sc *= 0.5f;
            typedef float f32x2 __attribute__((ext_vector_type(2)));
            const unsigned q1 = fp8x4(act[0] * sc, act[1] * sc, act[2] * sc, act[3] * sc);
            const f32x2 d0 = __builtin_amdgcn_cvt_pk_f32_fp8((int)q1, false), d1 = __builtin_amdgcn_cvt_pk_f32_fp8((int)q1, true);
            const unsigned q2 = fp8x4((act[0] * sc - d0.x) * 16.0f, (act[1] * sc - d0.y) * 16.0f, (act[2] * sc - d1.x) * 16.0f, (act[3] * sc - d1.y) * 16.0f);
            if (t < T && r16 < 8 && (!tc.nostore || q1 == 0x12345678u)) {
                unsigned char* d = AQ + (size_t)t * 256 + (2 * (r16 & 1) + (kg >> 1)) * 32 + (r16 >> 1) * 8 + 4 * (kg & 1);
                *(unsigned*)d = q1; *(unsigned*)(d + 128) = q2;
                if (lane == 0) ASC[t] = 1.0f / sc;
            }
        }
#undef PU_TOK
#undef PU_IDS
#undef PU_H
    }
}
DI void peer_experts_v(const TC tc, PRM p, LAS unsigned char* lds) {
    typedef int i32x2_ __attribute__((ext_vector_type(2)));
    const brsrc_t rv = mk_rsrc(pws(p) + WS_PEERV), ri = mk_rsrc(pws(p) + WS_IDX16), ra = mk_rsrc(pws(p) + WS_AQ);
    const float* ASC = (const float*)(pws(p) + WS_ASC); float* X = pout(p);
    const int lane = tc.tid & 63, r16 = lane & 15, kg = lane >> 4, r8 = lane >> 3, c8 = lane & 7;
    const int xs = rfl(tc.bid & 7), rank = rfl(tc.bid >> 3), nrank = rfl(tc.nb >> 3), wv = rfl(tc.tid >> 6), tstep = nrank * 8;
    if (rank >= nrank) return;
    const unsigned vid = (unsigned)r8 * 32u, vc = (unsigned)c8 * 16u, va = (unsigned)(r16 & 1) * 128u + (unsigned)kg * 32u, so = (unsigned)xs * (unsigned)(NEXP * 128);
    LAS unsigned char* wl = lds + wv * 16384;
    LAS unsigned char* wp = wl + r8 * 128 + ((c8 ^ r8) << 4);
    LAS unsigned char* tp[8];
#pragma unroll
    for (int cb = 0; cb < 8; ++cb) tp[cb] = wl + (8 * kg + (r16 >> 1)) * 128 + ((cb ^ (r16 >> 1)) << 4) + 8 * (r16 & 1);
#define PV_IDS(dst, t) do { const unsigned _o = (unsigned)(t) * 256u; dst[0] = bld4(ri, vid, _o, 0); dst[1] = bld4(ri, vid, _o, 16); } while (0)
    int t = rank * 8 + wv;
    PuG G0, G1; u32x4 idn[2]; u32x4 aq0, aq1; float asc;
    if (t < T) { PV_IDS(idn, t); pu_issue(rv, so, vc, idn, G0); aq0 = bld4(ra, va, (unsigned)t * 256u, 0); aq1 = bld4(ra, va, (unsigned)t * 256u, 16); asc = ASC[t];
                 if (t + tstep < T) { PV_IDS(idn, t + tstep); pu_issue(rv, so, vc, idn, G1); }
                 if (t + 2 * tstep < T) PV_IDS(idn, t + 2 * tstep); }
#define PV_STEP(G, tt) do { \
        _Pragma("unroll") for (int n = 0; n < 16; ++n) *(LAS u32x4*)(wp + n * 1024) = G.g[n]; \
        const u32x4 ca0 = aq0, ca1 = aq1; const float casc = asc; \
        const int tn = (tt) + tstep, tn2 = (tt) + 2 * tstep; \
        if (tn2 < T) { pu_issue(rv, so, vc, idn, G); if (tn2 + tstep < T) PV_IDS(idn, tn2 + tstep); } \
        if (tn < T) { aq0 = bld4(ra, va, (unsigned)tn * 256u, 0); aq1 = bld4(ra, va, (unsigned)tn * 256u, 16); asc = ASC[tn]; } \
        float* xr = X + (size_t)(tt) * D + xs * 128 + r16; \
        float xv[8]; \
        if (kg == 0) { _Pragma("unroll") for (int cb = 0; cb < 8; ++cb) xv[cb] = xr[cb * 16]; } \
        const bool sel = r16 < 2; \
        long aop[4]; \
        aop[0] = pu_op(sel ? ca0.x : 0u, sel ? ca0.y : 0u); aop[1] = pu_op(sel ? ca0.z : 0u, sel ? ca0.w : 0u); \
        aop[2] = pu_op(sel ? ca1.x : 0u, sel ? ca1.y : 0u); aop[3] = pu_op(sel ? ca1.z : 0u, sel ? ca1.w : 0u); \
        f32x4 acc[8]; \
        _Pragma("unroll") for (int cb = 0; cb < 8; ++cb) { \
            acc[cb] = (f32x4){0.f, 0.f, 0.f, 0.f}; \
            _Pragma("unroll") for (int s = 0; s < 4; ++s) { \
                const i32x2_ bv = __builtin_amdgcn_ds_read_tr8_b64_v2i32((LAS i32x2_*)(tp[cb] + s * 4096)); \
                acc[cb] = __builtin_amdgcn_mfma_f32_16x16x32_fp8_fp8(aop[s], __builtin_bit_cast(long, bv), acc[cb], 0, 0, 0); } \
            asm volatile("s_nop 7"); } \
        asm volatile("s_nop 15\n\ts_nop 15"); \
        if (kg == 0 && (!tc.nostore || acc[0][0] == 12345.678f)) {        \
            _Pragma("unroll") for (int cb = 0; cb < 8; ++cb) xr[cb * 16] = xv[cb] + (acc[cb][0] + acc[cb][1] * 0.0625f) * casc; } \
    } while (0)
    for (; t < T; t += 2 * tstep) {
        PV_STEP(G0, t);
        if (t + tstep < T) PV_STEP(G1, t + tstep);
    }
#undef PV_STEP
#undef PV_IDS
}

constexpr int PH_PRO = 3, PH_MAX = 48;
struct Prog { GemmDesc d[PH_MAX]; int n; };
constexpr GemmDesc gd0() { GemmDesc g{}; g.nz = 1; g.scale = 1.0f; g.M = T; g.bA = B_WS; g.bB = B_WS; g.bC = B_WS; g.bE0 = B_WS; g.bE1 = B_WS; g.bE2 = B_WS; return g; }
constexpr Prog make_prog() {
    Prog P{};
    for (int ph = 0; ph < PH_MAX; ++ph) P.d[ph] = gd0();
    P.d[0].kind = K_INIT;
    {
        GemmDesc& g = P.d[1]; GemmDesc& g2 = P.d[PH_MAX - 2]; g.alt = PH_MAX - 2; g.split = 32;
        g.kind = K_GEMM; g.oA = WS_MEMN; g.lda = D; g.zA_lo = (long)NB * MEM * D; g.oB = WS_WKV_T; g.ldb = D; g.zB_lo = (long)2 * D * D; g.M = NB * MEM; g.N = 2 * D; g.K = D; g.nz = DEPTH;
        g.oC = WS_KVB; g.ldc = 2 * D; g.zC_lo = (long)NB * MEM * 2 * D; g.epi = E_BF16;
        g2.kind = K_GEMM; g2.oA = WS_KBD; g2.lda = 256; g2.zA_l = 8 * 65536; g2.zA_hi = 4 * 65536; g2.zA_lo = 65536;
        g2.oB = WS_PWQB; g2.ldb = 2048; g2.zB_l = (long)D * 2048; g2.zB_hi = 4 * 256; g2.zB_lo = 256; g2.M = 256; g2.N = D; g2.K = 256; g2.nz = 16;
        g2.oC = WS_WPK_T; g2.ldc = D; g2.zC_l = (long)2048 * D; g2.zC_hi = (long)4 * 256 * D; g2.zC_lo = (long)256 * D; g2.epi = E_BF16;
    }
    {
        GemmDesc& g = P.d[2]; GemmDesc& g2 = P.d[PH_MAX - 1]; g.alt = PH_MAX - 1; g.split = 128;
        g.kind = K_GEMM; g.oA = WS_KVB; g.lda = 2 * D; g.zA_l = (long)NB * MEM * 2 * D; g.zA_hi = (long)MEM * 2 * D; g.zA_lo = 256;
        g.oB = WS_WQB; g.ldb = D; g.zB_l = (long)D * D; g.zB_hi = 0; g.zB_lo = 256; g.M = 256; g.N = D; g.K = 256; g.nz = 16;
        g.oC = WS_WQK_T; g.ldc = D; g.zC_l = (long)2 * D * D; g.zC_hi = (long)D * D; g.zC_lo = (long)256 * D; g.epi = E_BF16; g.scale = 0.0625f;
        g2.kind = K_GEMM; g2.oA = WS_WOT; g2.lda = D; g2.zA_l = (long)D * D; g2.zA_hi = 0; g2.zA_lo = 256;
        g2.oB = WS_KVB + (size_t)D * 2; g2.ldb = 2 * D; g2.zB_l = (long)NB * MEM * 2 * D; g2.zB_hi = (long)MEM * 2 * D; g2.zB_lo = 256; g2.M = D; g2.N = 256; g2.K = 256; g2.nz = 16;
        g2.oC = WS_VWO_T; g2.ldc = D; g2.zC_l = (long)2 * D * D; g2.zC_hi = (long)D * D; g2.zC_lo = 256; g2.epi = E_BF16;
    }
    int n = PH_PRO;
    for (int l = 0; l < DEPTH; ++l) {
        const int base = n;
        for (int s = 0; s < 16; ++s) P.d[base + s].layer = l;
        { GemmDesc& g = P.d[base + 0]; g.kind = K_RMS; g.bA = (l == 0 ? (int)I_X : (int)B_OUT); g.bB = I_NORM_MIX; g.oB = (long)l * D * 4; g.oC = WS_HN; g.epi = E_BF16; }
        { GemmDesc& g = P.d[base + 1]; g.kind = K_GEMM; g.oA = WS_HN; g.lda = D; g.oB = WS_WIN_T + (size_t)l * INC * D * 2; g.ldb = D; g.N = INC; g.K = D; g.oC = WS_PROJ; g.ldc = INC; g.epi = E_BF16; }
        P.d[base + 2].kind = K_MIX1;
        P.d[base + 3].kind = K_MIX2;
        P.d[base + 4].kind = K_MIX3;
        { GemmDesc& g = P.d[base + 5]; g.kind = K_GEMM; g.oA = WS_YS5; g.lda = 512; g.oB = WS_WGLU_T + (size_t)l * 512 * 512 * 2; g.ldb = 512; g.N = 512; g.K = 512;
          g.oC = WS_OB + (size_t)1 * T * 512 * 2; g.ldc = 512; g.epi = E_GLU; g.bE0 = I_S5_BGLU; g.oE0 = (long)l * 512 * 4; }
        { GemmDesc& g = P.d[base + 6];
          g.kind = K_GEMM; g.oA = WS_OB; g.lda = 512; g.zA_lo = (long)T * 512; g.oB = WS_WBR_T + (size_t)(l * 3) * D * 512 * 2; g.ldb = 512; g.zB_lo = (long)D * 512; g.N = D; g.K = 512; g.nz = 3; g.zinner = 1;
          g.oC = WS_MRG; g.ldc = D; g.epi = E_BRZ; g.oE0 = WS_PROJ + (size_t)C_GATE * 2; g.bE1 = I_B_GATE; g.oE1 = (long)(l * 3 * D) * 4; g.oE2 = WS_MF32; }
        { GemmDesc& g = P.d[base + 7]; g.kind = K_GEMM; g.oA = WS_MRG; g.lda = D; g.oB = WS_WOUT_T + (size_t)l * D * D * 2; g.ldb = D; g.N = D; g.K = D; g.bC = B_OUT; g.ldc = D; g.epi = E_ADDX; g.bE0 = (l == 0 ? (int)I_X : (int)B_OUT); g.oE0 = 0;   }
        { GemmDesc& g = P.d[base + 8]; g.kind = K_RMS; g.bA = B_OUT; g.bB = I_NORM_CROSS; g.oB = (long)l * D * 4; g.oC = WS_HN; g.epi = E_BF16; g.nz = 2;   }
        { GemmDesc& g = P.d[base + 9];
          g.kind = K_GEMM; g.oA = WS_HN; g.lda = D; g.zA_lo = (long)SEQ * D; g.oB = WS_WQK_T + (size_t)l * 2 * D * D * 2; g.ldb = D; g.zB_lo = (long)D * D; g.M = SEQ; g.N = D; g.K = D; g.nz = NB;
          g.oC = WS_P; g.ldc = D; g.zC_lo = (long)SEQ * D; g.epi = E_SOFTMAX; }
        { GemmDesc& g = P.d[base + 10];
          g.kind = K_GEMM; g.oA = WS_P; g.lda = D; g.zA_lo = (long)SEQ * D; g.oB = WS_VWO_T + (size_t)l * 2 * D * D * 2; g.ldb = D; g.zB_lo = (long)D * D; g.M = SEQ; g.N = D; g.K = D; g.nz = NB;
          g.bC = B_OUT; g.ldc = D; g.zC_lo = (long)SEQ * D; g.epi = E_ADDX; g.bE0 = B_OUT; g.oE0 = 0; }
        { GemmDesc& g = P.d[base + 11]; g.kind = K_RMS; g.bA = B_OUT; g.bB = I_NORM_FFN; g.oB = (long)l * D * 4; g.oC = WS_HN; g.epi = E_BF16; g.nz = 3;   }
        { GemmDesc& g = P.d[base + 12]; g.kind = K_GEMM; g.oA = WS_HN; g.lda = D; g.oB = WS_WPK_T + (size_t)l * 2048 * D * 2; g.ldb = D; g.N = 2048; g.K = D; g.oC = WS_SC; g.ldc = 2048; g.epi = E_F16; }
        P.d[base + 13].kind = K_ROUTE;
        P.d[base + 14].kind = K_EXPERTS;
        P.d[base + 15].kind = K_EXPERTS_V;
        n = base + 16;
    }
    { GemmDesc& g = P.d[n]; g.kind = K_RMS; g.bA = B_OUT; g.bB = I_NORM_FINAL; g.bC = B_OUT; g.epi = E_F32; g.M = T; ++n; }
    P.n = n;
    return P;
}
__constant__ Prog PROG = make_prog();
constexpr int NPH = make_prog().n;

DI void init_phase(const TC tc, PRM p, unsigned char* lds) {
        unsigned char* ws = pws(p); float* X = pout(p);
        prep_weights(tc, p, (LAS unsigned char*)lds);
        {
            const int* pos = (const int*)pin(p, I_POS); float* rt = (float*)(ws + WS_ROPE);
            for (int i = tc.bid * 512 + tc.tid; i < T * 64; i += tc.nb * 512) { const int tok = i >> 6, d = i & 63;
                const float ang = (float)pos[tok] * powf(10000.0f, -(float)d * (1.0f / 64.0f)); float sn, cs; sincosf(ang, &sn, &cs); rt[(size_t)tok * 128 + d] = cs; rt[(size_t)tok * 128 + 64 + d] = sn; }
        }
        {
            float* tb = (float*)(ws + WS_TAB);
            for (int i = tc.bid * 512 + tc.tid; i < DEPTH * 32 * 64; i += tc.nb * 512) s5_disc_init(p, i, tb + (size_t)i * 4);
            {
                bf16_t* bbf = (bf16_t*)(ws + WS_TAB + 256 * 1024); bf16_t* cmf = (bf16_t*)(ws + WS_TAB + 512 * 1024);
                const float* Bre = (const float*)pin(p, I_S5_BRE); const float* Bim = (const float*)pin(p, I_S5_BIM); const float* Cre = (const float*)pin(p, I_S5_CRE); const float* Cim = (const float*)pin(p, I_S5_CIM);
                for (int i = tc.bid * 512 + tc.tid; i < DEPTH * 32 * 128 * 16; i += tc.nb * 512) {
                    const int c = i & 15, n = (i >> 4) & 127, lg = i >> 11, ri = n >> 6, pp = n & 63;
                    float d4[4]; s5_disc_init(p, lg * 64 + pp, d4);
                    const float br = Bre[((size_t)lg * 64 + pp) * 16 + c], bi = Bim[((size_t)lg * 64 + pp) * 16 + c];
                    bbf[i] = (bf16_t)f2bf(ri == 0 ? d4[2] * br - d4[3] * bi : d4[2] * bi + d4[3] * br);
                    const int c2 = i >> 7 & 15, k2 = i & 127, lg2 = i >> 11, ri2 = k2 >> 6, p2 = k2 & 63;
                    cmf[i] = (bf16_t)f2bf(ri2 == 0 ? Cre[((size_t)lg2 * 16 + c2) * 64 + p2] : -Cim[((size_t)lg2 * 16 + c2) * 64 + p2]);
                }
            }
            const float* hl = (const float*)pin(p, I_HG_LB);
            for (int i = tc.bid * 512 + tc.tid; i < 512; i += tc.nb * 512) { const float a0 = hl[i], a1 = hl[512 + i], mx = fmaxf(a0, a1), e0 = expf(a0 - mx), e1 = expf(a1 - mx);
                tb[16384 + i] = 0.f; tb[16384 + 512 + i] = e1 / (e0 + e1); }
            if (tc.bid == 0 && tc.tid < 4) tb[16384 + 1024 + tc.tid] = log1pf(-exp2f(-5.0f - (float)tc.tid));
        }
        rms_rows(tc, (const float*)pin(p, I_MEM), (const float*)pin(p, I_NORM_MEM), (bf16_t*)(ws + WS_MEMN), nullptr, NB * MEM);
        rms_rows(tc, (const float*)pin(p, I_MEM), (const float*)pin(p, I_NORM_MEM) + D, (bf16_t*)(ws + WS_MEMN) + (size_t)NB * MEM * D, nullptr, NB * MEM);
    }

DI void run_phase(const TC tc, PRM p, int ph, unsigned char* lds, LAS unsigned char* lds_raw) {
    const GemmDesc& g = PROG.d[ph];
    const int kind = g.kind, l = g.layer;
    if (kind == K_GEMM) {
        const int alt = g.alt, split = g.split < tc.nb ? g.split : tc.nb / 2; const bool second = alt != 0 && tc.bid >= split;
        const GemmDesc& gg = PROG.d[rfl(second ? alt : ph)];
        TC t2 = tc; t2.bid = second ? tc.bid - split : tc.bid; t2.nb = alt != 0 ? (second ? tc.nb - split : split) : tc.nb;
        mgemm(t2, p, gg, (LAS unsigned char*)lds, lds_raw);
    }
    else if (kind == K_RMS) { rms_rows(tc, GPTR(const float*, bA, oA), GPTR(const float*, bB, oB), g.epi == E_BF16 ? GPTR(bf16_t*, bC, oC) : nullptr, g.epi == E_F32 ? GPTR(float*, bC, oC) : nullptr, g.M, g.nz == 3 ? pws(p) + WS_HQ : nullptr);
        if (g.nz == 2) peer_convert(tc, p, l); }
    else if (kind == K_MIX1) {
        constexpr int N_S5 = NB * 32 * S5_NCH / 8;
        for (int it = tc.bid; it < N_S5; it += tc.nb) s5_chunk_mfma<1>(tc, p, l, it * 8 + (tc.tid >> 6), (LAS unsigned char*)lds);
        __syncthreads();
        LaPreA pre; int it = tc.bid;
        if (it < LA_ITEMS) laA_issue(tc, p, it, pre);
        for (; it < LA_ITEMS; it += tc.nb) { const int nx = it + tc.nb; la_phaseA(tc, p, l, it, pre, nx < LA_ITEMS ? nx : -1, (LAS unsigned char*)lds); }
    }
    else if (kind == K_MIX2) { s5_scan(tc, p, l); la_scan(tc, p); }
    else if (kind == K_MIX3) {
        constexpr int N_S5 = NB * 32 * S5_NCH / 8;
        if (!(tc.nostore && PROBE_SEL == 1)) for (int it = tc.bid; it < N_S5; it += tc.nb) s5_chunk_mfma<3>(tc, p, l, it * 8 + (tc.tid >> 6), (LAS unsigned char*)lds);
        __syncthreads();
        if (!(tc.nostore && PROBE_SEL == 2)) {
            LaPreC pre; int it = tc.bid;
            if (it < LA_ITEMS) laC_issue(tc, p, it, pre);
            for (; it < LA_ITEMS; it += tc.nb) { const int nx = it + tc.nb; la_phaseC(tc, p, l, it, pre, nx < LA_ITEMS ? nx : -1, (LAS unsigned char*)lds); }
        }
    }
    else if (kind == K_ROUTE) peer_route(tc, p, (LAS unsigned char*)lds);
    else if (kind == K_EXPERTS) peer_experts_u(tc, p, l, (LAS unsigned char*)lds);
    else if (kind == K_EXPERTS_V) peer_experts_v(tc, p, (LAS unsigned char*)lds);

}

__global__ void __launch_bounds__(512, 2) mega(Params p) {
    extern __shared__ __attribute__((aligned(16))) unsigned char lds[];
    {
        volatile LAS unsigned* MISC = (volatile LAS unsigned*)((LAS unsigned char*)lds + LDS_BYTES - 64);
        if (threadIdx.x < 16) MISC[threadIdx.x] = 0u;
        LAS Params* lp = (LAS Params*)((LAS unsigned char*)lds + LDS_BYTES - 1024);
        if (threadIdx.x == 0) {
#pragma unroll
            for (int i = 0; i < 31; ++i) lp->in[i] = p.in[i];
            lp->out = p.out; lp->ws = p.ws; lp->lo = p.lo; lp->hi = p.hi;
        }
        __syncthreads();
        if (p.hi - p.lo > 1 && threadIdx.x == 0) (void)xb_add((unsigned*)(p.ws + WS_CTL) + 4096 + XB_XCNT(xb_xcc_id()), 1u);
    }
    int hi = rfl(p.hi), ph = rfl(p.lo);
    if (ph == 0) {
        TC tc; tc.tid = threadIdx.x; tc.bid = blockIdx.x; tc.nb = gridDim.x; tc.nostore = 0;
        PRM lp0 = *(LAS Params*)((LAS unsigned char*)lds + LDS_BYTES - 1024);
        init_phase(tc, lp0, lds);
        if (hi > 1) { XcdBarrier b0; b0.bar = (unsigned*)(pws(lp0) + WS_CTL) + 4096; b0.x = xb_xcc_id(); b0.st = (volatile LAS unsigned*)((LAS unsigned char*)lds + LDS_BYTES - 64); xcd_barrier(b0); }
        ph = 1;
    }
    int wave_s = __builtin_amdgcn_readfirstlane(threadIdx.x >> 6);
    int dup = 0;
    for (; ph < hi; ph = rfl(ph + ((PROBE_MASK != 0ull && ((PROBE_MASK >> ph) & 1ull) && dup < PROBE_REP) ? (++dup, 0) : (dup = 0, 1)))) {
        unsigned ones = ~0u; asm volatile("" : "+s"(ones), "+s"(hi), "+s"(ph), "+s"(wave_s));
        TC tc; tc.tid = wave_s * 64 + (int)__builtin_amdgcn_mbcnt_hi(ones, __builtin_amdgcn_mbcnt_lo(ones, 0u)); tc.bid = blockIdx.x; tc.nb = gridDim.x;
        tc.nostore = (PROBE_MASK != 0ull && ((PROBE_MASK >> ph) & 1ull) && dup < PROBE_REP) ? 1 : 0;
        asm volatile("" : "+v"(tc.tid), "+s"(tc.bid), "+s"(tc.nb));
        int lz = 0; asm volatile("" : "+v"(lz));
        LAS unsigned char* L = (LAS unsigned char*)lds + lz;
        PRM lp = *(LAS Params*)(L + LDS_BYTES - 1024);
        run_phase(tc, lp, rfl(ph), (unsigned char*)L, (LAS unsigned char*)lds);
        if (ph + 1 < hi) {
            XcdBarrier b2; b2.bar = (unsigned*)(pws(lp) + WS_CTL) + 4096; b2.x = xb_xcc_id(); b2.st = (volatile LAS unsigned*)(L + LDS_BYTES - 64);
            xcd_barrier(b2);
#if PROBE_BAR
            if (ph == PROBE_BAR) for (int k = 0; k < 10; ++k) xcd_barrier(b2);
#endif
        }
    }
}

extern "C" void kernel_launch(void* const* d_in, const int* in_sizes, int n_in, void* d_out, int out_size, void* d_ws, size_t ws_size, hipStream_t stream) {
    static int grid = 0;
    if (grid == 0) {
        if (n_in != 31 || out_size != T * D || ws_size < WS_END) { fprintf(stderr, "kernel_launch: unexpected shapes n_in %d out %d ws %zu (need %zu)\n", n_in, out_size, ws_size, (size_t)WS_END); grid = -1; return; }
        int dev = 0, cus = 0;
        if (hipGetDevice(&dev) != hipSuccess || hipDeviceGetAttribute(&cus, hipDeviceAttributeMultiprocessorCount, dev) != hipSuccess) { grid = -1; return; }
        if (hipFuncSetAttribute((const void*)mega, hipFuncAttributeMaxDynamicSharedMemorySize, LDS_BYTES) != hipSuccess) { fprintf(stderr, "kernel_launch: hipFuncSetAttribute failed\n"); grid = -1; return; }
        int per_cu = 0;
        if (hipOccupancyMaxActiveBlocksPerMultiprocessor(&per_cu, (const void*)mega, 512, LDS_BYTES) != hipSuccess || per_cu < 1) fprintf(stderr, "kernel_launch: occupancy query says %d\n", per_cu);
        (void)hipGetLastError();
        grid = cus;
    }
    if (grid < 0) return;
    (void)hipMemsetAsync((char*)d_ws + WS_CTL, 0, 32768, stream);
    Params p{};
    for (int i = 0; i < 31; ++i) p.in[i] = d_in[i];
    p.out = (float*)d_out; p.ws = (unsigned char*)d_ws;
#if ONE_LAUNCH
    p.lo = 0; p.hi = NPH;
    hipLaunchKernelGGL(mega, dim3(grid), dim3(512), LDS_BYTES, stream, p);
#else
    for (int ph = 0; ph < NPH; ++ph) { p.lo = ph; p.hi = ph + 1; hipLaunchKernelGGL(mega, dim3(grid), dim3(512), LDS_BYTES, stream, p); }
#endif
}
```

```cpp
#include <hip/hip_runtime.h>
#include <stdint.h>
#include <stdio.h>

#ifndef LA_HG
#define LA_HG 1
#endif
#ifndef LA_RT
#define LA_RT 1
#endif
#ifndef PEER_LO
#define PEER_LO 0
#endif
#ifndef PROBE_MASK
#define PROBE_MASK 0ull
#endif
#ifndef PROBE_REP
#define PROBE_REP 1
#endif
#ifndef PROBE_BAR
#define PROBE_BAR 0
#endif
#ifndef PROBE_SEL
#define PROBE_SEL 0
#endif
#ifndef ONE_LAUNCH
#define ONE_LAUNCH 1
#endif

typedef unsigned short bf16_t;
typedef float f32x4 __attribute__((ext_vector_type(4)));
typedef unsigned u32x4 __attribute__((ext_vector_type(4)));
typedef unsigned u32x2 __attribute__((ext_vector_type(2)));
#define DI __device__ __forceinline__
#define LAS __attribute__((address_space(3)))

constexpr int NB = 2, SEQ = 8192, T = NB * SEQ, D = 1024, DEPTH = 2;
constexpr int INC = 7680;
constexpr int C_HGQ = 0, C_HGF = 512, C_HGI = 1024, C_HGG = 1536, C_S5U = 2048, C_RTQ = 2560, C_RTK = 3072, C_RTV = 3584, C_RTG = 4096, C_GATE = 4608;
constexpr int MEM = 256, NEXP = 16384;
constexpr float EPS = 1e-6f;

constexpr size_t MiB = 1u << 20;
constexpr size_t WS_CTL = 0, CTL_BYTES = 1 * MiB;
constexpr size_t WS_HN = 1 * MiB;
constexpr size_t WS_OB = 33 * MiB;
constexpr size_t WS_YS5 = 81 * MiB;
constexpr size_t WS_WIN_T = 97 * MiB;
constexpr size_t WS_WBR_T = 127 * MiB;
constexpr size_t WS_WOUT_T = 133 * MiB;
constexpr size_t WS_WGLU_T = 137 * MiB;
constexpr size_t WS_WPK_T = 138 * MiB;
constexpr size_t WS_WQK_T = 146 * MiB;
constexpr size_t WS_VWO_T = 154 * MiB;
constexpr size_t WS_R = 162 * MiB;
constexpr size_t WS_PROJ = WS_R;
constexpr size_t WS_OTMP = WS_R + 240 * MiB;
constexpr size_t WS_LAST = WS_OTMP;
constexpr size_t WS_LADEC = WS_R + 344 * MiB;
constexpr size_t WS_S5X = WS_R + 345 * MiB;
constexpr size_t WS_MF32 = WS_OTMP;
constexpr size_t WS_MRG = WS_OTMP + 64 * MiB;
constexpr size_t WS_RQ = WS_OTMP + 64 * MiB;
constexpr size_t WS_RK = WS_OTMP + 80 * MiB;
constexpr size_t WS_MEMN = WS_R;
constexpr size_t WS_WKV_T = WS_R + 2 * MiB;
constexpr size_t WS_WOT = WS_R + 10 * MiB;
constexpr size_t WS_WQB = WS_R + 14 * MiB;
constexpr size_t WS_PWQB = WS_R + 18 * MiB;
constexpr size_t WS_KBD = WS_R + 26 * MiB;
constexpr size_t WS_KVB = WS_R + 28 * MiB;
constexpr size_t WS_P = WS_R;
constexpr size_t WS_SC = WS_R;
constexpr size_t WS_PEERU = WS_R + 176 * MiB;
constexpr size_t WS_PEERV = WS_R + 192 * MiB;
constexpr size_t WS_PEERS = WS_R + 208 * MiB;
constexpr size_t WS_HQ = WS_R + 128 * MiB;
constexpr size_t WS_AQ = WS_R + 210 * MiB;
constexpr size_t WS_ASC = WS_R + 216 * MiB;
constexpr size_t WS_IDX16 = WS_R + 218 * MiB;
constexpr size_t WS_IDX = WS_R + 160 * MiB;
constexpr size_t WS_GATE = WS_R + 168 * MiB;
constexpr size_t WS_ROPE = WS_R + 336 * MiB;
constexpr size_t WS_TAB = WS_R + 347 * MiB;
constexpr size_t WS_END = WS_ROPE + 12 * MiB;

constexpr int LDS_BYTES = 147456;
constexpr int LDS_GD = 131072 + 8192;

DI float bf2f(bf16_t v) { return __uint_as_float((unsigned)v << 16); }
DI float bflo(unsigned w) { return __uint_as_float(w << 16); }
DI float bfhi(unsigned w) { return __uint_as_float(w & 0xffff0000u); }
DI unsigned f2bf(float f) { unsigned u = __float_as_uint(f); return (u + 0x7fffu + ((u >> 16) & 1u)) >> 16; }
typedef float f32x2_ __attribute__((ext_vector_type(2)));
typedef __bf16 bf16x2_ __attribute__((ext_vector_type(2)));
DI unsigned pk2(float lo, float hi) { const f32x2_ v = {lo, hi}; return __builtin_bit_cast(unsigned, __builtin_convertvector(v, bf16x2_)); }
template <int M> DI float sx(float v) { return __int_as_float(__builtin_amdgcn_ds_swizzle(__float_as_int(v), (M << 10) | 0x1f)); }
DI void halves(float v, float& lo, float& hi) { const auto r = __builtin_amdgcn_permlane32_swap(__float_as_uint(v), __float_as_uint(v), false, false); lo = __uint_as_float(r[0]); hi = __uint_as_float(r[1]); }
DI float wave_sum(float v) { v += sx<1>(v); v += sx<2>(v); v += sx<4>(v); v += sx<8>(v); v += sx<16>(v); float lo, hi; halves(v, lo, hi); return lo + hi; }
DI float wave_max(float v) { v = fmaxf(v, sx<1>(v)); v = fmaxf(v, sx<2>(v)); v = fmaxf(v, sx<4>(v)); v = fmaxf(v, sx<8>(v)); v = fmaxf(v, sx<16>(v)); float lo, hi; halves(v, lo, hi); return fmaxf(lo, hi); }
DI float fexp(float x) { return __builtin_amdgcn_exp2f(x * 1.4426950408889634f); }
DI float flog(float x) { return __builtin_amdgcn_logf(x) * 0.6931471805599453f; }
DI float frcp(float x) { return __builtin_amdgcn_rcpf(x); }
DI float frsq(float x) { return __builtin_amdgcn_rsqf(x); }
DI float sigmoidf_(float x) { return frcp(1.0f + fexp(-x)); }
DI float siluf_(float x) { return x * frcp(1.0f + fexp(-x)); }
DI float gelu_tanh(float x) { const float u = 0.7978845608028654f * (x + 0.044715f * x * x * x); return x - x * frcp(1.0f + fexp(2.0f * u)); }

#define XB_TMO      128
#define XB_XCNT(j)  (256  + 64 * (j))
#define XB_XSUB(j)  (1280 + 64 * (j))
#define XB_XGEN(j)  (2304 + 64 * (j))
#define XB_TOP      3328
#define XB_TOPGEN   3392
#define XCD_BAR_WORDS 3456
#define XB_SPIN_CAP (1u << 22)
DI unsigned xb_ld(unsigned* p) { return __hip_atomic_load(p, __ATOMIC_RELAXED, __HIP_MEMORY_SCOPE_AGENT); }
DI unsigned xb_add(unsigned* p, unsigned v) { return __hip_atomic_fetch_add(p, v, __ATOMIC_RELAXED, __HIP_MEMORY_SCOPE_AGENT); }
DI unsigned xb_xcc_id() { return (unsigned)__builtin_amdgcn_s_getreg((3 << 11) | 20) & 0xFu; }
#define XB_SPIN(cond, bar) do { unsigned _sp = 0; while (cond) { __builtin_amdgcn_s_sleep(1); \
    if ((++_sp & 255u) == 0u) { if (xb_ld(&(bar)[XB_TMO])) break; if (_sp > XB_SPIN_CAP) { atomicAdd(&(bar)[XB_TMO], 1u); break; } } } } while (0)
struct XcdBarrier { unsigned* bar; unsigned x; volatile LAS unsigned* st; };
DI XcdBarrier xcd_barrier_post(unsigned* bar, volatile LAS unsigned* st) {
    XcdBarrier b; b.bar = bar; b.x = xb_xcc_id(); b.st = st;
    if (threadIdx.x == 0) (void)xb_add(&bar[XB_XCNT(b.x)], 1u);
    return b;
}
DI void xcd_barrier_complete(unsigned* bar, unsigned x, unsigned& nloc, unsigned& nx) {
    const unsigned G = gridDim.x * gridDim.y * gridDim.z;
    unsigned sum, cnt, mine, sp = 0u;
    for (;;) {
        sum = 0u; cnt = 0u; mine = 0u;
#pragma unroll
        for (unsigned j = 0; j < 16; ++j) { const unsigned c = xb_ld(&bar[XB_XCNT(j)]); sum += c; cnt += (c > 0u) ? 1u : 0u; mine = (j == x) ? c : mine; }
        if (sum == G) break;
        __builtin_amdgcn_s_sleep(1);
        if ((++sp & 255u) == 0u) { if (xb_ld(&bar[XB_TMO])) break; if (sp > XB_SPIN_CAP) { atomicAdd(&bar[XB_TMO], 1u); break; } }
    }
    nloc = mine > 0u ? mine : 1u; nx = cnt > 0u ? cnt : 1u;
}
DI void xcd_barrier(const XcdBarrier& b) {
    asm volatile("s_waitcnt vmcnt(0)" ::: "memory");
    __syncthreads();
    if (threadIdx.x == 0) {
        unsigned* bar = b.bar;
        __builtin_amdgcn_s_waitcnt(0);
        unsigned nloc = b.st[0], nx = b.st[1];
        if (nloc == 0u) { xcd_barrier_complete(bar, b.x, nloc, nx); b.st[0] = nloc; b.st[1] = nx; }
        const unsigned old = xb_add(&bar[XB_XSUB(b.x)], 1u);
        const unsigned gen = old / nloc;
        if (old + 1u == (gen + 1u) * nloc) {
            __builtin_amdgcn_fence(__ATOMIC_RELEASE, "agent");
            asm volatile("s_waitcnt vmcnt(0)" ::: "memory");
            __builtin_amdgcn_fence(__ATOMIC_ACQUIRE, "agent");
            const unsigned og = xb_add(&bar[XB_TOP], 1u);
            const unsigned tg = og / nx;
            if (og + 1u == (tg + 1u) * nx) xb_add(&bar[XB_TOPGEN], 1u);
            else XB_SPIN(xb_ld(&bar[XB_TOPGEN]) == tg, bar);
            asm volatile("s_waitcnt vmcnt(0)" ::: "memory");
            xb_add(&bar[XB_XGEN(b.x)], 1u);
            asm volatile("s_waitcnt vmcnt(0)" ::: "memory");
        } else {
            __builtin_amdgcn_fence(__ATOMIC_ACQUIRE, "agent");
            XB_SPIN(xb_ld(&bar[XB_XGEN(b.x)]) == gen, bar);
            asm volatile("s_waitcnt vmcnt(0)" ::: "memory");
        }
    }
    __syncthreads();
}

struct Params { const void* in[31]; float* out; unsigned char* ws; int lo, hi; };
typedef const LAS Params& PRM;
DI unsigned long long rfl64(unsigned long long v) { const unsigned lo = __builtin_amdgcn_readfirstlane((unsigned)v), hi = __builtin_amdgcn_readfirstlane((unsigned)(v >> 32)); return ((unsigned long long)hi << 32) | lo; }
DI int rfl(int v) { return __builtin_amdgcn_readfirstlane(v); }
#define GLOBAL_AS __attribute__((address_space(1)))
DI const void* pin(PRM p, int i) { return (const void*)(const GLOBAL_AS char*)rfl64((unsigned long long)p.in[i]); }
DI unsigned char* pws(PRM p) { return (unsigned char*)(GLOBAL_AS unsigned char*)rfl64((unsigned long long)p.ws); }
DI float* pout(PRM p) { return (float*)(GLOBAL_AS float*)rfl64((unsigned long long)p.out); }

enum { I_X = 0, I_MEM, I_POS, I_NORM_MIX, I_W_IN, I_B_GATE, I_HG_LB, I_HG_NORM, I_S5_LRE, I_S5_LIM, I_S5_LOGSTEP, I_S5_BRE, I_S5_BIM, I_S5_CRE, I_S5_CIM,
       I_S5_D, I_S5_WGLU, I_S5_BGLU, I_W_BRANCH, I_W_OUT, I_NORM_CROSS, I_NORM_MEM, I_XA_WQ, I_XA_WKV, I_XA_WO, I_NORM_FFN, I_PEER_WQ, I_PEER_KEYS,
       I_PEER_U, I_PEER_V, I_NORM_FINAL };

struct TC { int tid, bid, nb, nostore; };
enum { E_BF16 = 0, E_F32, E_GLU, E_BR0, E_BR1, E_BR2, E_ADDX, E_SOFTMAX, E_BRZ, E_F16, E_BF16G, E_G8 };
enum { K_NONE = 0, K_GEMM, K_RMS, K_MIX1, K_MIX2, K_MIX3, K_ROUTE, K_EXPERTS, K_EXPERTS_V, K_INIT };
enum { B_OUT = 31, B_WS = 32 };
struct GemmDesc {
    int kind, epi, layer, alt;
    int bA, bB, bC, bE0, bE1, bE2, zinner, split;
    long oA, oB, oC, oE0, oE1, oE2;
    long zA_l, zA_hi, zA_lo, zB_l, zB_hi, zB_lo, zC_l, zC_hi, zC_lo;
    int lda, ldb, ldc, M, N, K, nz; float scale;
};
DI const void* base_ptr(PRM p, int id) { const unsigned long long v = rfl64(id < 31 ? (unsigned long long)p.in[id] : (id == 31 ? (unsigned long long)p.out : (unsigned long long)p.ws)); return (const void*)(const GLOBAL_AS char*)v; }
typedef const GemmDesc& GD;
#define GI(f) (g.f)
#define GL(f) (g.f)
#define GPTR(ty, bf, of) ((ty)((const char*)base_ptr(p, g.bf) + g.of))
#define ZOFF(g, X, zi) ((size_t)(((zi) >> 3) * GL(z##X##_l) + (((zi) >> 2) & 1) * GL(z##X##_hi) + ((zi) & 3) * GL(z##X##_lo)))
DI unsigned pkh2(float lo, float hi) { typedef float f32x2h __attribute__((ext_vector_type(2))); typedef _Float16 f16x2h __attribute__((ext_vector_type(2)));
    return __builtin_bit_cast(unsigned, __builtin_convertvector((f32x2h){lo, hi}, f16x2h)); }
DI float h2f(unsigned short h) { return (float)__builtin_bit_cast(_Float16, h); }
DI unsigned fp8x4(float a, float b, float c, float d) {
    a = fminf(fmaxf(a, -448.f), 448.f); b = fminf(fmaxf(b, -448.f), 448.f); c = fminf(fmaxf(c, -448.f), 448.f); d = fminf(fmaxf(d, -448.f), 448.f);
    int t = 0; t = __builtin_amdgcn_cvt_pk_fp8_f32(a, b, t, false); t = __builtin_amdgcn_cvt_pk_fp8_f32(c, d, t, true); return (unsigned)t;
}
DI void store8_bf16(bf16_t* p, const float (&v)[8]) {
    u32x4 w; w.x = pk2(v[0], v[1]); w.y = pk2(v[2], v[3]); w.z = pk2(v[4], v[5]); w.w = pk2(v[6], v[7]);
    *(u32x4*)p = w;
}
DI void unpack8(const u32x4 w, float (&v)[8]) { v[0] = bflo(w.x); v[1] = bfhi(w.x); v[2] = bflo(w.y); v[3] = bfhi(w.y); v[4] = bflo(w.z); v[5] = bfhi(w.z); v[6] = bflo(w.w); v[7] = bfhi(w.w); }
DI void load8_bf16(const bf16_t* p, float (&v)[8]) {
    const u32x4 w = *(const u32x4*)p;
    v[0] = bflo(w.x); v[1] = bfhi(w.x); v[2] = bflo(w.y); v[3] = bfhi(w.y); v[4] = bflo(w.z); v[5] = bfhi(w.z); v[6] = bflo(w.w); v[7] = bfhi(w.w);
}
struct EpiU { int epi, ldc; size_t zo, zx; unsigned char* C; const unsigned char* A; const unsigned char* e0; const unsigned char* e1; unsigned char* e2; float scale; };
struct EpiL { u32x4 a, b; };
DI EpiU epi_unit(PRM p, GD g, int z) {
    EpiU u; u.ldc = GI(ldc); u.epi = GI(epi); u.zx = 0;
    if (u.epi == E_BRZ) { u.epi = E_BR0 + z; u.zx = (size_t)z * D; }
    u.zo = ZOFF(g, C, z); u.C = GPTR(unsigned char*, bC, oC); u.A = GPTR(const unsigned char*, bA, oA); u.e0 = GPTR(const unsigned char*, bE0, oE0); u.e1 = GPTR(const unsigned char*, bE1, oE1);
    u.e2 = GPTR(unsigned char*, bE2, oE2); u.scale = g.scale; return u;
}
DI void epi_load(const EpiU& u, int row, int col, EpiL& L) {
    const size_t co = u.zo + (size_t)row * u.ldc + col;
    switch (u.epi) {
    case E_GLU: L.a = *(const u32x4*)((const bf16_t*)u.A + (size_t)row * 512 + col); break;
    case E_BR0: { const u32x2 q = *(const u32x2*)(u.e0 + u.zx + (size_t)row * INC * 2 + col); L.a.x = q.x; L.a.y = q.y; } break;
    case E_BR1: case E_BR2: { const u32x2 q = *(const u32x2*)(u.e0 + u.zx + (size_t)row * INC * 2 + col); L.a.x = q.x; L.a.y = q.y; L.b = *(const u32x4*)((const bf16_t*)u.C + co); } break;
    case E_ADDX: { const float* x = (const float*)u.e0 + co; L.a = *(const u32x4*)x; L.b = *(const u32x4*)(x + 4); } break;
    default: break;
    }
}
DI void epi_finish(const int nostore, const EpiU& u, int row, int col, float (&v)[8], const EpiL& L) {
    const size_t co = u.zo + (size_t)row * u.ldc + col;
    switch (u.epi) {
    case E_BF16: {
#pragma unroll
        for (int j = 0; j < 8; ++j) v[j] *= u.scale;
        store8_bf16((bf16_t*)u.C + co, v); } break;
    case E_F32: { float* c = (float*)u.C + co; *(f32x4*)c = (f32x4){v[0], v[1], v[2], v[3]}; *(f32x4*)(c + 4) = (f32x4){v[4], v[5], v[6], v[7]}; } break;
    case E_BF16G: {
        if (col >= C_GATE) {
            u32x2 w; w.x = fp8x4(v[0] * 16.0f, v[1] * 16.0f, v[2] * 16.0f, v[3] * 16.0f); w.y = fp8x4(v[4] * 16.0f, v[5] * 16.0f, v[6] * 16.0f, v[7] * 16.0f);
            *(u32x2*)((unsigned char*)u.C + ((size_t)row * INC + C_GATE) * 2 + (col - C_GATE)) = w;
        } else store8_bf16((bf16_t*)u.C + co, v); } break;
    case E_G8: { u32x2 w; w.x = fp8x4(v[0] * 16.0f, v[1] * 16.0f, v[2] * 16.0f, v[3] * 16.0f); w.y = fp8x4(v[4] * 16.0f, v[5] * 16.0f, v[6] * 16.0f, v[7] * 16.0f);
        *(u32x2*)(u.C + (size_t)row * INC * 2 + col) = w; } break;
    case E_F16: { u32x4 w; w.x = pkh2(v[0], v[1]); w.y = pkh2(v[2], v[3]); w.z = pkh2(v[4], v[5]); w.w = pkh2(v[6], v[7]); *(u32x4*)((unsigned short*)u.C + co) = w; } break;
    case E_GLU: {
        float y[8], o[8]; unpack8(L.a, y); const float* bias = (const float*)u.e0;
#pragma unroll
        for (int j = 0; j < 8; ++j) o[j] = y[j] * sigmoidf_(v[j] + bias[col + j]);
        store8_bf16((bf16_t*)u.C + co, o); } break;
    case E_BR0: case E_BR1: case E_BR2: {
        float lg[8], o[8]; const float* bg = (const float*)u.e1 + u.zx;
        { typedef float f32x2 __attribute__((ext_vector_type(2)));
          const f32x2 g0 = __builtin_amdgcn_cvt_pk_f32_fp8((int)L.a.x, false), g1 = __builtin_amdgcn_cvt_pk_f32_fp8((int)L.a.x, true), g2 = __builtin_amdgcn_cvt_pk_f32_fp8((int)L.a.y, false), g3 = __builtin_amdgcn_cvt_pk_f32_fp8((int)L.a.y, true);
          lg[0] = g0.x; lg[1] = g0.y; lg[2] = g1.x; lg[3] = g1.y; lg[4] = g2.x; lg[5] = g2.y; lg[6] = g3.x; lg[7] = g3.y; }
#pragma unroll
        for (int j = 0; j < 8; ++j) { o[j] = sigmoidf_(lg[j] * 0.0625f + bg[col + j]) * v[j]; }
        if (u.epi != E_BR0) { float pr[8]; unpack8(L.b, pr);
#pragma unroll
            for (int j = 0; j < 8; ++j) o[j] += pr[j]; }
        if (nostore && o[0] != 12345.678f) break;
        store8_bf16((bf16_t*)u.C + co, o); } break;
    case E_ADDX: { float* x = (float*)u.C + co; f32x4 x0 = __builtin_bit_cast(f32x4, L.a), x1 = __builtin_bit_cast(f32x4, L.b);
        x0 += (f32x4){v[0], v[1], v[2], v[3]}; x1 += (f32x4){v[4], v[5], v[6], v[7]}; if (nostore && x0.x != 12345.678f) break; *(f32x4*)x = x0; *(f32x4*)(x + 4) = x1; } break;
    default: break;
    }
}
typedef short bf16x8 __attribute__((ext_vector_type(8)));
namespace mgk {
constexpr int BM = 256, BK = 64, HALF = 128, HTB = HALF * BK * 2, NXCD = 8, WGM = 8;
DI int lds_byte(int r, int c) { const int st = (r >> 4) * 2 + (c >> 5), rr = r & 15, cc = c & 31, ob = rr * 64 + cc * 2; return st * 1024 + (ob ^ (((ob >> 9) & 1) << 5)); }
DI void stage_rc(int b, int& R, int& C) { const int st = b / 1024, sb = b % 1024, swz = sb ^ (((sb >> 9) & 1) << 5); R = (st >> 1) * 16 + swz / 64; C = (st & 1) * 32 + (swz % 64) / 2; }
DI int perm32(int rho) { const int n = rho >> 4, i = rho & 15; return 8 * (i >> 2) + 4 * n + (i & 3); }
struct Unit { int pm, pn, z; };
DI bool next_unit(GD g, int i, int G, int c, Unit& u) {
    const int nM = GI(M) / BM, nN = GI(N) / BM, nwg = nM * nN;
    long L = (long)i * G + c; int zz;
    if (GI(zinner)) { const int nz = GI(nz); zz = i % nz; L = (long)(i / nz) * G + c; if (L >= nwg) return false; }
    else { if (L >= (long)nwg * GI(nz)) return false; zz = (int)(L / nwg); }
    u.z = zz; int wgid = (int)(L % nwg);
    { const int q = nwg / NXCD, r = nwg % NXCD, xcd = wgid % NXCD, off = wgid / NXCD; wgid = (xcd < r ? xcd * (q + 1) : r * (q + 1) + (xcd - r) * q) + off; }
    const int nig = WGM * nN, gid = wgid / nig, fm = gid * WGM, gsz = (nM - fm) < WGM ? (nM - fm) : WGM;
    u.pm = rfl(fm + ((wgid % nig) % gsz)); u.pn = rfl((wgid % nig) / gsz); u.z = rfl(u.z); return true;
}
}

DI void mgemm(const TC tc, PRM p, GD g, LAS unsigned char* lds, LAS unsigned char* lds_dma) {
    using namespace mgk;
    const int tid = tc.tid, wid = __builtin_amdgcn_readfirstlane(tid >> 6), lane = tid & 63, wr = wid >> 2, wc = wid & 3, fr = lane & 15, fq = lane >> 4;
    const int nt = (tc.nostore && PROBE_SEL == 6) ? 2 : GI(K) / BK, lda = GI(lda), ldb = GI(ldb);
    unsigned voffA[2], voffB[2];
#pragma unroll
    for (int i = 0; i < 2; ++i) { int R, C; stage_rc(tid * 16 + i * 8192, R, C); const int Rb = (R & ~31) + perm32(R & 31);
        voffA[i] = (unsigned)(R * lda + C) * 2u; voffB[i] = (unsigned)(Rb * ldb + C) * 2u; }
    const size_t kstep = (size_t)(BK * 2);
    const size_t hstepA = (size_t)HALF * lda * 2, hstepB = (size_t)HALF * ldb * 2;
    const unsigned ldsw = (unsigned)wid * 1024u;
    const unsigned ldsm0 = (unsigned)__builtin_amdgcn_readfirstlane((int)((unsigned)(size_t)lds_dma + ldsw));
    LAS unsigned char* aB = lds + lds_byte(wr * 64 + fr, fq * 8); LAS unsigned char* bB = lds + 4 * HTB + lds_byte(wc * 32 + fr, fq * 8);
    asm volatile("" : "+v"(aB), "+v"(bB));
#define MG_SA(b, h) (((b) * 2 + (h)) * HTB)
#define MG_SB(b, h) ((4 + (b) * 2 + (h)) * HTB)
#ifndef MG_ASM_DMA
#define MG_ASM_DMA 0
#endif
#if MG_ASM_DMA
#define MG_STAGE(bufoff, gbase, voff) do { _Pragma("unroll") for (int _i = 0; _i < 2; ++_i) \
        asm volatile("s_mov_b32 m0, %0\n\ts_nop 0\n\tglobal_load_lds_dwordx4 %1, %2" :: "s"(ldsm0 + (unsigned)((bufoff) + _i * 8192)), "v"((voff)[_i]), "s"((const char*)(gbase)) : "m0", "memory"); } while (0)
#else
#define MG_STAGE(bufoff, gbase, voff) do { _Pragma("unroll") for (int _i = 0; _i < 2; ++_i) \
        __builtin_amdgcn_global_load_lds((const unsigned*)((const char*)(gbase) + (voff)[_i]), (LAS unsigned*)(lds_dma + (bufoff) + ldsw + _i * 8192), 16, 0, 0); } while (0)
#endif
#define MG_LDA(dst, b, h) do { _Pragma("unroll") for (int m = 0; m < 4; ++m) _Pragma("unroll") for (int k = 0; k < 2; ++k) dst[m][k] = *(const LAS bf16x8*)(aB + MG_SA(b, h) + m * 2048 + k * 1024); } while (0)
#define MG_LDB(dst, b, h) do { _Pragma("unroll") for (int n = 0; n < 2; ++n) _Pragma("unroll") for (int k = 0; k < 2; ++k) dst[n][k] = *(const LAS bf16x8*)(bB + (MG_SB(b, h) - 4 * HTB) + n * 2048 + k * 1024); } while (0)
#define MG_MMA(ai, bj, At, Bt) do { __builtin_amdgcn_s_setprio(1); _Pragma("unroll") for (int m = 0; m < 4; ++m) _Pragma("unroll") for (int n = 0; n < 2; ++n) _Pragma("unroll") for (int k = 0; k < 2; ++k) \
        acc[ai][bj][m][n] = __builtin_amdgcn_mfma_f32_16x16x32_bf16(Bt[n][k], At[m][k], acc[ai][bj][m][n], 0, 0, 0); __builtin_amdgcn_s_setprio(0); } while (0)
#define MG_WAIT_V(n) asm volatile("s_waitcnt vmcnt(" #n ")" ::: "memory")
#define MG_WAIT_L(n) asm volatile("s_waitcnt lgkmcnt(" #n ")" ::: "memory")
#define MG_BAR __builtin_amdgcn_s_barrier()
#define MG_SCHED __builtin_amdgcn_sched_barrier(0)
    const int G = rfl(tc.nb), cidx = rfl(tc.bid);
    Unit cur, nxt; int ui = 0;
    if (!next_unit(g, 0, G, cidx, cur)) return;
    {
        const int nun = (GI(M) / BM) * (GI(N) / BM) * GI(nz), full = nun / G, rem = nun - full * G;
        if (rem != 0 && full >= 4 && cidx >= rem && !GI(zinner)) { const int steps = (cidx - rem) & 15; for (int k = 0; k < steps; ++k) __builtin_amdgcn_s_sleep(64); }
    }
    f32x4 acc[2][2][4][2];
#pragma unroll
    for (int a = 0; a < 2; ++a)
#pragma unroll
        for (int b = 0; b < 2; ++b)
#pragma unroll
            for (int m = 0; m < 4; ++m)
#pragma unroll
                for (int n = 0; n < 2; ++n) acc[a][b][m][n] = (f32x4){0.f, 0.f, 0.f, 0.f};
    bf16x8 At[4][2], B0[2][2], B1[2][2];
    const bf16_t* const Abase = GPTR(const bf16_t*, bA, oA); const bf16_t* const Bbase = GPTR(const bf16_t*, bB, oB);
    const char* cA = (const char*)(Abase + ZOFF(g, A, cur.z) + (size_t)cur.pm * BM * lda);
    const char* cB = (const char*)(Bbase + ZOFF(g, B, cur.z) + (size_t)cur.pn * BM * ldb);
    MG_STAGE(MG_SB(0, 0), cB, voffB); MG_STAGE(MG_SB(0, 1), cB + hstepB, voffB); MG_STAGE(MG_SA(0, 0), cA, voffA); MG_STAGE(MG_SA(0, 1), cA + hstepA, voffA);
    if (wr == 1) MG_BAR;
    MG_WAIT_V(2); MG_BAR;
    MG_STAGE(MG_SB(1, 0), cB + kstep, voffB); MG_STAGE(MG_SA(1, 0), cA + kstep, voffA); MG_STAGE(MG_SB(1, 1), cB + hstepB + kstep, voffB);
    MG_WAIT_V(6); MG_BAR;
    for (;;) {
        const bool has_next = next_unit(g, ui + 1, G, cidx, nxt);
        const char* nA = has_next ? (const char*)(Abase + ZOFF(g, A, nxt.z) + (size_t)nxt.pm * BM * GI(lda)) : cA;
        const char* nB = has_next ? (const char*)(Bbase + ZOFF(g, B, nxt.z) + (size_t)nxt.pn * BM * GI(ldb)) : cB;
        for (int t = 0; t < nt; t += 2) {
            const bool last = (t == nt - 2);
            const char* a1 = cA + (size_t)(t + 1) * kstep;
            const char* a2 = last ? nA : cA + (size_t)(t + 2) * kstep; const char* b2 = last ? nB : cB + (size_t)(t + 2) * kstep;
            const char* a3 = a2 + kstep; const char* b3 = b2 + kstep;
            MG_LDB(B0, 0, 0); MG_LDB(B1, 0, 1); MG_SCHED; MG_LDA(At, 0, 0); MG_STAGE(MG_SA(1, 1), a1 + hstepA, voffA);
            MG_WAIT_V(8); MG_WAIT_L(0); MG_BAR; MG_MMA(0, 0, At, B0); MG_MMA(0, 1, At, B1); MG_BAR; MG_SCHED;
            MG_LDA(At, 0, 1); MG_STAGE(MG_SB(0, 0), b2, voffB); MG_STAGE(MG_SB(0, 1), b2 + hstepB, voffB); MG_STAGE(MG_SA(0, 0), a2, voffA);
            MG_WAIT_V(8); MG_WAIT_L(0); MG_BAR; MG_MMA(1, 0, At, B0); MG_MMA(1, 1, At, B1); MG_BAR; MG_SCHED;
            MG_LDB(B0, 1, 0); MG_LDB(B1, 1, 1); MG_SCHED; MG_LDA(At, 1, 0); MG_STAGE(MG_SA(0, 1), a2 + hstepA, voffA);
            MG_WAIT_V(8); MG_WAIT_L(0); MG_BAR; MG_MMA(0, 0, At, B0); MG_MMA(0, 1, At, B1); MG_BAR; MG_SCHED;
            MG_LDA(At, 1, 1); MG_STAGE(MG_SB(1, 0), b3, voffB); MG_STAGE(MG_SB(1, 1), b3 + hstepB, voffB); MG_STAGE(MG_SA(1, 0), a3, voffA);
            MG_WAIT_V(8); MG_WAIT_L(0); MG_BAR; MG_MMA(1, 0, At, B0); MG_MMA(1, 1, At, B1); MG_BAR; MG_SCHED;
        }
        if (wr == 0) MG_BAR;
        int fr_e = fr, fq_e = fq, ez = 0;
        asm volatile("" : "+v"(fr_e), "+v"(fq_e), "+v"(ez));
        PRM pe = *(const LAS Params*)((const LAS unsigned char*)&p + ez);
#define p pe
#define fr fr_e
#define fq fq_e
        if (tc.nostore && PROBE_SEL == 5) {   }
        else if (GI(epi) == E_SOFTMAX) {
            LAS float* red = (LAS float*)(lds + 131072);
#pragma unroll
            for (int ai = 0; ai < 2; ++ai)
#pragma unroll
                for (int m = 0; m < 4; ++m) {
                    float mx = -INFINITY;
#pragma unroll
                    for (int bj = 0; bj < 2; ++bj)
#pragma unroll
                        for (int n = 0; n < 2; ++n)
#pragma unroll
                            for (int j = 0; j < 4; ++j) mx = fmaxf(mx, acc[ai][bj][m][n][j]);
                    mx = fmaxf(mx, sx<16>(mx)); { float lo_, hi_; halves(mx, lo_, hi_); mx = fmaxf(lo_, hi_); }
                    float s = 0.f;
#pragma unroll
                    for (int bj = 0; bj < 2; ++bj)
#pragma unroll
                        for (int n = 0; n < 2; ++n)
#pragma unroll
                            for (int j = 0; j < 4; ++j) { const float e = fexp(acc[ai][bj][m][n][j] - mx); acc[ai][bj][m][n][j] = e; s += e; }
                    s += sx<16>(s); { float lo_, hi_; halves(s, lo_, hi_); s = lo_ + hi_; }
                    if (fq == 0) { const int rl = ai * HALF + wr * 64 + m * 16 + fr; red[(rl * 4 + wc) * 2] = mx; red[(rl * 4 + wc) * 2 + 1] = s; }
                }
            asm volatile("s_waitcnt lgkmcnt(0)" ::: "memory"); __builtin_amdgcn_s_barrier(); asm volatile("" ::: "memory");
            bf16_t* Cb = GPTR(bf16_t*, bC, oC) + ZOFF(g, C, cur.z); const int ldc = GI(ldc);
#pragma unroll
            for (int ai = 0; ai < 2; ++ai)
#pragma unroll
                for (int m = 0; m < 4; ++m) {
                    const int rl = ai * HALF + wr * 64 + m * 16 + fr;
                    const f32x4 p0 = *(const LAS f32x4*)(red + rl * 8), p1 = *(const LAS f32x4*)(red + rl * 8 + 4);
                    const float M_ = fmaxf(fmaxf(p0.x, p0.z), fmaxf(p1.x, p1.z));
                    const float tot = p0.y * fexp(p0.x - M_) + p0.w * fexp(p0.z - M_) + p1.y * fexp(p1.x - M_) + p1.w * fexp(p1.z - M_);
                    const float sc = fexp(red[(rl * 4 + wc) * 2] - M_) * frcp(tot);
                    bf16_t* rowp = Cb + (size_t)(cur.pm * BM + rl) * ldc + cur.pn * BM + wc * 32 + 8 * fq;
#pragma unroll
                    for (int bj = 0; bj < 2; ++bj) {
                        float v[8];
#pragma unroll
                        for (int j = 0; j < 4; ++j) { v[j] = acc[ai][bj][m][0][j] * sc; v[4 + j] = acc[ai][bj][m][1][j] * sc; }
                        store8_bf16(rowp + bj * HALF, v);
                    }
                }
        } else {
            const int row0 = cur.pm * BM + wr * 64 + fr, col0 = cur.pn * BM + wc * 32 + 8 * fq;
            const EpiU eu = epi_unit(p, g, cur.z);
#pragma unroll
            for (int ai = 0; ai < 2; ++ai)
#pragma unroll
                for (int m = 0; m < 4; ++m) {
                    EpiL L[2];
#pragma unroll
                    for (int bj = 0; bj < 2; ++bj) epi_load(eu, row0 + ai * HALF + m * 16, col0 + bj * HALF, L[bj]);
#pragma unroll
                    for (int bj = 0; bj < 2; ++bj) {
                        float v[8];
#pragma unroll
                        for (int j = 0; j < 4; ++j) { v[j] = acc[ai][bj][m][0][j]; v[4 + j] = acc[ai][bj][m][1][j]; }
                        epi_finish(tc.nostore, eu, row0 + ai * HALF + m * 16, col0 + bj * HALF, v, L[bj]);
                    }
                }
        }
#undef fr
#undef fq
#undef p
        if (!has_next) break;
#pragma unroll
        for (int a = 0; a < 2; ++a)
#pragma unroll
            for (int b = 0; b < 2; ++b)
#pragma unroll
                for (int m = 0; m < 4; ++m)
#pragma unroll
                    for (int n = 0; n < 2; ++n) acc[a][b][m][n] = (f32x4){0.f, 0.f, 0.f, 0.f};
        cur = nxt; cA = nA; cB = nB; ++ui;
        if (wr == 1) MG_BAR;
    }
    MG_WAIT_V(0);
    MG_BAR;
#undef MG_SA
#undef MG_SB
#undef MG_STAGE
#undef MG_LDA
#undef MG_LDB
#undef MG_MMA
#undef MG_WAIT_V
#undef MG_WAIT_L
#undef MG_BAR
#undef MG_SCHED
}

DI void transpose_item(const float* W, int K, int N, bf16_t* WT, LAS float* scr, int item, int lane) {
    const int nblk = N / 32, kb = item / nblk, nb = item % nblk, k0 = 64 * kb, n0 = 32 * nb;
#pragma unroll 8
    for (int i = 0; i < 32; ++i) { const int kk = 2 * i + (lane >> 5); scr[kk * 33 + (lane & 31)] = W[(size_t)(k0 + kk) * N + n0 + (lane & 31)]; }
    asm volatile("s_waitcnt lgkmcnt(0)" ::: "memory");
    const int c = lane & 7;
#pragma unroll
    for (int j = 0; j < 4; ++j) { const int n = (lane >> 3) + 8 * j; const LAS float* s = scr + (8 * c) * 33 + n;
        u32x4 o; o.x = pk2(s[0 * 33], s[1 * 33]); o.y = pk2(s[2 * 33], s[3 * 33]); o.z = pk2(s[4 * 33], s[5 * 33]); o.w = pk2(s[6 * 33], s[7 * 33]);
        *(u32x4*)(WT + (size_t)(n0 + n) * K + k0 + 8 * c) = o; }
    asm volatile("s_waitcnt lgkmcnt(0)" ::: "memory");
}
DI void prep_weights(const TC tc, PRM p, LAS unsigned char* lds) {
    const int lane = tc.tid & 63, wave = tc.tid >> 6, gw = tc.bid * 8 + wave, NGW = tc.nb * 8;
    LAS float* scr = (LAS float*)(lds + wave * 16384);
    unsigned char* ws = pws(p);
    constexpr int I_IN = (D / 64) * (INC / 32), I_BR = (512 / 64) * (D / 32), I_OUT = (D / 64) * (D / 32), I_GLU = (512 / 64) * (512 / 32), I_KV = (D / 64) * (2 * D / 32), I_WO = (D / 64) * (D / 32);
    constexpr int PER_L = I_IN + 3 * I_BR + I_OUT + I_GLU + I_KV + I_WO;
    for (int it = gw; it < DEPTH * PER_L; it += NGW) {
        const int l = it / PER_L; int r = it % PER_L;
        if (r < I_IN) { transpose_item((const float*)pin(p, I_W_IN) + (size_t)l * D * INC, D, INC, (bf16_t*)(ws + WS_WIN_T) + (size_t)l * INC * D, scr, r, lane); continue; } r -= I_IN;
        if (r < 3 * I_BR) { const int br = r / I_BR; transpose_item((const float*)pin(p, I_W_BRANCH) + (size_t)l * 1536 * D + (size_t)br * 512 * D, 512, D, (bf16_t*)(ws + WS_WBR_T) + (size_t)(l * 3 + br) * D * 512, scr, r % I_BR, lane); continue; } r -= 3 * I_BR;
        if (r < I_OUT) { transpose_item((const float*)pin(p, I_W_OUT) + (size_t)l * D * D, D, D, (bf16_t*)(ws + WS_WOUT_T) + (size_t)l * D * D, scr, r, lane); continue; } r -= I_OUT;
        if (r < I_GLU) { transpose_item((const float*)pin(p, I_S5_WGLU) + (size_t)l * 512 * 512, 512, 512, (bf16_t*)(ws + WS_WGLU_T) + (size_t)l * 512 * 512, scr, r, lane); continue; } r -= I_GLU;
        if (r < I_KV) { transpose_item((const float*)pin(p, I_XA_WKV) + (size_t)l * D * 2 * D, D, 2 * D, (bf16_t*)(ws + WS_WKV_T) + (size_t)l * 2 * D * D, scr, r, lane); continue; } r -= I_KV;
        transpose_item((const float*)pin(p, I_XA_WO) + (size_t)l * D * D, D, D, (bf16_t*)(ws + WS_WOT) + (size_t)l * D * D, scr, r, lane);
    }
    {
        const size_t n_wq = (size_t)DEPTH * D * D / 8, n_pq = (size_t)DEPTH * D * 2048 / 8;
        const float* wq = (const float*)pin(p, I_XA_WQ); const float* pq = (const float*)pin(p, I_PEER_WQ);
        bf16_t* wqb = (bf16_t*)(ws + WS_WQB); bf16_t* pqb = (bf16_t*)(ws + WS_PWQB);
        for (size_t i = (size_t)tc.bid * 512 + tc.tid; i < n_wq + n_pq; i += (size_t)tc.nb * 512) {
            const float* s = i < n_wq ? wq + i * 8 : pq + (i - n_wq) * 8; bf16_t* d = i < n_wq ? wqb + i * 8 : pqb + (i - n_wq) * 8;
            const f32x4 a = *(const f32x4*)s, b = *(const f32x4*)(s + 4);
            u32x4 w; w.x = pk2(a.x, a.y); w.y = pk2(a.z, a.w); w.z = pk2(b.x, b.y); w.w = pk2(b.z, b.w); *(u32x4*)d = w;
        }
    }
    {
        const float* keys = (const float*)pin(p, I_PEER_KEYS); bf16_t* kbd = (bf16_t*)(ws + WS_KBD);
        const size_t n = (size_t)DEPTH * 8 * 256 * 256 / 8;
        for (size_t i = (size_t)tc.bid * 512 + tc.tid; i < n; i += (size_t)tc.nb * 512) {
            const size_t e = i * 8; const int c = (int)(e & 255), r = (int)((e >> 8) & 255); const size_t lh = e >> 16;
            const int pr = r >> 7, key = r & 127, pc = c >> 7, d = c & 127;
            u32x4 w = (u32x4){0u, 0u, 0u, 0u};
            if (pr == pc) { const float* s = keys + ((lh * 2 + pr) * 128 + key) * 128 + d; const f32x4 a = *(const f32x4*)s, b = *(const f32x4*)(s + 4);
                w.x = pk2(a.x, a.y); w.y = pk2(a.z, a.w); w.z = pk2(b.x, b.y); w.w = pk2(b.z, b.w); }
            *(u32x4*)(kbd + e) = w;
        }
    }
}

DI void rms_rows(const TC tc, const float* X, const float* gain, bf16_t* ob, float* of, int rows, unsigned char* oq = nullptr) {
    const int lane = tc.tid & 63, gw = tc.bid * 8 + (tc.tid >> 6), NGW = tc.nb * 8;
    f32x4 n0[4], n1[4], gv[4];
#pragma unroll
    for (int j = 0; j < 4; ++j) { n0[j] = (f32x4){0.f, 0.f, 0.f, 0.f}; n1[j] = n0[j]; gv[j] = ((const f32x4*)gain)[lane + 64 * j]; }
    if (gw < rows) {
#pragma unroll
        for (int j = 0; j < 4; ++j) n0[j] = ((const f32x4*)(X + (size_t)gw * D) + lane)[64 * j]; }
    if (gw + NGW < rows) {
#pragma unroll
        for (int j = 0; j < 4; ++j) n1[j] = ((const f32x4*)(X + (size_t)(gw + NGW) * D) + lane)[64 * j]; }
    for (int r = gw; r < rows; r += NGW) {
        f32x4 v[4]; float ss = 0.f;
#pragma unroll
        for (int j = 0; j < 4; ++j) { v[j] = n0[j]; n0[j] = n1[j]; }
        if (r + 2 * NGW < rows) {
#pragma unroll
            for (int j = 0; j < 4; ++j) n1[j] = ((const f32x4*)(X + (size_t)(r + 2 * NGW) * D) + lane)[64 * j]; }
#pragma unroll
        for (int j = 0; j < 4; ++j) ss += v[j].x * v[j].x + v[j].y * v[j].y + v[j].z * v[j].z + v[j].w * v[j].w;
        const float sc = frsq(wave_sum(ss) * (1.0f / D) + EPS);
#pragma unroll
        for (int j = 0; j < 4; ++j) {
            const f32x4 o = v[j] * sc * gv[j];
            if (ob) { u32x2 w; w.x = pk2(o.x, o.y); w.y = pk2(o.z, o.w); *((u32x2*)(ob + (size_t)r * D) + lane + 64 * j) = w; }
            if (of) ((f32x4*)(of + (size_t)r * D))[lane + 64 * j] = o;
            if (oq) {
                typedef float f32x2 __attribute__((ext_vector_type(2)));
                const f32x4 o8 = o * 8.0f; const unsigned q1 = fp8x4(o8.x, o8.y, o8.z, o8.w);
                const f32x2 d0 = __builtin_amdgcn_cvt_pk_f32_fp8((int)q1, false), d1 = __builtin_amdgcn_cvt_pk_f32_fp8((int)q1, true);
                ((unsigned*)(oq + (size_t)r * D))[lane + 64 * j] = q1;
                if (PEER_LO) { const unsigned q2 = fp8x4((o8.x - d0.x) * 16.0f, (o8.y - d0.y) * 16.0f, (o8.z - d1.x) * 16.0f, (o8.w - d1.y) * 16.0f);
                    ((unsigned*)(oq + (size_t)T * D + (size_t)r * D))[lane + 64 * j] = q2; }
            }
        }
    }
}

template <bool RET>
DI void seq_linattn(const TC tc, PRM p, int l, int item) {
    const bf16_t* PROJ = (const bf16_t*)(pws(p) + WS_PROJ);
    float* OT = (float*)(pws(p) + WS_OTMP) + (size_t)(RET ? 2 : 0) * T * 512;
    const int b = item >> 5, h = (item >> 3) & 3, jg = item & 7;
    const int tid = tc.tid, j = tid >> 5, ks = tid & 31, k0 = ks * 4;
    const int qoff = (RET ? C_RTQ : C_HGQ) + h * 128, foff = (RET ? C_RTK : C_HGF) + h * 128, voff = (RET ? C_RTV : C_HGI) + h * 128 + jg * 16 + j;
    const int* pos = (const int*)pin(p, I_POS) + b * SEQ;
    float lb[4], inv[4];
    float gam = 1.0f;
    if (RET) {
        gam = 1.0f - exp2f(-5.0f - (float)h);
#pragma unroll
        for (int i = 0; i < 4; ++i) inv[i] = powf(10000.0f, -(float)((k0 + i) & 63) * (1.0f / 64.0f));
    } else {
        const float* hl = (const float*)pin(p, I_HG_LB);
#pragma unroll
        for (int i = 0; i < 4; ++i) {
            const int c = h * 128 + k0 + i;
            if (l == 0) lb[i] = 0.f;
            else { const float a0 = hl[c], a1 = hl[512 + c], m = fmaxf(a0, a1), e0 = expf(a0 - m), e1 = expf(a1 - m); lb[i] = e1 / (e0 + e1); }
        }
    }
    float S[4] = {0.f, 0.f, 0.f, 0.f};
    const bf16_t* base = PROJ + (size_t)b * SEQ * INC;
    const int pk0 = k0 ^ 64;
    for (int t0 = 0; t0 < SEQ; t0 += 4) {
        u32x2 q4[4], f4[4], qp4[4], fp4[4]; bf16_t vv[4]; int ps[4];
#pragma unroll
        for (int u = 0; u < 4; ++u) {
            const bf16_t* row = base + (size_t)(t0 + u) * INC;
            q4[u] = *(const u32x2*)(row + qoff + k0); f4[u] = *(const u32x2*)(row + foff + k0); vv[u] = row[voff];
            if (RET) { qp4[u] = *(const u32x2*)(row + qoff + pk0); fp4[u] = *(const u32x2*)(row + foff + pk0); ps[u] = pos[t0 + u]; }
        }
#pragma unroll
        for (int u = 0; u < 4; ++u) {
            const float qv[4] = {bflo(q4[u].x), bfhi(q4[u].x), bflo(q4[u].y), bfhi(q4[u].y)};
            const float fv[4] = {bflo(f4[u].x), bfhi(f4[u].x), bflo(f4[u].y), bfhi(f4[u].y)};
            const float v = bf2f(vv[u]);
            float part = 0.f;
            if (RET) {
                const float qpv[4] = {bflo(qp4[u].x), bfhi(qp4[u].x), bflo(qp4[u].y), bfhi(qp4[u].y)};
                const float fpv[4] = {bflo(fp4[u].x), bfhi(fp4[u].x), bflo(fp4[u].y), bfhi(fp4[u].y)};
                const float pf = (float)ps[u];
#pragma unroll
                for (int i = 0; i < 4; ++i) {
                    const float ang = pf * inv[i]; float sn, cs; sincosf(ang, &sn, &cs);
                    float qr, kr;
                    if (k0 < 64) { qr = qv[i] * cs - qpv[i] * sn; kr = fv[i] * cs - fpv[i] * sn; }
                    else { qr = qpv[i] * sn + qv[i] * cs; kr = fpv[i] * sn + fv[i] * cs; }
                    kr *= 0.08838834764831845f;
                    S[i] = gam * S[i] + kr * v;
                    part += S[i] * qr;
                }
            } else {
#pragma unroll
                for (int i = 0; i < 4; ++i) {
                    const float z = fv[i];
                    const float sg = 1.0f / (1.0f + expf(-z));
                    float f = lb[i] + (1.0f - lb[i]) * sg; f = fminf(fmaxf(f, 1e-6f), 1.0f);
                    const float kk = (1.0f - lb[i]) / (1.0f + expf(z));
                    S[i] = f * S[i] + kk * v;
                    part += S[i] * (qv[i] * 0.08838834764831845f);
                }
            }
            part += sx<16>(part); part += sx<8>(part); part += sx<4>(part); part += sx<2>(part); part += sx<1>(part);
            if (ks == 0) OT[(size_t)(b * SEQ + t0 + u) * 512 + h * 128 + jg * 16 + j] = part;
        }
    }
}

DI float reduce16(float (&v)[16], int lane) {
    const bool h4 = lane & 16, h3 = lane & 8, h2 = lane & 4, h1 = lane & 2;
#pragma unroll
    for (int i = 0; i < 8; ++i) { const float send = h4 ? v[i] : v[i + 8], keep = h4 ? v[i + 8] : v[i]; v[i] = keep + sx<16>(send); }
#pragma unroll
    for (int i = 0; i < 4; ++i) { const float send = h3 ? v[i] : v[i + 4], keep = h3 ? v[i + 4] : v[i]; v[i] = keep + sx<8>(send); }
#pragma unroll
    for (int i = 0; i < 2; ++i) { const float send = h2 ? v[i] : v[i + 2], keep = h2 ? v[i + 2] : v[i]; v[i] = keep + sx<4>(send); }
    { const float send = h1 ? v[0] : v[1], keep = h1 ? v[1] : v[0]; v[0] = keep + sx<2>(send); }
    float r = v[0]; r += sx<1>(r);
    float lo, hi; halves(r, lo, hi);
    return lo + hi;
}

constexpr int S5_LC = 128, S5_NCH = SEQ / S5_LC;
struct S5Const { float a_re, a_im; };
DI void s5_disc_init(PRM p, int idx, float* out) {
    const int l = idx >> 11, g = (idx >> 6) & 31, lane = idx & 63;
    const float lr = fminf(((const float*)pin(p, I_S5_LRE))[(l * 32 + g) * 64 + lane], -1e-4f);
    const float li = ((const float*)pin(p, I_S5_LIM))[(l * 32 + g) * 64 + lane];
    const float dt = expf(((const float*)pin(p, I_S5_LOGSTEP))[l * 32 + g]);
    const float mag = expf(lr * dt);
    const float a_re = mag * cosf(li * dt), a_im = mag * sinf(li * dt);
    const float den = lr * lr + li * li;
    out[0] = a_re; out[1] = a_im; out[2] = ((a_re - 1.0f) * lr + a_im * li) / den; out[3] = (a_im * lr - (a_re - 1.0f) * li) / den;
}
DI S5Const s5_disc(PRM p, int l, int g, int lane, float& z_re, float& z_im) {
    const f32x4 v = *(const f32x4*)((const float*)(pws(p) + WS_TAB) + (size_t)((l * 32 + g) * 64 + lane) * 4);
    S5Const c; c.a_re = v.x; c.a_im = v.y; z_re = v.z; z_im = v.w; return c;
}
template <int MODE>
DI void s5_chunk(const TC tc, PRM p, int l, int item) {
    const bf16_t* PROJ = (const bf16_t*)(pws(p) + WS_PROJ);
    float* XEND = (float*)(pws(p) + WS_S5X);
    const int b = item / (32 * S5_NCH), g = (item / S5_NCH) & 31, n = item % S5_NCH, lane = tc.tid & 63;
    float z_re, z_im; const S5Const cc = s5_disc(p, l, g, lane, z_re, z_im);
    const float a_re = cc.a_re, a_im = cc.a_im;
    float bbr[16], bbi[16];
    const float* Bre = (const float*)pin(p, I_S5_BRE) + ((size_t)(l * 32 + g) * 64 + lane) * 16;
    const float* Bim = (const float*)pin(p, I_S5_BIM) + ((size_t)(l * 32 + g) * 64 + lane) * 16;
#pragma unroll
    for (int c = 0; c < 16; ++c) { const float br = Bre[c], bi = Bim[c]; bbr[c] = z_re * br - z_im * bi; bbi[c] = z_re * bi + z_im * br; }
    float cr[16], ci[16]; float dch = 0.f;
    const int cch = ((lane >> 4) & 1) * 8 + ((lane >> 3) & 1) * 4 + ((lane >> 2) & 1) * 2 + ((lane >> 1) & 1);
    if (MODE == 3) {
        const float* Cre = (const float*)pin(p, I_S5_CRE) + (size_t)(l * 32 + g) * 16 * 64 + lane;
        const float* Cim = (const float*)pin(p, I_S5_CIM) + (size_t)(l * 32 + g) * 16 * 64 + lane;
#pragma unroll
        for (int c = 0; c < 16; ++c) { cr[c] = Cre[c * 64]; ci[c] = Cim[c * 64]; }
        dch = ((const float*)pin(p, I_S5_D))[l * 512 + g * 16 + cch];
    }
    float* xe = XEND + ((size_t)((b * 32 + g) * S5_NCH + n) * 64 + lane) * 2;
    float xr = 0.f, xi = 0.f;
    if (MODE == 3) { xr = xe[0]; xi = xe[1]; }
    const bf16_t* base = PROJ + (size_t)(b * SEQ + n * S5_LC) * INC + C_S5U + g * 16;
    bf16_t* yo = (bf16_t*)(pws(p) + WS_YS5) + (size_t)(b * SEQ + n * S5_LC) * 512 + g * 16 + cch;
    for (int t0 = 0; t0 < S5_LC; t0 += 4) {
        u32x4 ua[4], ub[4];
#pragma unroll
        for (int u = 0; u < 4; ++u) { const bf16_t* row = base + (size_t)(t0 + u) * INC; ua[u] = *(const u32x4*)row; ub[u] = *(const u32x4*)(row + 8); }
#pragma unroll
        for (int u = 0; u < 4; ++u) {
            const float uu[16] = {bflo(ua[u].x), bfhi(ua[u].x), bflo(ua[u].y), bfhi(ua[u].y), bflo(ua[u].z), bfhi(ua[u].z), bflo(ua[u].w), bfhi(ua[u].w),
                                  bflo(ub[u].x), bfhi(ub[u].x), bflo(ub[u].y), bfhi(ub[u].y), bflo(ub[u].z), bfhi(ub[u].z), bflo(ub[u].w), bfhi(ub[u].w)};
            float br = 0.f, bi = 0.f;
#pragma unroll
            for (int c = 0; c < 16; ++c) { br += bbr[c] * uu[c]; bi += bbi[c] * uu[c]; }
            const float nr = a_re * xr - a_im * xi + br, ni = a_re * xi + a_im * xr + bi;
            xr = nr; xi = ni;
            if (MODE == 3) {
                float pv[16];
#pragma unroll
                for (int c = 0; c < 16; ++c) pv[c] = cr[c] * xr - ci[c] * xi;
                float y = reduce16(pv, lane);
                float uc = 0.f;
#pragma unroll
                for (int c = 0; c < 16; ++c) uc = (cch == c) ? uu[c] : uc;
                y = gelu_tanh(y + dch * uc);
                if ((lane & 33) == 0) yo[(size_t)(t0 + u) * 512] = (bf16_t)f2bf(y);
            }
        }
    }
    if (MODE == 1) { xe[0] = xr; xe[1] = xi; }
}
constexpr int S5W_BU = 0, S5W_X = 10240, S5W_BYTES = 16384, S5W_XS = 24  ;
template <int MODE>
DI void s5_chunk_mfma(const TC tc, PRM p, int l, int item, LAS unsigned char* lds) {
    const bf16_t* PROJ = (const bf16_t*)(pws(p) + WS_PROJ);
    float* XEND = (float*)(pws(p) + WS_S5X);
    const int b = item / (32 * S5_NCH), g = (item / S5_NCH) & 31, n = item % S5_NCH, lane = tc.tid & 63, w = tc.tid >> 6, tl = lane & 15, kg = lane >> 4;
    LAS float* BUs = (LAS float*)(lds + w * S5W_BYTES + S5W_BU); LAS bf16_t* Xs = (LAS bf16_t*)(lds + w * S5W_BYTES + S5W_X);
    float z_re, z_im; const S5Const cc = s5_disc(p, l, g, lane, z_re, z_im);
    const float a_re = cc.a_re, a_im = cc.a_im;
    const bf16_t* BBF = (const bf16_t*)(pws(p) + WS_TAB + 256 * 1024) + (size_t)(l * 32 + g) * 128 * 16;
    const bf16_t* CMF = (const bf16_t*)(pws(p) + WS_TAB + 512 * 1024) + (size_t)(l * 32 + g) * 16 * 128;
    bf16x8 bbf[8], cmf[4];
    const bf16x8 zf = {0, 0, 0, 0, 0, 0, 0, 0};
#pragma unroll
    for (int nt = 0; nt < 8; ++nt) bbf[nt] = (kg < 2) ? *(const bf16x8*)(BBF + (nt * 16 + tl) * 16 + 8 * kg) : zf;
    f32x4 dch = {0.f, 0.f, 0.f, 0.f};
    if (MODE == 3) {
#pragma unroll
        for (int ks = 0; ks < 4; ++ks) cmf[ks] = *(const bf16x8*)(CMF + tl * 128 + ks * 32 + 8 * kg);
        dch = *(const f32x4*)((const float*)pin(p, I_S5_D) + l * 512 + g * 16 + 4 * kg);
    }
    float* xe = XEND + ((size_t)((b * 32 + g) * S5_NCH + n) * 64 + lane) * 2;
    float xr = 0.f, xi = 0.f;
    if (MODE == 3) { xr = xe[0]; xi = xe[1]; }
    const size_t tok0 = (size_t)b * SEQ + (size_t)n * S5_LC;
    const bf16_t* ub = PROJ + tok0 * INC + C_S5U + g * 16;
    bf16_t* yo = (bf16_t*)(pws(p) + WS_YS5) + tok0 * 512 + g * 16 + 4 * kg;
    bf16x8 un = (kg < 2) ? *(const bf16x8*)(ub + (size_t)tl * INC + 8 * kg) : zf;
    u32x2 uon = {0u, 0u};
    if (MODE == 3) uon = *(const u32x2*)(ub + (size_t)tl * INC + 4 * kg);
#pragma unroll 1
    for (int t0 = 0; t0 < S5_LC; t0 += 16) {
        const bf16x8 ua = un;
        const u32x2 uo = uon;
        if (t0 + 16 < S5_LC) { un = (kg < 2) ? *(const bf16x8*)(ub + (size_t)(t0 + 16 + tl) * INC + 8 * kg) : zf;
            if (MODE == 3) uon = *(const u32x2*)(ub + (size_t)(t0 + 16 + tl) * INC + 4 * kg); }
        f32x4 bu[8];
#pragma unroll
        for (int nt = 0; nt < 8; ++nt) bu[nt] = __builtin_amdgcn_mfma_f32_16x16x32_bf16(ua, bbf[nt], (f32x4){0.f, 0.f, 0.f, 0.f}, 0, 0, 0);
        __builtin_amdgcn_sched_barrier(0); asm volatile("s_nop 15\n\ts_nop 15" ::: "memory"); __builtin_amdgcn_sched_barrier(0);
#pragma unroll
        for (int nt = 0; nt < 8; ++nt) *(LAS f32x4*)(BUs + (nt * 16 + tl) * 20 + kg * 4) = bu[nt];
        float brv[16], biv[16];
#pragma unroll
        for (int j = 0; j < 4; ++j) { const f32x4 a = *(const LAS f32x4*)(BUs + lane * 20 + 4 * j), c = *(const LAS f32x4*)(BUs + (64 + lane) * 20 + 4 * j);
            brv[4 * j] = a.x; brv[4 * j + 1] = a.y; brv[4 * j + 2] = a.z; brv[4 * j + 3] = a.w; biv[4 * j] = c.x; biv[4 * j + 1] = c.y; biv[4 * j + 2] = c.z; biv[4 * j + 3] = c.w; }
        __builtin_amdgcn_sched_barrier(0);
#pragma unroll
        for (int t = 0; t < 16; ++t) {
            const float br = brv[t], bi = biv[t];
            const float nr = a_re * xr - a_im * xi + br, ni = a_re * xi + a_im * xr + bi;
            xr = nr; xi = ni;
            if (MODE == 3) { brv[t] = xr; biv[t] = xi; }
        }
        if (MODE == 3) {
#pragma unroll
            for (int j = 0; j < 2; ++j) {
                u32x4 wr_, wi_;
                wr_.x = pk2(brv[8 * j], brv[8 * j + 1]); wr_.y = pk2(brv[8 * j + 2], brv[8 * j + 3]); wr_.z = pk2(brv[8 * j + 4], brv[8 * j + 5]); wr_.w = pk2(brv[8 * j + 6], brv[8 * j + 7]);
                wi_.x = pk2(biv[8 * j], biv[8 * j + 1]); wi_.y = pk2(biv[8 * j + 2], biv[8 * j + 3]); wi_.z = pk2(biv[8 * j + 4], biv[8 * j + 5]); wi_.w = pk2(biv[8 * j + 6], biv[8 * j + 7]);
                *(LAS u32x4*)(Xs + lane * S5W_XS + 8 * j) = wr_; *(LAS u32x4*)(Xs + (64 + lane) * S5W_XS + 8 * j) = wi_;
            }
            f32x4 y = (f32x4){0.f, 0.f, 0.f, 0.f};
            typedef short i16x4_ __attribute__((ext_vector_type(4)));
#pragma unroll
            for (int ks = 0; ks < 4; ++ks) {
                const LAS bf16_t* rp0 = Xs + (ks * 32 + 8 * kg + (tl >> 2)) * S5W_XS + 4 * (tl & 3);
                const i16x4_ lo4 = __builtin_amdgcn_ds_read_tr16_b64_v4i16((LAS i16x4_*)rp0), hi4 = __builtin_amdgcn_ds_read_tr16_b64_v4i16((LAS i16x4_*)(rp0 + 4 * S5W_XS));
                const bf16x8 af = {lo4.x, lo4.y, lo4.z, lo4.w, hi4.x, hi4.y, hi4.z, hi4.w};
                y = __builtin_amdgcn_mfma_f32_16x16x32_bf16(cmf[ks], af, y, 0, 0, 0);
            }
            { const float u4[4] = {bflo(uo.x), bfhi(uo.x), bflo(uo.y), bfhi(uo.y)};
              u32x2 ow; ow.x = pk2(gelu_tanh(y[0] + dch.x * u4[0]), gelu_tanh(y[1] + dch.y * u4[1])); ow.y = pk2(gelu_tanh(y[2] + dch.z * u4[2]), gelu_tanh(y[3] + dch.w * u4[3]));
              *(u32x2*)(yo + (size_t)(t0 + tl) * 512) = ow; }
        }
    }
    if (MODE == 1) { xe[0] = xr; xe[1] = xi; }
}

DI void s5_scan(const TC tc, PRM p, int l) {
    float* XEND = (float*)(pws(p) + WS_S5X);
    for (int it = tc.bid * 512 + tc.tid; it < NB * 32 * 64; it += tc.nb * 512) {
        const int bg = it >> 6, lane = it & 63, g = bg & 31;
        float z_re, z_im; const S5Const cc = s5_disc(p, l, g, lane, z_re, z_im);
        float pr = cc.a_re, pi = cc.a_im;
#pragma unroll
        for (int i = 0; i < 7; ++i) { const float nr = pr * pr - pi * pi, ni = 2.0f * pr * pi; pr = nr; pi = ni; }
        float* xe = XEND + ((size_t)bg * S5_NCH * 64 + lane) * 2;
        float sr = 0.f, si = 0.f; asm volatile("" : "+v"(sr), "+v"(si));
        for (int n0 = 0; n0 < S5_NCH; n0 += 32) {
            float er[32], ei[32];
#pragma unroll
            for (int u = 0; u < 32; ++u) { er[u] = xe[(size_t)(n0 + u) * 128]; ei[u] = xe[(size_t)(n0 + u) * 128 + 1]; }
#pragma unroll
            for (int u = 0; u < 32; ++u) {
                if (!tc.nostore) { xe[(size_t)(n0 + u) * 128] = sr; xe[(size_t)(n0 + u) * 128 + 1] = si; }
                const float nr = pr * sr - pi * si + er[u], ni = pr * si + pi * sr + ei[u]; sr = nr; si = ni;
            }
        }
    }
}

constexpr int LA_C = 64, LA_NCH = SEQ / LA_C, LA_ITEMS = 2 * NB * 4 * LA_NCH;
constexpr int LA_QS = 144, LA_BS = 132, LA_VS = 80, LA_SS = 144, LA_PS = 80;
constexpr int LA_Q = 0, LA_K = LA_Q + 64 * LA_QS * 2, LA_B = LA_K + 64 * LA_QS * 2, LA_VT = LA_B + 64 * LA_BS * 4, LA_ST = LA_VT + 128 * LA_VS * 2, LA_P = LA_ST + 128 * LA_SS * 2,
              LA_X = LA_P + 64 * LA_PS * 2;
static_assert(LA_X + 2048 <= 144 * 1024 - 1024 && (LA_K | LA_B | LA_VT | LA_ST | LA_P | LA_X) % 16 == 0, "linear-attention LDS layout");
DI bf16x8 pack8(const float (&v)[8]) { u32x4 w; w.x = pk2(v[0], v[1]); w.y = pk2(v[2], v[3]); w.z = pk2(v[4], v[5]); w.w = pk2(v[6], v[7]); return __builtin_bit_cast(bf16x8, w); }

DI void la_item(int item, int& m, int& b, int& h, int& n) { n = item % LA_NCH; h = (item / LA_NCH) & 3; b = (item / (LA_NCH * 4)) & 1; m = item / (LA_NCH * 4 * NB); }
DI int la_vrow(int v) { return (v & 64) + ((v & 3) << 4) + ((v >> 2) & 15); }
DI int la_vchan(int row) { return (row & 64) + ((row & 15) << 2) + ((row >> 4) & 3); }
DI void la_vt_commit(const TC tc, const u32x4 va, const u32x4 vb, LAS unsigned char* lds) {
    const int t2 = tc.tid & 31, cv = (tc.tid >> 5) * 8; LAS unsigned* VT32 = (LAS unsigned*)(lds + LA_VT);
    VT32[(la_vrow(cv + 0) * LA_VS) / 2 + t2] = (va.x & 0xffffu) | (vb.x << 16); VT32[(la_vrow(cv + 1) * LA_VS) / 2 + t2] = (va.x >> 16) | (vb.x & 0xffff0000u);
    VT32[(la_vrow(cv + 2) * LA_VS) / 2 + t2] = (va.y & 0xffffu) | (vb.y << 16); VT32[(la_vrow(cv + 3) * LA_VS) / 2 + t2] = (va.y >> 16) | (vb.y & 0xffff0000u);
    VT32[(la_vrow(cv + 4) * LA_VS) / 2 + t2] = (va.z & 0xffffu) | (vb.z << 16); VT32[(la_vrow(cv + 5) * LA_VS) / 2 + t2] = (va.z >> 16) | (vb.z & 0xffff0000u);
    VT32[(la_vrow(cv + 6) * LA_VS) / 2 + t2] = (va.w & 0xffffu) | (vb.w << 16); VT32[(la_vrow(cv + 7) * LA_VS) / 2 + t2] = (va.w >> 16) | (vb.w & 0xffff0000u);
}
DI void la_hg_kf(const float* tab, int l, int h, int c0, int t, const u32x4 zraw, LAS unsigned char* lds) {
    LAS bf16_t* Ks = (LAS bf16_t*)(lds + LA_K); LAS float* Bs = (LAS float*)(lds + LA_B);
    float z[8], kk[8], lf[8]; unpack8(zraw, z);
#pragma unroll
    for (int j = 0; j < 8; ++j) { const float lb = tab[l * 512 + h * 128 + c0 + j]; const float sg = frcp(1.0f + fexp(-z[j])); float f = lb + (1.0f - lb) * sg; f = fminf(fmaxf(f, 1e-6f), 1.0f);
        lf[j] = flog(f); kk[j] = (1.0f - lb) * frcp(1.0f + fexp(z[j])); }
    *(LAS bf16x8*)(Ks + t * LA_QS + c0) = pack8(kk);
    *(LAS f32x4*)(Bs + t * LA_BS + c0) = (f32x4){lf[0], lf[1], lf[2], lf[3]}; *(LAS f32x4*)(Bs + t * LA_BS + c0 + 4) = (f32x4){lf[4], lf[5], lf[6], lf[7]};
}
DI void la_cumsum(const TC tc, int m, LAS unsigned char* lds) {
    LAS float* Bs = (LAS float*)(lds + LA_B);
    __syncthreads();
    if (m == 0) {
        LAS float* Xs = (LAS float*)(lds + LA_X);
        const int k = tc.tid & 127, sg = tc.tid >> 7;
        float v[16]; float tot = 0.f;
#pragma unroll
        for (int i = 0; i < 16; ++i) { v[i] = Bs[(sg * 16 + i) * LA_BS + k]; tot += v[i]; }
        Xs[sg * 128 + k] = tot;
        __syncthreads();
        float run = 0.f;
#pragma unroll
        for (int s = 0; s < 3; ++s) run += (s < sg) ? Xs[s * 128 + k] : 0.f;
#pragma unroll
        for (int i = 0; i < 16; ++i) { run += v[i]; Bs[(sg * 16 + i) * LA_BS + k] = run; }
        __syncthreads();
    }
}
struct LaPreA { u32x4 q[2], qp[2], k[2], kp[2]; f32x4 cs[2][2], sn[2][2]; u32x4 va, vb; };
DI void laA_issue(const TC tc, PRM p, int item, LaPreA& r) {
    int m, b, h, n; la_item(item, m, b, h, n);
    const bf16_t* PROJ = (const bf16_t*)(pws(p) + WS_PROJ); const int tid = tc.tid, c0 = (tid & 15) * 8;
#pragma unroll
    for (int ps = 0; ps < 2; ++ps) {
        const size_t tok = (size_t)b * SEQ + (size_t)n * LA_C + (tid >> 4) + 32 * ps; const bf16_t* prow = PROJ + tok * INC;
        if (m == 0) r.k[ps] = *(const u32x4*)(prow + C_HGF + h * 128 + c0);
        else {
            r.q[ps] = *(const u32x4*)(prow + C_RTQ + h * 128 + c0); r.qp[ps] = *(const u32x4*)(prow + C_RTQ + h * 128 + (c0 ^ 64));
            r.k[ps] = *(const u32x4*)(prow + C_RTK + h * 128 + c0); r.kp[ps] = *(const u32x4*)(prow + C_RTK + h * 128 + (c0 ^ 64));
            const float* rt = (const float*)(pws(p) + WS_ROPE) + tok * 128 + (c0 & 63);
            r.cs[ps][0] = *(const f32x4*)rt; r.cs[ps][1] = *(const f32x4*)(rt + 4); r.sn[ps][0] = *(const f32x4*)(rt + 64); r.sn[ps][1] = *(const f32x4*)(rt + 68);
        }
    }
    const size_t tokv = (size_t)b * SEQ + (size_t)n * LA_C + 2 * (tid & 31);
    const bf16_t* pv = PROJ + tokv * INC + (m == 0 ? C_HGI : C_RTV) + h * 128 + (tid >> 5) * 8;
    r.va = *(const u32x4*)pv; r.vb = *(const u32x4*)(pv + INC);
}
DI void laA_commit(const TC tc, PRM p, int l, int item, const LaPreA& r, LAS unsigned char* lds) {
    int m, b, h, n; la_item(item, m, b, h, n);
    const int tid = tc.tid, c0 = (tid & 15) * 8;
    const float* tab = (const float*)(pws(p) + WS_TAB) + 16384;
    LAS bf16_t* Ks = (LAS bf16_t*)(lds + LA_K); LAS float* Bs = (LAS float*)(lds + LA_B);
#pragma unroll
    for (int ps = 0; ps < 2; ++ps) {
        const int t = (tid >> 4) + 32 * ps; const size_t tok = (size_t)b * SEQ + (size_t)n * LA_C + t;
        if (m == 0) la_hg_kf(tab, l, h, c0, t, r.k[ps], lds);
        else {
            float q[8], qp[8], k[8], kp[8]; unpack8(r.q[ps], q); unpack8(r.qp[ps], qp); unpack8(r.k[ps], k); unpack8(r.kp[ps], kp);
            const float cs[8] = {r.cs[ps][0].x, r.cs[ps][0].y, r.cs[ps][0].z, r.cs[ps][0].w, r.cs[ps][1].x, r.cs[ps][1].y, r.cs[ps][1].z, r.cs[ps][1].w};
            const float sn[8] = {r.sn[ps][0].x, r.sn[ps][0].y, r.sn[ps][0].z, r.sn[ps][0].w, r.sn[ps][1].x, r.sn[ps][1].y, r.sn[ps][1].z, r.sn[ps][1].w};
            float qr[8], kr[8];
#pragma unroll
            for (int j = 0; j < 8; ++j) {
                if (c0 < 64) { qr[j] = q[j] * cs[j] - qp[j] * sn[j]; kr[j] = k[j] * cs[j] - kp[j] * sn[j]; }
                else { qr[j] = qp[j] * sn[j] + q[j] * cs[j]; kr[j] = kp[j] * sn[j] + k[j] * cs[j]; }
            }
            const bf16x8 qb = pack8(qr), kb = pack8(kr);
            *(bf16x8*)((bf16_t*)(pws(p) + WS_RQ) + tok * 512 + h * 128 + c0) = qb; *(bf16x8*)((bf16_t*)(pws(p) + WS_RK) + tok * 512 + h * 128 + c0) = kb;
            *(LAS bf16x8*)(Ks + t * LA_QS + c0) = kb;
            const float bt = (float)(t + 1) * tab[1024 + h];
            *(LAS f32x4*)(Bs + t * LA_BS + c0) = (f32x4){bt, bt, bt, bt}; *(LAS f32x4*)(Bs + t * LA_BS + c0 + 4) = (f32x4){bt, bt, bt, bt};
        }
    }
    la_vt_commit(tc, r.va, r.vb, lds);
    la_cumsum(tc, m, lds);
}
struct LaPreC { u32x4 a[2], b[2], va, vb, st[4]; };
DI void laC_issue(const TC tc, PRM p, int item, LaPreC& r) {
    int m, b, h, n; la_item(item, m, b, h, n);
    const bf16_t* PROJ = (const bf16_t*)(pws(p) + WS_PROJ); const int tid = tc.tid, c0 = (tid & 15) * 8;
#pragma unroll
    for (int ps = 0; ps < 2; ++ps) {
        const size_t tok = (size_t)b * SEQ + (size_t)n * LA_C + (tid >> 4) + 32 * ps;
        if (m == 0) { r.a[ps] = *(const u32x4*)(PROJ + tok * INC + C_HGQ + h * 128 + c0); r.b[ps] = *(const u32x4*)(PROJ + tok * INC + C_HGF + h * 128 + c0); }
        else { r.a[ps] = *(const u32x4*)((const bf16_t*)(pws(p) + WS_RQ) + tok * 512 + h * 128 + c0); r.b[ps] = *(const u32x4*)((const bf16_t*)(pws(p) + WS_RK) + tok * 512 + h * 128 + c0); }
    }
    const size_t tokv = (size_t)b * SEQ + (size_t)n * LA_C + 2 * (tid & 31);
    const bf16_t* pv = PROJ + tokv * INC + (m == 0 ? C_HGI : C_RTV) + h * 128 + (tid >> 5) * 8;
    r.va = *(const u32x4*)pv; r.vb = *(const u32x4*)(pv + INC);
    const bf16_t* st = (const bf16_t*)(pws(p) + WS_LAST) + (size_t)item * 16384;
#pragma unroll
    for (int i = 0; i < 4; ++i) r.st[i] = *(const u32x4*)(st + (i * 512 + tid) * 8);
}
DI void laC_commit(const TC tc, PRM p, int l, int item, const LaPreC& r, LAS unsigned char* lds) {
    int m, b, h, n; la_item(item, m, b, h, n);
    const int tid = tc.tid, c0 = (tid & 15) * 8;
    const float* tab = (const float*)(pws(p) + WS_TAB) + 16384;
    LAS bf16_t* Qs = (LAS bf16_t*)(lds + LA_Q); LAS bf16_t* Ks = (LAS bf16_t*)(lds + LA_K);
#pragma unroll
    for (int ps = 0; ps < 2; ++ps) {
        const int t = (tid >> 4) + 32 * ps;
        *(LAS u32x4*)(Qs + t * LA_QS + c0) = r.a[ps];
        if (m == 0) la_hg_kf(tab, l, h, c0, t, r.b[ps], lds);
        else *(LAS u32x4*)(Ks + t * LA_QS + c0) = r.b[ps];
    }
    la_vt_commit(tc, r.va, r.vb, lds);
    LAS bf16_t* STs = (LAS bf16_t*)(lds + LA_ST);
#pragma unroll
    for (int i = 0; i < 4; ++i) { const int e = (i * 512 + tid) * 8, v = e >> 7, k = e & 127; *(LAS u32x4*)(STs + la_vrow(v) * LA_SS + k) = r.st[i]; }
    la_cumsum(tc, m, lds);
}

DI void la_phaseA(const TC tc, PRM p, int l, int item, LaPreA& pre, int next_item, LAS unsigned char* lds) {
    { TC t2 = tc; asm volatile("" : "+v"(t2.tid)); laA_commit(t2, p, l, item, pre, lds); }
    __builtin_amdgcn_sched_barrier(0);
    if (next_item >= 0) { TC t3 = tc; asm volatile("" : "+v"(t3.tid)); laA_issue(t3, p, next_item, pre); }
    __builtin_amdgcn_sched_barrier(0);
    const int tid = tc.tid, lane = tid & 63, w = tid >> 6, c0 = (tid & 15) * 8, tl = lane & 15, kg = lane >> 4;
    LAS bf16_t* Ks = (LAS bf16_t*)(lds + LA_K); LAS float* Bs = (LAS float*)(lds + LA_B); LAS bf16_t* VT = (LAS bf16_t*)(lds + LA_VT); LAS bf16_t* KT = (LAS bf16_t*)(lds + LA_ST);
    float bl[8];
    { const f32x4 a = *(const LAS f32x4*)(Bs + (LA_C - 1) * LA_BS + c0), c = *(const LAS f32x4*)(Bs + (LA_C - 1) * LA_BS + c0 + 4);
      bl[0] = a.x; bl[1] = a.y; bl[2] = a.z; bl[3] = a.w; bl[4] = c.x; bl[5] = c.y; bl[6] = c.z; bl[7] = c.w; }
#pragma unroll
    for (int ps = 0; ps < 2; ++ps) {
        const int t = (tid >> 4) + 32 * ps;
        float k[8]; unpack8(*(const LAS u32x4*)(Ks + t * LA_QS + c0), k);
        const f32x4 a = *(const LAS f32x4*)(Bs + t * LA_BS + c0), c = *(const LAS f32x4*)(Bs + t * LA_BS + c0 + 4);
        const float bt[8] = {a.x, a.y, a.z, a.w, c.x, c.y, c.z, c.w};
#pragma unroll
        for (int j = 0; j < 8; ++j) KT[la_vrow(c0 + j) * 72 + t] = (bf16_t)f2bf(k[j] * fexp(bl[j] - bt[j]));
    }
    if (tid < 128) ((float*)(pws(p) + WS_LADEC))[(size_t)item * 128 + tid] = fexp(Bs[(LA_C - 1) * LA_BS + tid]);
    __syncthreads();
    f32x4 acc[8];
#pragma unroll
    for (int cb = 0; cb < 8; ++cb) acc[cb] = (f32x4){0.f, 0.f, 0.f, 0.f};
#pragma unroll
    for (int ks = 0; ks < 2; ++ks) {
        const bf16x8 a = *(const LAS bf16x8*)(VT + (16 * w + tl) * LA_VS + ks * 32 + 8 * kg);
#pragma unroll
        for (int cb = 0; cb < 8; ++cb) {
            const bf16x8 bb = *(const LAS bf16x8*)(KT + (cb * 16 + tl) * 72 + ks * 32 + 8 * kg);
            acc[cb] = __builtin_amdgcn_mfma_f32_16x16x32_bf16(a, bb, acc[cb], 0, 0, 0);
        }
    }
    bf16_t* st = (bf16_t*)(pws(p) + WS_LAST) + (size_t)item * 16384;
#pragma unroll
    for (int r = 0; r < 4; ++r)
#pragma unroll
        for (int g2 = 0; g2 < 2; ++g2) { u32x2 w2; w2.x = pk2(acc[4 * g2][r], acc[4 * g2 + 1][r]); w2.y = pk2(acc[4 * g2 + 2][r], acc[4 * g2 + 3][r]);
            *(u32x2*)(st + la_vchan(16 * w + kg * 4 + r) * 128 + 64 * g2 + 4 * tl) = w2; }
    __syncthreads();
}

DI void la_scan(const TC tc, PRM p, LAS unsigned char* lds) {
    bf16_t* ST = (bf16_t*)(pws(p) + WS_LAST); const float* DEC = (const float*)(pws(p) + WS_LADEC);
    for (int gid = tc.bid * 512 + tc.tid; gid - tc.tid < 16 * 8192; gid += tc.nb * 512) {
        const int seq = gid >> 13, e = (gid & 8191) * 2, k = e & 127;
        LAS float* dc = (LAS float*)lds + k;
        __syncthreads();
        { const f32x4* s = (const f32x4*)(DEC + (size_t)seq * LA_NCH * 128);
#pragma unroll
          for (int j = 0; j < 8; ++j) *(LAS f32x4*)(lds + (size_t)(j * 512 + tc.tid) * 16) = s[j * 512 + tc.tid]; }
        __syncthreads();
        unsigned* st = (unsigned*)(ST + (size_t)seq * LA_NCH * 16384 + e);
        float s0 = 0.f, s1 = 0.f;
        for (int n0 = 0; n0 < LA_NCH; n0 += 32) {
            unsigned kv[32]; float d0[32], d1[32];
#pragma unroll
            for (int u = 0; u < 32; ++u) { typedef float f32x2 __attribute__((ext_vector_type(2)));
                kv[u] = st[(size_t)(n0 + u) * 8192]; const f32x2 dd = *(const LAS f32x2*)(dc + (n0 + u) * 128); d0[u] = dd.x; d1[u] = dd.y; }
#pragma unroll
            for (int u = 0; u < 32; ++u) { if (tc.nostore && s0 == 12345.678f) st[0] = 1u; if (!tc.nostore) st[(size_t)(n0 + u) * 8192] = pk2(s0, s1); s0 = d0[u] * s0 + bflo(kv[u]); s1 = d1[u] * s1 + bfhi(kv[u]); }
        }
    }
}

DI void la_phaseC(const TC tc, PRM p, int l, int item, LaPreC& pre, int next_item, LAS unsigned char* lds) {
    const int n = item % LA_NCH, h = (item / LA_NCH) & 3, b = (item / (LA_NCH * 4)) & 1, m = item / (LA_NCH * 4 * NB);
    int tid = tc.tid; asm volatile("" : "+v"(tid));
    const int lane = tid & 63, w = tid >> 6, tl = lane & 15, kg = lane >> 4, rb = w >> 1, vh = w & 1;
    u32x2 gatev[4];
    {
        const bf16_t* pg = (const bf16_t*)(pws(p) + WS_PROJ) + ((size_t)b * SEQ + (size_t)n * LA_C + 16 * rb + kg * 4) * INC + (m == 0 ? C_HGG : C_RTG) + h * 128 + vh * 64 + 4 * tl;
#pragma unroll
        for (int r = 0; r < 4; ++r) gatev[r] = *(const u32x2*)(pg + (size_t)r * INC);
    }
    { TC t2 = tc; asm volatile("" : "+v"(t2.tid)); laC_commit(t2, p, l, item, pre, lds); }
    __builtin_amdgcn_sched_barrier(0);
    if (next_item >= 0) { TC t3 = tc; asm volatile("" : "+v"(t3.tid)); laC_issue(t3, p, next_item, pre); }
    __builtin_amdgcn_sched_barrier(0);
    LAS bf16_t* Qs = (LAS bf16_t*)(lds + LA_Q); LAS bf16_t* Ks = (LAS bf16_t*)(lds + LA_K); LAS float* Bs = (LAS float*)(lds + LA_B); LAS bf16_t* VT = (LAS bf16_t*)(lds + LA_VT);
    LAS bf16_t* STs = (LAS bf16_t*)(lds + LA_ST); LAS bf16_t* Ps = (LAS bf16_t*)(lds + LA_P); LAS float* Xs = (LAS float*)(lds + LA_X);
    const float lgam = ((const float*)(pws(p) + WS_TAB))[16384 + 1024 + h];
    if (m == 0) {
        const int c0 = (tid & 15) * 8;
#pragma unroll
        for (int ps = 0; ps < 2; ++ps) {
            const int t = (tid >> 4) + 32 * ps, te = (t | 15);
            float k[8]; unpack8(*(const LAS u32x4*)(Ks + t * LA_QS + c0), k);
            const f32x4 a = *(const LAS f32x4*)(Bs + t * LA_BS + c0), c = *(const LAS f32x4*)(Bs + t * LA_BS + c0 + 4);
            const f32x4 ea = *(const LAS f32x4*)(Bs + te * LA_BS + c0), ec = *(const LAS f32x4*)(Bs + te * LA_BS + c0 + 4);
            const float bt[8] = {a.x, a.y, a.z, a.w, c.x, c.y, c.z, c.w}, be[8] = {ea.x, ea.y, ea.z, ea.w, ec.x, ec.y, ec.z, ec.w};
#pragma unroll
            for (int j = 0; j < 8; ++j) k[j] *= fexp(be[j] - bt[j]);
            *(LAS bf16x8*)(Ks + t * LA_QS + c0) = pack8(k);
        }
        __syncthreads();
    }
    f32x4 acc1[4];
#pragma unroll
    for (int vb = 0; vb < 4; ++vb) acc1[vb] = (f32x4){0.f, 0.f, 0.f, 0.f};
    if (m == 1) {
        bf16x8 qa[4];
#pragma unroll
        for (int ks = 0; ks < 4; ++ks) qa[ks] = *(const LAS bf16x8*)(Qs + (16 * rb + tl) * LA_QS + ks * 32 + 8 * kg);
#pragma unroll
        for (int ks = 0; ks < 4; ++ks)
#pragma unroll
            for (int vb = 0; vb < 4; ++vb) acc1[vb] = __builtin_amdgcn_mfma_f32_16x16x32_bf16(qa[ks], *(const LAS bf16x8*)(STs + (vh * 64 + vb * 16 + tl) * LA_SS + ks * 32 + 8 * kg), acc1[vb], 0, 0, 0);
#pragma unroll
        for (int r = 0; r < 4; ++r) { const float dq = fexp(lgam * (float)(16 * rb + kg * 4 + r + 1));
#pragma unroll
            for (int vb = 0; vb < 4; ++vb) acc1[vb][r] *= dq; }
        for (int cb = 0; cb <= rb; ++cb) {
            f32x4 sc = (f32x4){0.f, 0.f, 0.f, 0.f};
#pragma unroll
            for (int ks = 0; ks < 4; ++ks) sc = __builtin_amdgcn_mfma_f32_16x16x32_bf16(qa[ks], *(const LAS bf16x8*)(Ks + (cb * 16 + tl) * LA_QS + ks * 32 + 8 * kg), sc, 0, 0, 0);
#pragma unroll
            for (int r = 0; r < 4; ++r) { const int dts = (16 * rb + kg * 4 + r) - (cb * 16 + tl);
                const float v = dts >= 0 ? sc[r] * fexp(lgam * (float)dts) : 0.f; Ps[(16 * rb + kg * 4 + r) * LA_PS + cb * 16 + tl] = (bf16_t)f2bf(v); }
        }
    } else {
        bf16x8 qw[4], q0[4];
#pragma unroll
        for (int ks = 0; ks < 4; ++ks) {
            const int kc = ks * 32 + 8 * kg;
            float bw[8];
            if (rb > 0) { const f32x4 a = *(const LAS f32x4*)(Bs + (16 * rb - 1) * LA_BS + kc), c = *(const LAS f32x4*)(Bs + (16 * rb - 1) * LA_BS + kc + 4);
                bw[0] = a.x; bw[1] = a.y; bw[2] = a.z; bw[3] = a.w; bw[4] = c.x; bw[5] = c.y; bw[6] = c.z; bw[7] = c.w; }
            else {
#pragma unroll
                for (int j = 0; j < 8; ++j) bw[j] = 0.f; }
            float q[8]; unpack8(*(const LAS u32x4*)(Qs + (16 * rb + tl) * LA_QS + kc), q);
            const f32x4 a = *(const LAS f32x4*)(Bs + (16 * rb + tl) * LA_BS + kc), c = *(const LAS f32x4*)(Bs + (16 * rb + tl) * LA_BS + kc + 4);
            const float bt[8] = {a.x, a.y, a.z, a.w, c.x, c.y, c.z, c.w};
            float x0[8], x1[8];
#pragma unroll
            for (int j = 0; j < 8; ++j) { x1[j] = q[j] * fexp(bt[j] - bw[j]); x0[j] = q[j] * fexp(bt[j]); }
            q0[ks] = pack8(x0); qw[ks] = pack8(x1);
        }
#pragma unroll
        for (int ks = 0; ks < 4; ++ks)
#pragma unroll
            for (int vb = 0; vb < 4; ++vb) acc1[vb] = __builtin_amdgcn_mfma_f32_16x16x32_bf16(q0[ks], *(const LAS bf16x8*)(STs + (vh * 64 + vb * 16 + tl) * LA_SS + ks * 32 + 8 * kg), acc1[vb], 0, 0, 0);
        for (int cb = 0; cb <= rb; ++cb) {
            f32x4 sc = (f32x4){0.f, 0.f, 0.f, 0.f};
            if (cb == rb) {
#pragma unroll
                for (int ks = 0; ks < 4; ++ks) {
                    const int kc = ks * 32 + 8 * kg;
                    float q[8]; unpack8(*(const LAS u32x4*)(Qs + (16 * rb + tl) * LA_QS + kc), q);
                    const f32x4 a = *(const LAS f32x4*)(Bs + (16 * rb + tl) * LA_BS + kc), c = *(const LAS f32x4*)(Bs + (16 * rb + tl) * LA_BS + kc + 4);
                    const f32x4 na = *(const LAS f32x4*)(Bs + (16 * rb + 15) * LA_BS + kc), nc = *(const LAS f32x4*)(Bs + (16 * rb + 15) * LA_BS + kc + 4);
                    const float bt[8] = {a.x, a.y, a.z, a.w, c.x, c.y, c.z, c.w}, bn[8] = {na.x, na.y, na.z, na.w, nc.x, nc.y, nc.z, nc.w};
#pragma unroll
                    for (int j = 0; j < 8; ++j) q[j] *= fexp(fminf(bt[j] - bn[j], 80.0f));
                    sc = __builtin_amdgcn_mfma_f32_16x16x32_bf16(pack8(q), *(const LAS bf16x8*)(Ks + (cb * 16 + tl) * LA_QS + kc), sc, 0, 0, 0);
                }
            } else {
#pragma unroll
                for (int ks = 0; ks < 4; ++ks) {
                    const int kc = ks * 32 + 8 * kg;
                    bf16x8 af;
                    if (cb == rb - 1) af = qw[ks];
                    else {
                        float q[8]; unpack8(*(const LAS u32x4*)(Qs + (16 * rb + tl) * LA_QS + kc), q);
                        const f32x4 a = *(const LAS f32x4*)(Bs + (16 * rb + tl) * LA_BS + kc), c = *(const LAS f32x4*)(Bs + (16 * rb + tl) * LA_BS + kc + 4);
                        const f32x4 ea = *(const LAS f32x4*)(Bs + (16 * cb + 15) * LA_BS + kc), ec = *(const LAS f32x4*)(Bs + (16 * cb + 15) * LA_BS + kc + 4);
                        const float bt[8] = {a.x, a.y, a.z, a.w, c.x, c.y, c.z, c.w}, be[8] = {ea.x, ea.y, ea.z, ea.w, ec.x, ec.y, ec.z, ec.w};
#pragma unroll
                        for (int j = 0; j < 8; ++j) q[j] *= fexp(bt[j] - be[j]);
                        af = pack8(q);
                    }
                    sc = __builtin_amdgcn_mfma_f32_16x16x32_bf16(af, *(const LAS bf16x8*)(Ks + (cb * 16 + tl) * LA_QS + kc), sc, 0, 0, 0);
                }
            }
#pragma unroll
            for (int r = 0; r < 4; ++r) { const float v = (cb < rb || tl <= kg * 4 + r) ? sc[r] : 0.f; Ps[(16 * rb + kg * 4 + r) * LA_PS + cb * 16 + tl] = (bf16_t)f2bf(v); }
        }
    }
    if ((rb & 1) == 0) {
#pragma unroll
        for (int r = 0; r < 4; ++r) Ps[(16 * rb + kg * 4 + r) * LA_PS + (rb + 1) * 16 + tl] = (bf16_t)0;
    }
    const int nks = (rb >> 1) + 1;
    for (int ks = 0; ks < nks; ++ks) {
        const bf16x8 a = *(const LAS bf16x8*)(Ps + (16 * rb + tl) * LA_PS + ks * 32 + 8 * kg);
#pragma unroll
        for (int vb = 0; vb < 4; ++vb) acc1[vb] = __builtin_amdgcn_mfma_f32_16x16x32_bf16(a, *(const LAS bf16x8*)(VT + (vh * 64 + vb * 16 + tl) * LA_VS + ks * 32 + 8 * kg), acc1[vb], 0, 0, 0);
    }
    float s1[4], s2[4];
#pragma unroll
    for (int r = 0; r < 4; ++r) { float a = 0.f, q = 0.f;
#pragma unroll
        for (int vb = 0; vb < 4; ++vb) { acc1[vb][r] *= 0.08838834764831845f; a += acc1[vb][r]; q += acc1[vb][r] * acc1[vb][r]; }
        a += sx<1>(a); a += sx<2>(a); a += sx<4>(a); a += sx<8>(a);
        q += sx<1>(q); q += sx<2>(q); q += sx<4>(q); q += sx<8>(q);
        s1[r] = a; s2[r] = q;
        if (tl == 0) { Xs[((16 * rb + kg * 4 + r) * 2 + vh) * 2] = a; Xs[((16 * rb + kg * 4 + r) * 2 + vh) * 2 + 1] = q; } }
    __syncthreads();
    const bf16_t* PROJ = (const bf16_t*)(pws(p) + WS_PROJ);
    bf16_t* OBm = (bf16_t*)(pws(p) + WS_OB) + (size_t)(m == 0 ? 0 : 2) * T * 512;
    const float* hnorm = (const float*)pin(p, I_HG_NORM) + l * 512 + h * 128;
#pragma unroll
    for (int r = 0; r < 4; ++r) {
        const int t = 16 * rb + kg * 4 + r; const size_t tok = (size_t)b * SEQ + (size_t)n * LA_C + t;
        const float a = s1[r] + Xs[(t * 2 + (vh ^ 1)) * 2], q = s2[r] + Xs[(t * 2 + (vh ^ 1)) * 2 + 1];
        float mu = 0.f, rs;
        if (m == 0) rs = frsq(q * (1.0f / 128.0f) + EPS);
        else { mu = a * (1.0f / 128.0f); rs = frsq(fmaxf(q * (1.0f / 128.0f) - mu * mu, 0.f) + EPS); }
        const int v0 = vh * 64 + 4 * tl;
        const float gt[4] = {bflo(gatev[r].x), bfhi(gatev[r].x), bflo(gatev[r].y), bfhi(gatev[r].y)};
        f32x4 hw = {1.f, 1.f, 1.f, 1.f}; if (m == 0) hw = *(const f32x4*)(hnorm + v0);
        float o[4];
#pragma unroll
        for (int vb = 0; vb < 4; ++vb) o[vb] = (acc1[vb][r] - mu) * rs * siluf_(gt[vb]) * hw[vb];
        u32x2 ow; ow.x = pk2(o[0], o[1]); ow.y = pk2(o[2], o[3]);
        *(u32x2*)(OBm + tok * 512 + h * 128 + v0) = ow;
    }
    __syncthreads();
}

DI void mixer_post(const TC tc, PRM p, int l) {
    const bf16_t* PROJ = (const bf16_t*)(pws(p) + WS_PROJ);
    const float* OT = (const float*)(pws(p) + WS_OTMP);
    bf16_t* OB = (bf16_t*)(pws(p) + WS_OB); bf16_t* YS5 = (bf16_t*)(pws(p) + WS_YS5);
    const float* hnorm = (const float*)pin(p, I_HG_NORM) + l * 512; const float* s5d = (const float*)pin(p, I_S5_D) + l * 512;
    const int lane = tc.tid & 63, gw = tc.bid * 8 + (tc.tid >> 6), NGW = tc.nb * 8, c0 = lane * 8;
    for (int t = gw; t < T; t += NGW) {
        const bf16_t* prow = PROJ + (size_t)t * INC;
        if (!LA_HG) {
            float o[8], g[8], r[8];
            const f32x4 a = *(const f32x4*)(OT + (size_t)t * 512 + c0), bq = *(const f32x4*)(OT + (size_t)t * 512 + c0 + 4);
            o[0] = a.x; o[1] = a.y; o[2] = a.z; o[3] = a.w; o[4] = bq.x; o[5] = bq.y; o[6] = bq.z; o[7] = bq.w;
            float ss = 0.f;
#pragma unroll
            for (int j = 0; j < 8; ++j) ss += o[j] * o[j];
            ss += sx<8>(ss); ss += sx<4>(ss); ss += sx<2>(ss); ss += sx<1>(ss);
            const float sc = 1.0f / sqrtf(ss * (1.0f / 128.0f) + EPS);
            load8_bf16(prow + C_HGG + c0, g);
#pragma unroll
            for (int j = 0; j < 8; ++j) r[j] = o[j] * sc * hnorm[c0 + j] * siluf_(g[j]);
            store8_bf16(OB + (size_t)t * 512 + c0, r);
        }
        if (!LA_RT) {
            float o[8], g[8], r[8];
            const float* src = OT + (size_t)2 * T * 512 + (size_t)t * 512 + c0;
            const f32x4 a = *(const f32x4*)src, bq = *(const f32x4*)(src + 4);
            o[0] = a.x; o[1] = a.y; o[2] = a.z; o[3] = a.w; o[4] = bq.x; o[5] = bq.y; o[6] = bq.z; o[7] = bq.w;
            float s = 0.f;
#pragma unroll
            for (int j = 0; j < 8; ++j) s += o[j];
            s += sx<8>(s); s += sx<4>(s); s += sx<2>(s); s += sx<1>(s);
            const float mu = s * (1.0f / 128.0f);
            float q = 0.f;
#pragma unroll
            for (int j = 0; j < 8; ++j) { o[j] -= mu; q += o[j] * o[j]; }
            q += sx<8>(q); q += sx<4>(q); q += sx<2>(q); q += sx<1>(q);
            const float sc = 1.0f / sqrtf(q * (1.0f / 128.0f) + EPS);
            load8_bf16(prow + C_RTG + c0, g);
#pragma unroll
            for (int j = 0; j < 8; ++j) r[j] = o[j] * sc * siluf_(g[j]);
            store8_bf16(OB + (size_t)2 * T * 512 + (size_t)t * 512 + c0, r);
        }
    }
}

DI unsigned f2key(float x) { const unsigned u = __float_as_uint(x); return u ^ ((u >> 31) ? 0xffffffffu : 0x80000000u); }
DI float key2f(unsigned k) { const unsigned u = (k >> 31) ? (k ^ 0x80000000u) : ~k; return __uint_as_float(u); }
#define CE_DESC(a, b) do { const unsigned _x = (a), _y = (b); (a) = _x > _y ? _x : _y; (b) = _x > _y ? _y : _x; } while (0)
DI void sort16_desc(unsigned (&v)[16]) {
#pragma unroll
    for (int k = 2; k <= 16; k <<= 1)
#pragma unroll
        for (int j = k >> 1; j > 0; j >>= 1)
#pragma unroll
            for (int i = 0; i < 16; ++i) { const int q = i ^ j; if (q > i) { if ((i & k) == 0) CE_DESC(v[i], v[q]); else CE_DESC(v[q], v[i]); } }
}
DI void merge16_desc(unsigned (&r)[16], const unsigned (&g)[16]) {
#pragma unroll
    for (int i = 0; i < 16; ++i) r[i] = r[i] > g[15 - i] ? r[i] : g[15 - i];
#pragma unroll
    for (int j = 8; j > 0; j >>= 1)
#pragma unroll
        for (int i = 0; i < 16; ++i) if ((i & j) == 0) CE_DESC(r[i], r[i + j]);
}
struct CvState { f32x4 a[4], b[4]; int r, step; const float* U; const float* V; unsigned char* ws; };
DI const float* cv_src(const CvState& s, int r, int lane) { return (r < NEXP ? s.U + (size_t)r * D : s.V + (size_t)(r - NEXP) * D) + lane * 4; }
DI void cv_load(const CvState& s, int r, int lane, f32x4 (&d)[4]) {
    if (r < 2 * NEXP) { const float* a = cv_src(s, r, lane);
#pragma unroll
        for (int q = 0; q < 4; ++q) d[q] = __builtin_nontemporal_load((const f32x4*)(a + 256 * q)); }
}
DI void cv_init(const TC tc, PRM p, int l, CvState& s) {
    s.U = (const float*)pin(p, I_PEER_U) + (size_t)l * NEXP * D; s.V = (const float*)pin(p, I_PEER_V) + (size_t)l * NEXP * D; s.ws = pws(p);
    const int lane = tc.tid & 63; s.r = rfl(tc.bid * 8 + (tc.tid >> 6)); s.step = rfl(tc.nb * 8);
#pragma unroll
    for (int q = 0; q < 4; ++q) { s.a[q] = (f32x4){0.f, 0.f, 0.f, 0.f}; s.b[q] = s.a[q]; }
    cv_load(s, s.r, lane, s.a); cv_load(s, s.r + s.step, lane, s.b);
}
DI void cv_conv(const int lane, CvState& s, f32x4 (&v)[4]) {
    if (s.r < 2 * NEXP) {
        float am = 0.f;
#pragma unroll
        for (int q = 0; q < 4; ++q) am = fmaxf(fmaxf(am, fmaxf(fabsf(v[q].x), fabsf(v[q].y))), fmaxf(fabsf(v[q].z), fabsf(v[q].w)));
        am = fmaxf(wave_max(am), 1e-30f);
        int ex = 8 - (int)((__float_as_uint(am) >> 23) & 0xffu) + 127; ex = ex > 120 ? 120 : (ex < -120 ? -120 : ex);
        float sc = __uint_as_float((unsigned)(ex + 127) << 23); if (am * sc > 448.0f) sc *= 0.5f;
        const int r = s.r;
        unsigned char* dst = s.ws + (r < NEXP ? WS_PEERU : WS_PEERV) + (size_t)(lane >> 5) * ((size_t)NEXP * 128) + (size_t)(r < NEXP ? r : r - NEXP) * 128 + (lane & 31) * 4;
#pragma unroll
        for (int q = 0; q < 4; ++q) *(unsigned*)(dst + (size_t)(2 * q) * ((size_t)NEXP * 128)) = fp8x4(v[q].x * sc, v[q].y * sc, v[q].z * sc, v[q].w * sc);
        if (lane == 0) ((float*)(s.ws + WS_PEERS))[r] = 1.0f / sc;
        cv_load(s, r + 2 * s.step, lane, v);
    }
    s.r += s.step;
}
DI void top16_keys(const u32x4 w0, const u32x4 w1, int gi, unsigned (&g)[16]) {
    const f32x4 cv[4] = {(f32x4){h2f((unsigned short)w0.x), h2f((unsigned short)(w0.x >> 16)), h2f((unsigned short)w0.y), h2f((unsigned short)(w0.y >> 16))},
                         (f32x4){h2f((unsigned short)w0.z), h2f((unsigned short)(w0.z >> 16)), h2f((unsigned short)w0.w), h2f((unsigned short)(w0.w >> 16))},
                         (f32x4){h2f((unsigned short)w1.x), h2f((unsigned short)(w1.x >> 16)), h2f((unsigned short)w1.y), h2f((unsigned short)(w1.y >> 16))},
                         (f32x4){h2f((unsigned short)w1.z), h2f((unsigned short)(w1.z >> 16)), h2f((unsigned short)w1.w), h2f((unsigned short)(w1.w >> 16))}};
#pragma unroll
    for (int q = 0; q < 4; ++q) { const f32x4 v = cv[q]; const unsigned ib = 127u - (unsigned)(gi * 16 + q * 4);
        g[q * 4 + 0] = (f2key(v.x) & ~127u) | ib; g[q * 4 + 1] = (f2key(v.y) & ~127u) | (ib - 1u); g[q * 4 + 2] = (f2key(v.z) & ~127u) | (ib - 2u); g[q * 4 + 3] = (f2key(v.w) & ~127u) | (ib - 3u); }
}
DI void top16_of_128(const unsigned short* scw, int rmax, int half, unsigned (&r)[16], const int lane, LAS unsigned char* stg, CvState& cvs) {
    u32x4 pf[4];
    const unsigned short* lp[4];
#pragma unroll
    for (int i = 0; i < 4; ++i) { const int rr = 16 * i + (lane >> 2); lp[i] = scw + (size_t)(rr < rmax ? rr : rmax) * 256 + half * 128 + (lane & 3) * 8; }
#pragma unroll
    for (int i = 0; i < 4; ++i) pf[i] = *(const u32x4*)lp[i];
#pragma unroll 1
    for (int S = 0; S < 4; ++S) {
#pragma unroll
        for (int i = 0; i < 4; ++i) *(LAS u32x4*)(stg + (16 * i + (lane >> 2)) * 80 + (lane & 3) * 16) = pf[i];
        if (S < 3) {
#pragma unroll
            for (int i = 0; i < 4; ++i) pf[i] = *(const u32x4*)(lp[i] + (S + 1) * 32); }
        u32x4 nx[4];
#pragma unroll
        for (int q = 0; q < 4; ++q) nx[q] = *(const LAS u32x4*)(stg + lane * 80 + 16 * q);
        unsigned g[16];
        top16_keys(nx[0], nx[1], 2 * S, g);
        cv_conv(lane, cvs, cvs.a);
        sort16_desc(g);
        if (S == 0) {
#pragma unroll
            for (int i = 0; i < 16; ++i) r[i] = g[i];
        } else merge16_desc(r, g);
        top16_keys(nx[2], nx[3], 2 * S + 1, g);
        cv_conv(lane, cvs, cvs.b);
        sort16_desc(g);
        merge16_desc(r, g);
    }
}
DI void peer_route(const TC tc, PRM p, int l, LAS unsigned char* lds) {
    const unsigned short* SC = (const unsigned short*)(pws(p) + WS_SC);
    float* GATE = (float*)(pws(p) + WS_GATE);
    LAS unsigned short* li = (LAS unsigned short*)lds;
    CvState cvs; cv_init(tc, p, l, cvs);
    const int lane_ = tc.tid & 63;
    for (int it0 = tc.bid * 512 + tc.tid; it0 - (tc.tid & 63) < T * 8; it0 += tc.nb * 512) {
        const int it = it0 < T * 8 ? it0 : T * 8 - 1;
        unsigned r1[16], r2[16];
        const int itw = it0 - lane_;
        LAS unsigned char* stg = lds + 32768 + (tc.tid >> 6) * 5120;
        top16_of_128(SC + (size_t)itw * 256, T * 8 - 1 - itw, 0, r1, lane_, stg, cvs);
        top16_of_128(SC + (size_t)itw * 256, T * 8 - 1 - itw, 1, r2, lane_, stg, cvs);
        float s1[16], s2[16];
#pragma unroll
        for (int i = 0; i < 16; ++i) { li[i * 512 + tc.tid] = (unsigned short)(127u - (r1[i] & 127u)); li[(16 + i) * 512 + tc.tid] = (unsigned short)(127u - (r2[i] & 127u));
            s1[i] = key2f(r1[i] & ~127u); s2[i] = key2f(r2[i] & ~127u); }
        unsigned best[16];
#pragma unroll
        for (int gi = 0; gi < 4; ++gi) {
            unsigned g[16];
#pragma unroll
            for (int q = 0; q < 16; ++q) {
                constexpr int CI[64] = {0,0,0,0,0,0,0,0,0,0,0,0,0,0,0,0, 1,1,1,1,1,1,1,1, 2,2,2,2,2, 3,3,3,3, 4,4,4, 5,5, 6,6, 7,7, 8,9,10,11,12,13,14,15, -1,-1,-1,-1,-1,-1,-1,-1,-1,-1,-1,-1,-1,-1};
                constexpr int CJ[64] = {0,1,2,3,4,5,6,7,8,9,10,11,12,13,14,15, 0,1,2,3,4,5,6,7, 0,1,2,3,4, 0,1,2,3, 0,1,2, 0,1, 0,1, 0,1, 0,0,0,0,0,0,0,0, 0,0,0,0,0,0,0,0,0,0,0,0,0,0};
                const int ci = CI[gi * 16 + q], cj = CJ[gi * 16 + q];
                g[q] = ci < 0 ? 0u : ((f2key(s1[ci < 0 ? 0 : ci] + s2[cj]) & ~255u) | (255u - (unsigned)((ci < 0 ? 0 : ci) * 16 + cj)));
            }
            sort16_desc(g);
            if (gi == 0) {
#pragma unroll
                for (int i = 0; i < 16; ++i) best[i] = g[i];
            } else merge16_desc(best, g);
        }
        float e[16], sum = 0.f; const float m0 = key2f(best[0] & ~255u);
        int ids[16];
#pragma unroll
        for (int s = 0; s < 16; ++s) { const unsigned pos = 255u - (best[s] & 255u); const int i1 = li[(pos >> 4) * 512 + tc.tid], i2 = li[(16 + (pos & 15u)) * 512 + tc.tid];
            ids[s] = i1 * 128 + i2; e[s] = fexp(key2f(best[s] & ~255u) - m0); sum += e[s]; }
        const float inv = frcp(sum);
        if (it0 < T * 8)
#pragma unroll
        for (int s = 0; s < 16; s += 4) {
            *(u32x2*)((unsigned short*)(pws(p) + WS_IDX16) + (size_t)it * 16 + s) = (u32x2){(unsigned)ids[s] | ((unsigned)ids[s + 1] << 16), (unsigned)ids[s + 2] | ((unsigned)ids[s + 3] << 16)};
            *(f32x4*)(GATE + (size_t)it * 16 + s) = (f32x4){e[s] * inv, e[s + 1] * inv, e[s + 2] * inv, e[s + 3] * inv};
        }
    }
    while (cvs.r < 2 * NEXP) { cv_conv(lane_, cvs, cvs.a); cv_conv(lane_, cvs, cvs.b); }
}

DI void peer_convert(const TC tc, PRM p, int l) {
    const float* U = (const float*)pin(p, I_PEER_U) + (size_t)l * NEXP * D; const float* V = (const float*)pin(p, I_PEER_V) + (size_t)l * NEXP * D;
    unsigned char* UB = pws(p) + WS_PEERU; unsigned char* VB = pws(p) + WS_PEERV; float* SCL = (float*)(pws(p) + WS_PEERS);
    const int lane = tc.tid & 63, gw = tc.bid * 8 + (tc.tid >> 6), NGW = tc.nb * 8;
    f32x4 nx[4], ny[4];
#pragma unroll
    for (int q = 0; q < 4; ++q) { nx[q] = (f32x4){0.f, 0.f, 0.f, 0.f}; ny[q] = nx[q]; }
    if (gw < 2 * NEXP) { const float* s = (gw < NEXP ? U + (size_t)gw * D : V + (size_t)(gw - NEXP) * D) + lane * 16;
#pragma unroll
        for (int q = 0; q < 4; ++q) nx[q] = __builtin_nontemporal_load((const f32x4*)(s + 4 * q)); }
    if (gw + NGW < 2 * NEXP) { const int rn = gw + NGW; const float* s = (rn < NEXP ? U + (size_t)rn * D : V + (size_t)(rn - NEXP) * D) + lane * 16;
#pragma unroll
        for (int q = 0; q < 4; ++q) ny[q] = __builtin_nontemporal_load((const f32x4*)(s + 4 * q)); }
    for (int r = gw; r < 2 * NEXP; r += NGW) {
        f32x4 v[4];
#pragma unroll
        for (int q = 0; q < 4; ++q) { v[q] = nx[q]; nx[q] = ny[q]; }
        { const int rn = r + 2 * NGW;
          if (rn < 2 * NEXP) { const float* s = (rn < NEXP ? U + (size_t)rn * D : V + (size_t)(rn - NEXP) * D) + lane * 16;
#pragma unroll
              for (int q = 0; q < 4; ++q) ny[q] = __builtin_nontemporal_load((const f32x4*)(s + 4 * q)); } }
        float am = 0.f;
#pragma unroll
        for (int q = 0; q < 4; ++q) am = fmaxf(fmaxf(am, fmaxf(fabsf(v[q].x), fabsf(v[q].y))), fmaxf(fabsf(v[q].z), fabsf(v[q].w)));
        am = fmaxf(wave_max(am), 1e-30f);
        int ex = 8 - (int)((__float_as_uint(am) >> 23) & 0xffu) + 127;
        ex = ex > 120 ? 120 : (ex < -120 ? -120 : ex);
        float sc = __uint_as_float((unsigned)(ex + 127) << 23);
        if (am * sc > 448.0f) sc *= 0.5f;
        u32x4 w;
        int t0 = 0, t1 = 0, t2 = 0, t3 = 0;
        t0 = __builtin_amdgcn_cvt_pk_fp8_f32(v[0].x * sc, v[0].y * sc, t0, false); t0 = __builtin_amdgcn_cvt_pk_fp8_f32(v[0].z * sc, v[0].w * sc, t0, true);
        t1 = __builtin_amdgcn_cvt_pk_fp8_f32(v[1].x * sc, v[1].y * sc, t1, false); t1 = __builtin_amdgcn_cvt_pk_fp8_f32(v[1].z * sc, v[1].w * sc, t1, true);
        t2 = __builtin_amdgcn_cvt_pk_fp8_f32(v[2].x * sc, v[2].y * sc, t2, false); t2 = __builtin_amdgcn_cvt_pk_fp8_f32(v[2].z * sc, v[2].w * sc, t2, true);
        t3 = __builtin_amdgcn_cvt_pk_fp8_f32(v[3].x * sc, v[3].y * sc, t3, false); t3 = __builtin_amdgcn_cvt_pk_fp8_f32(v[3].z * sc, v[3].w * sc, t3, true);
        w.x = (unsigned)t0; w.y = (unsigned)t1; w.z = (unsigned)t2; w.w = (unsigned)t3;
        *(u32x4*)((r < NEXP ? UB : VB) + (size_t)(lane >> 3) * ((size_t)NEXP * 128) + (size_t)(r < NEXP ? r : r - NEXP) * 128 + (lane & 7) * 16) = w;
        if (lane == 0) SCL[r] = 1.0f / sc;
    }
}
DI void unpack_fp8x16(const u32x4 w, float (&o)[16]) {
    typedef float f32x2 __attribute__((ext_vector_type(2)));
    const unsigned ww[4] = {w.x, w.y, w.z, w.w};
#pragma unroll
    for (int q = 0; q < 4; ++q) { const f32x2 a = __builtin_amdgcn_cvt_pk_f32_fp8((int)ww[q], false), b = __builtin_amdgcn_cvt_pk_f32_fp8((int)ww[q], true);
        o[4 * q] = a.x; o[4 * q + 1] = a.y; o[4 * q + 2] = b.x; o[4 * q + 3] = b.y; }
}
typedef __amdgpu_buffer_rsrc_t brsrc_t;
DI brsrc_t mk_rsrc(const void* base) { return __builtin_amdgcn_make_buffer_rsrc((void*)base, 0, 0x7fffffff, 0x00020000); }
DI u32x4 bld4(brsrc_t r, unsigned voff, unsigned soff, int imm) { return __builtin_amdgcn_raw_buffer_load_b128(r, (int)voff + imm, (int)soff, 0); }
DI u32x2 bld2(brsrc_t r, unsigned voff, unsigned soff, int imm) { return __builtin_amdgcn_raw_buffer_load_b64(r, (int)voff + imm, (int)soff, 0); }
DI long pu_op(unsigned lo, unsigned hi) { u32x2 w; w.x = lo; w.y = hi; return __builtin_bit_cast(long, w); }
struct PuG { u32x4 g[16]; };
DI void pu_issue(brsrc_t ru, unsigned soff, unsigned vc, const u32x4 (&id)[2], PuG& G) {
#pragma unroll
    for (int n = 0; n < 16; ++n) { const unsigned w = id[n >> 3][(n >> 1) & 3]; const unsigned e7 = (n & 1) ? ((w >> 9) & 0x7fff80u) : ((w << 7) & 0x7fff80u); G.g[n] = bld4(ru, e7 + vc, soff, 0); }
}
DI void peer_experts_u(const TC tc, PRM p, int l, LAS unsigned char* lds) {
    const unsigned short* IDX16 = (const unsigned short*)(pws(p) + WS_IDX16); float* GATE = (float*)(pws(p) + WS_GATE); const float* SCL = (const float*)(pws(p) + WS_PEERS);
    const brsrc_t ru = mk_rsrc(pws(p) + WS_PEERU), ri = mk_rsrc(pws(p) + WS_IDX16), rh = mk_rsrc(pws(p) + WS_HQ);
    const int lane = tc.tid & 63, r16 = lane & 15, kg = lane >> 4, r8 = lane >> 3, c8 = lane & 7, xs = rfl(tc.bid & 7);
    const int wv = rfl(tc.tid >> 6), gw = rfl(tc.bid * 8 + wv), NGW = rfl(tc.nb * 8);
    const unsigned vid = (unsigned)r8 * 32u, vc = (unsigned)c8 * 16u, vh = (unsigned)kg * 8u;
    LAS unsigned char* wl = lds + wv * 16384;
    LAS unsigned char* wp = wl + r8 * 128 + ((c8 ^ r8) << 4);
    LAS unsigned char* rp[4];
#pragma unroll
    for (int s = 0; s < 4; ++s) rp[s] = wl + r16 * 128 + (((2 * s + (kg >> 1)) ^ (r16 & 7)) << 4) + (kg & 1) * 8;
    for (int tb = gw; tb < T; tb += NGW * 8) {
        f32x4 ah[8], al[8];
#pragma unroll
        for (int i = 0; i < 8; ++i) { ah[i] = (f32x4){0.f, 0.f, 0.f, 0.f}; al[i] = (f32x4){0.f, 0.f, 0.f, 0.f}; }
#define PU_TOK(i) ((unsigned)((tb + (i) * NGW) < T ? (tb + (i) * NGW) : T - 1))
#define PU_IDS(dst, i) do { const unsigned _o = PU_TOK(i) * 256u; dst[0] = bld4(ri, vid, _o, 0); dst[1] = bld4(ri, vid, _o, 16); } while (0)
#define PU_H(dst1, dst2, i, sl) do { const unsigned _o = PU_TOK(i) * (unsigned)D + (unsigned)(sl) * 128u; _Pragma("unroll") for (int _s = 0; _s < 4; ++_s) { dst1[_s] = bld2(rh, vh, _o, 32 * _s); \
        dst2[_s] = PEER_LO ? bld2(rh, vh, _o + (unsigned)(T * D), 32 * _s) : dst1[_s]; } } while (0)
        PuG G; u32x4 idn[2]; u32x2 hc1[4], hc2[4], hn1[4], hn2[4];
        { PU_IDS(idn, 0); PU_H(hc1, hc2, 0, xs); pu_issue(ru, (unsigned)xs * (unsigned)(NEXP * 128), vc, idn, G); PU_IDS(idn, 1); }
#pragma unroll 1
        for (int js = 0; js < 8; ++js) {
            const int sl = (tc.nostore && PROBE_SEL == 7) ? xs : ((js + xs) & 7), sln = (tc.nostore && PROBE_SEL == 7) ? xs : ((js + 1 + xs) & 7);
            const unsigned so = (unsigned)sl * (unsigned)(NEXP * 128), son = (unsigned)sln * (unsigned)(NEXP * 128);
#pragma unroll
            for (int i = 0; i < 8; ++i) {
#pragma unroll
                for (int n = 0; n < 16; ++n) *(LAS u32x4*)(wp + n * 1024) = G.g[n];
                pu_issue(ru, i == 7 ? son : so, vc, idn, G);
                PU_IDS(idn, (i + 2) & 7);
                PU_H(hn1, hn2, (i + 1) & 7, i == 7 ? sln : sl);
#pragma unroll
                for (int mb = 0; mb < 8; ++mb) {
                    const bool sel = (r16 == mb);
#pragma unroll
                    for (int s = 0; s < 4; ++s) {
                        const long ao = *(const LAS long*)(rp[s] + mb * 2048);
                        ah[i] = __builtin_amdgcn_mfma_f32_16x16x32_fp8_fp8(ao, pu_op(sel ? hc1[s].x : 0u, sel ? hc1[s].y : 0u), ah[i], 0, 0, 0);
                        if (PEER_LO) al[i] = __builtin_amdgcn_mfma_f32_16x16x32_fp8_fp8(ao, pu_op(sel ? hc2[s].x : 0u, sel ? hc2[s].y : 0u), al[i], 0, 0, 0);
                        asm volatile("s_nop 7");
                    }
                }
#pragma unroll
                for (int s = 0; s < 4; ++s) { hc1[s] = hn1[s]; hc2[s] = hn2[s]; }
            }
        }
        asm volatile("s_nop 15\n\ts_nop 15");
        unsigned char* AQ = pws(p) + WS_AQ; float* ASC = (float*)(pws(p) + WS_ASC);
#pragma unroll
        for (int i = 0; i < 8; ++i) {
            const int t = tb + i * NGW; const int tl = t < T ? t : T - 1;
            float act[4];
#pragma unroll
            for (int r = 0; r < 4; ++r) {
                const size_t o = (size_t)tl * 128 + 64 * (kg & 1) + 16 * r + 2 * (r16 & 7) + (kg >> 1);
                const int e = (int)IDX16[o]; const float a = (ah[i][r] + (PEER_LO ? al[i][r] * 0.0625f : 0.f)) * 0.125f * SCL[e];
                act[r] = (r16 < 8) ? gelu_tanh(a) * GATE[o] * SCL[NEXP + e] : 0.f;
            }
            float am = fmaxf(wave_max(fmaxf(fmaxf(fabsf(act[0]), fabsf(act[1])), fmaxf(fabsf(act[2]), fabsf(act[3])))), 1e-30f);
            int ex = 8 - (int)((__float_as_uint(am) >> 23) & 0xffu) + 127; ex = ex > 120 ? 120 : (ex < -120 ? -120 : ex);
            float sc = __uint_as_float((unsigned)(ex + 127) << 23); if (am * sc > 448.0f) sc *= 0.5f;
            typedef float f32x2 __attribute__((ext_vector_type(2)));
            const unsigned q1 = fp8x4(act[0] * sc, act[1] * sc, act[2] * sc, act[3] * sc);
            const f32x2 d0 = __builtin_amdgcn_cvt_pk_f32_fp8((int)q1, false), d1 = __builtin_amdgcn_cvt_pk_f32_fp8((int)q1, true);
            const unsigned q2 = fp8x4((act[0] * sc - d0.x) * 16.0f, (act[1] * sc - d0.y) * 16.0f, (act[2] * sc - d1.x) * 16.0f, (act[3] * sc - d1.y) * 16.0f);
            if (t < T && r16 < 8 && (!tc.nostore || q1 == 0x12345678u)) {
                unsigned char* d = AQ + (size_t)t * 256 + (2 * (r16 & 1) + (kg >> 1)) * 32 + (r16 >> 1) * 8 + 4 * (kg & 1);
                *(unsigned*)d = q1; *(unsigned*)(d + 128) = q2;
                if (lane == 0) ASC[t] = 1.0f / sc;
            }
        }
#undef PU_TOK
#undef PU_IDS
#undef PU_H
    }
}
DI void peer_experts_v(const TC tc, PRM p, LAS unsigned char* lds) {
    typedef int i32x2_ __attribute__((ext_vector_type(2)));
    const brsrc_t rv = mk_rsrc(pws(p) + WS_PEERV), ri = mk_rsrc(pws(p) + WS_IDX16), ra = mk_rsrc(pws(p) + WS_AQ);
    const float* ASC = (const float*)(pws(p) + WS_ASC); float* X = pout(p);
    const int lane = tc.tid & 63, r16 = lane & 15, kg = lane >> 4, r8 = lane >> 3, c8 = lane & 7;
    const int xs = rfl(tc.bid & 7), rank = rfl(tc.bid >> 3), nrank = rfl(tc.nb >> 3), wv = rfl(tc.tid >> 6), tstep = nrank * 8;
    if (rank >= nrank) return;
    const unsigned vid = (unsigned)r8 * 32u, vc = (unsigned)c8 * 16u, va = (unsigned)(r16 & 1) * 128u + (unsigned)kg * 32u, so = (unsigned)xs * (unsigned)(NEXP * 128);
    LAS unsigned char* wl = lds + wv * 16384;
    LAS unsigned char* wp = wl + r8 * 128 + ((c8 ^ r8) << 4);
    LAS unsigned char* tp[8];
#pragma unroll
    for (int cb = 0; cb < 8; ++cb) tp[cb] = wl + (8 * kg + (r16 >> 1)) * 128 + ((cb ^ (r16 >> 1)) << 4) + 8 * (r16 & 1);
#define PV_IDS(dst, t) do { const unsigned _o = (unsigned)(t) * 256u; dst[0] = bld4(ri, vid, _o, 0); dst[1] = bld4(ri, vid, _o, 16); } while (0)
    int t = rank * 8 + wv;
    PuG G0, G1; u32x4 idn[2]; u32x4 aq0, aq1; float asc;
    if (t < T) { PV_IDS(idn, t); pu_issue(rv, so, vc, idn, G0); aq0 = bld4(ra, va, (unsigned)t * 256u, 0); aq1 = bld4(ra, va, (unsigned)t * 256u, 16); asc = ASC[t];
                 if (t + tstep < T) { PV_IDS(idn, t + tstep); pu_issue(rv, so, vc, idn, G1); }
                 if (t + 2 * tstep < T) PV_IDS(idn, t + 2 * tstep); }
#define PV_STEP(G, tt) do { \
        _Pragma("unroll") for (int n = 0; n < 16; ++n) *(LAS u32x4*)(wp + n * 1024) = G.g[n]; \
        const u32x4 ca0 = aq0, ca1 = aq1; const float casc = asc; \
        const int tn = (tt) + tstep, tn2 = (tt) + 2 * tstep; \
        if (tn2 < T) { pu_issue(rv, so, vc, idn, G); if (tn2 + tstep < T) PV_IDS(idn, tn2 + tstep); } \
        if (tn < T) { aq0 = bld4(ra, va, (unsigned)tn * 256u, 0); aq1 = bld4(ra, va, (unsigned)tn * 256u, 16); asc = ASC[tn]; } \
        float* xr = X + (size_t)(tt) * D + xs * 128 + r16; \
        float xv[8]; \
        if (kg == 0) { _Pragma("unroll") for (int cb = 0; cb < 8; ++cb) xv[cb] = xr[cb * 16]; } \
        const bool sel = r16 < 2; \
        long aop[4]; \
        aop[0] = pu_op(sel ? ca0.x : 0u, sel ? ca0.y : 0u); aop[1] = pu_op(sel ? ca0.z : 0u, sel ? ca0.w : 0u); \
        aop[2] = pu_op(sel ? ca1.x : 0u, sel ? ca1.y : 0u); aop[3] = pu_op(sel ? ca1.z : 0u, sel ? ca1.w : 0u); \
        f32x4 acc[8]; \
        _Pragma("unroll") for (int cb = 0; cb < 8; ++cb) { \
            acc[cb] = (f32x4){0.f, 0.f, 0.f, 0.f}; \
            _Pragma("unroll") for (int s = 0; s < 4; ++s) { \
                const i32x2_ bv = __builtin_amdgcn_ds_read_tr8_b64_v2i32((LAS i32x2_*)(tp[cb] + s * 4096)); \
                acc[cb] = __builtin_amdgcn_mfma_f32_16x16x32_fp8_fp8(aop[s], __builtin_bit_cast(long, bv), acc[cb], 0, 0, 0); } \
            asm volatile("s_nop 7"); } \
        asm volatile("s_nop 15\n\ts_nop 15"); \
        if (kg == 0 && (!tc.nostore || acc[0][0] == 12345.678f)) {        \
            _Pragma("unroll") for (int cb = 0; cb < 8; ++cb) xr[cb * 16] = xv[cb] + (acc[cb][0] + acc[cb][1] * 0.0625f) * casc; } \
    } while (0)
    for (; t < T; t += 2 * tstep) {
        PV_STEP(G0, t);
        if (t + tstep < T) PV_STEP(G1, t + tstep);
    }
#undef PV_STEP
#undef PV_IDS
}

constexpr int PH_PRO = 3, PH_MAX = 48;
struct Prog { GemmDesc d[PH_MAX]; int n; };
constexpr GemmDesc gd0() { GemmDesc g{}; g.nz = 1; g.scale = 1.0f; g.M = T; g.bA = B_WS; g.bB = B_WS; g.bC = B_WS; g.bE0 = B_WS; g.bE1 = B_WS; g.bE2 = B_WS; return g; }
constexpr Prog make_prog() {
    Prog P{};
    for (int ph = 0; ph < PH_MAX; ++ph) P.d[ph] = gd0();
    P.d[0].kind = K_INIT;
    {
        GemmDesc& g = P.d[1]; GemmDesc& g2 = P.d[PH_MAX - 2]; g.alt = PH_MAX - 2; g.split = 32;
        g.kind = K_GEMM; g.oA = WS_MEMN; g.lda = D; g.zA_lo = (long)NB * MEM * D; g.oB = WS_WKV_T; g.ldb = D; g.zB_lo = (long)2 * D * D; g.M = NB * MEM; g.N = 2 * D; g.K = D; g.nz = DEPTH;
        g.oC = WS_KVB; g.ldc = 2 * D; g.zC_lo = (long)NB * MEM * 2 * D; g.epi = E_BF16;
        g2.kind = K_GEMM; g2.oA = WS_KBD; g2.lda = 256; g2.zA_l = 8 * 65536; g2.zA_hi = 4 * 65536; g2.zA_lo = 65536;
        g2.oB = WS_PWQB; g2.ldb = 2048; g2.zB_l = (long)D * 2048; g2.zB_hi = 4 * 256; g2.zB_lo = 256; g2.M = 256; g2.N = D; g2.K = 256; g2.nz = 16;
        g2.oC = WS_WPK_T; g2.ldc = D; g2.zC_l = (long)2048 * D; g2.zC_hi = (long)4 * 256 * D; g2.zC_lo = (long)256 * D; g2.epi = E_BF16;
    }
    {
        GemmDesc& g = P.d[2]; GemmDesc& g2 = P.d[PH_MAX - 1]; g.alt = PH_MAX - 1; g.split = 128;
        g.kind = K_GEMM; g.oA = WS_KVB; g.lda = 2 * D; g.zA_l = (long)NB * MEM * 2 * D; g.zA_hi = (long)MEM * 2 * D; g.zA_lo = 256;
        g.oB = WS_WQB; g.ldb = D; g.zB_l = (long)D * D; g.zB_hi = 0; g.zB_lo = 256; g.M = 256; g.N = D; g.K = 256; g.nz = 16;
        g.oC = WS_WQK_T; g.ldc = D; g.zC_l = (long)2 * D * D; g.zC_hi = (long)D * D; g.zC_lo = (long)256 * D; g.epi = E_BF16; g.scale = 0.0625f;
        g2.kind = K_GEMM; g2.oA = WS_WOT; g2.lda = D; g2.zA_l = (long)D * D; g2.zA_hi = 0; g2.zA_lo = 256;
        g2.oB = WS_KVB + (size_t)D * 2; g2.ldb = 2 * D; g2.zB_l = (long)NB * MEM * 2 * D; g2.zB_hi = (long)MEM * 2 * D; g2.zB_lo = 256; g2.M = D; g2.N = 256; g2.K = 256; g2.nz = 16;
        g2.oC = WS_VWO_T; g2.ldc = D; g2.zC_l = (long)2 * D * D; g2.zC_hi = (long)D * D; g2.zC_lo = 256; g2.epi = E_BF16;
    }
    int n = PH_PRO;
    for (int l = 0; l < DEPTH; ++l) {
        const int base = n;
        for (int s = 0; s < 16; ++s) P.d[base + s].layer = l;
        { GemmDesc& g = P.d[base + 0]; g.kind = K_RMS; g.bA = (l == 0 ? (int)I_X : (int)B_OUT); g.bB = I_NORM_MIX; g.oB = (long)l * D * 4; g.oC = WS_HN; g.epi = E_BF16; }
        { GemmDesc& g = P.d[base + 1]; g.kind = K_GEMM; g.oA = WS_HN; g.lda = D; g.oB = WS_WIN_T + (size_t)l * INC * D * 2; g.ldb = D; g.N = INC - 512; g.K = D; g.oC = WS_PROJ; g.ldc = INC; g.epi = E_BF16G; }
        P.d[base + 2].kind = K_MIX1;
        P.d[base + 3].kind = K_MIX2;
        P.d[base + 4].kind = K_MIX3;
        { GemmDesc& g = P.d[base + 5]; g.kind = K_GEMM; g.oA = WS_YS5; g.lda = 512; g.oB = WS_WGLU_T + (size_t)l * 512 * 512 * 2; g.ldb = 512; g.N = 512; g.K = 512;
          g.oC = WS_OB + (size_t)1 * T * 512 * 2; g.ldc = 512; g.epi = E_GLU; g.bE0 = I_S5_BGLU; g.oE0 = (long)l * 512 * 4;
          GemmDesc& g2 = P.d[PH_MAX - 4 + l]; g.alt = PH_MAX - 4 + l; g.split = 128; g2.layer = l;
          g2.kind = K_GEMM; g2.oA = WS_HN; g2.lda = D; g2.oB = WS_WIN_T + ((size_t)l * INC + (INC - 512)) * D * 2; g2.ldb = D; g2.N = 512; g2.K = D;
          g2.oC = WS_PROJ + (size_t)C_GATE * 2 + (INC - 512 - C_GATE); g2.ldc = INC; g2.epi = E_G8; }
        { GemmDesc& g = P.d[base + 6];
          g.kind = K_GEMM; g.oA = WS_OB; g.lda = 512; g.zA_lo = (long)T * 512; g.oB = WS_WBR_T + (size_t)(l * 3) * D * 512 * 2; g.ldb = 512; g.zB_lo = (long)D * 512; g.N = D; g.K = 512; g.nz = 3; g.zinner = 1;
          g.oC = WS_MRG; g.ldc = D; g.epi = E_BRZ; g.oE0 = WS_PROJ + (size_t)C_GATE * 2; g.bE1 = I_B_GATE; g.oE1 = (long)(l * 3 * D) * 4; g.oE2 = WS_MF32; }
        { GemmDesc& g = P.d[base + 7]; g.kind = K_GEMM; g.oA = WS_MRG; g.lda = D; g.oB = WS_WOUT_T + (size_t)l * D * D * 2; g.ldb = D; g.N = D; g.K = D; g.bC = B_OUT; g.ldc = D; g.epi = E_ADDX; g.bE0 = (l == 0 ? (int)I_X : (int)B_OUT); g.oE0 = 0;   }
        { GemmDesc& g = P.d[base + 8]; g.kind = K_RMS; g.bA = B_OUT; g.bB = I_NORM_CROSS; g.oB = (long)l * D * 4; g.oC = WS_HN; g.epi = E_BF16; g.nz = 2;   }
        { GemmDesc& g = P.d[base + 9];
          g.kind = K_GEMM; g.oA = WS_HN; g.lda = D; g.zA_lo = (long)SEQ * D; g.oB = WS_WQK_T + (size_t)l * 2 * D * D * 2; g.ldb = D; g.zB_lo = (long)D * D; g.M = SEQ; g.N = D; g.K = D; g.nz = NB;
          g.oC = WS_P; g.ldc = D; g.zC_lo = (long)SEQ * D; g.epi = E_SOFTMAX; }
        { GemmDesc& g = P.d[base + 10];
          g.kind = K_GEMM; g.oA = WS_P; g.lda = D; g.zA_lo = (long)SEQ * D; g.oB = WS_VWO_T + (size_t)l * 2 * D * D * 2; g.ldb = D; g.zB_lo = (long)D * D; g.M = SEQ; g.N = D; g.K = D; g.nz = NB;
          g.bC = B_OUT; g.ldc = D; g.zC_lo = (long)SEQ * D; g.epi = E_ADDX; g.bE0 = B_OUT; g.oE0 = 0; }
        { GemmDesc& g = P.d[base + 11]; g.kind = K_RMS; g.bA = B_OUT; g.bB = I_NORM_FFN; g.oB = (long)l * D * 4; g.oC = WS_HN; g.epi = E_BF16; g.nz = 3;   }
        { GemmDesc& g = P.d[base + 12]; g.kind = K_GEMM; g.oA = WS_HN; g.lda = D; g.oB = WS_WPK_T + (size_t)l * 2048 * D * 2; g.ldb = D; g.N = 2048; g.K = D; g.oC = WS_SC; g.ldc = 2048; g.epi = E_F16; }
        P.d[base + 13].kind = K_ROUTE;
        P.d[base + 14].kind = K_EXPERTS;
        P.d[base + 15].kind = K_EXPERTS_V;
        n = base + 16;
    }
    { GemmDesc& g = P.d[n]; g.kind = K_RMS; g.bA = B_OUT; g.bB = I_NORM_FINAL; g.bC = B_OUT; g.epi = E_F32; g.M = T; ++n; }
    P.n = n;
    return P;
}
__constant__ Prog PROG = make_prog();
constexpr int NPH = make_prog().n;

DI void init_phase(const TC tc, PRM p, unsigned char* lds) {
        unsigned char* ws = pws(p); float* X = pout(p);
        prep_weights(tc, p, (LAS unsigned char*)lds);
        {
            const int* pos = (const int*)pin(p, I_POS); float* rt = (float*)(ws + WS_ROPE);
            for (int i = tc.bid * 512 + tc.tid; i < T * 64; i += tc.nb * 512) { const int tok = i >> 6, d = i & 63;
                const float ang = (float)pos[tok] * powf(10000.0f, -(float)d * (1.0f / 64.0f)); float sn, cs; sincosf(ang, &sn, &cs); rt[(size_t)tok * 128 + d] = cs; rt[(size_t)tok * 128 + 64 + d] = sn; }
        }
        {
            float* tb = (float*)(ws + WS_TAB);
            for (int i = tc.bid * 512 + tc.tid; i < DEPTH * 32 * 64; i += tc.nb * 512) s5_disc_init(p, i, tb + (size_t)i * 4);
            {
                bf16_t* bbf = (bf16_t*)(ws + WS_TAB + 256 * 1024); bf16_t* cmf = (bf16_t*)(ws + WS_TAB + 512 * 1024);
                const float* Bre = (const float*)pin(p, I_S5_BRE); const float* Bim = (const float*)pin(p, I_S5_BIM); const float* Cre = (const float*)pin(p, I_S5_CRE); const float* Cim = (const float*)pin(p, I_S5_CIM);
                for (int i = tc.bid * 512 + tc.tid; i < DEPTH * 32 * 128 * 16; i += tc.nb * 512) {
                    const int c = i & 15, n = (i >> 4) & 127, lg = i >> 11, ri = n >> 6, pp = n & 63;
                    float d4[4]; s5_disc_init(p, lg * 64 + pp, d4);
                    const float br = Bre[((size_t)lg * 64 + pp) * 16 + c], bi = Bim[((size_t)lg * 64 + pp) * 16 + c];
                    bbf[i] = (bf16_t)f2bf(ri == 0 ? d4[2] * br - d4[3] * bi : d4[2] * bi + d4[3] * br);
                    const int c2 = i >> 7 & 15, k2 = i & 127, lg2 = i >> 11, ri2 = k2 >> 6, p2 = k2 & 63;
                    cmf[i] = (bf16_t)f2bf(ri2 == 0 ? Cre[((size_t)lg2 * 16 + c2) * 64 + p2] : -Cim[((size_t)lg2 * 16 + c2) * 64 + p2]);
                }
            }
            const float* hl = (const float*)pin(p, I_HG_LB);
            for (int i = tc.bid * 512 + tc.tid; i < 512; i += tc.nb * 512) { const float a0 = hl[i], a1 = hl[512 + i], mx = fmaxf(a0, a1), e0 = expf(a0 - mx), e1 = expf(a1 - mx);
                tb[16384 + i] = 0.f; tb[16384 + 512 + i] = e1 / (e0 + e1); }
            if (tc.bid == 0 && tc.tid < 4) tb[16384 + 1024 + tc.tid] = log1pf(-exp2f(-5.0f - (float)tc.tid));
        }
        rms_rows(tc, (const float*)pin(p, I_MEM), (const float*)pin(p, I_NORM_MEM), (bf16_t*)(ws + WS_MEMN), nullptr, NB * MEM);
        rms_rows(tc, (const float*)pin(p, I_MEM), (const float*)pin(p, I_NORM_MEM) + D, (bf16_t*)(ws + WS_MEMN) + (size_t)NB * MEM * D, nullptr, NB * MEM);
    }

DI void run_phase(const TC tc, PRM p, int ph, unsigned char* lds, LAS unsigned char* lds_raw) {
    const GemmDesc& g = PROG.d[ph];
    const int kind = g.kind, l = g.layer;
    if (kind == K_GEMM) {
        const int alt = g.alt, split = g.split < tc.nb ? g.split : tc.nb / 2; const bool second = alt != 0 && tc.bid >= split;
        const GemmDesc& gg = PROG.d[rfl(second ? alt : ph)];
        TC t2 = tc; t2.bid = second ? tc.bid - split : tc.bid; t2.nb = alt != 0 ? (second ? tc.nb - split : split) : tc.nb;
        mgemm(t2, p, gg, (LAS unsigned char*)lds, lds_raw);
    }
    else if (kind == K_RMS) { rms_rows(tc, GPTR(const float*, bA, oA), GPTR(const float*, bB, oB), g.epi == E_BF16 ? GPTR(bf16_t*, bC, oC) : nullptr, g.epi == E_F32 ? GPTR(float*, bC, oC) : nullptr, g.M, g.nz == 3 ? pws(p) + WS_HQ : nullptr);
        (void)l; }
    else if (kind == K_MIX1) {
        constexpr int N_S5 = NB * 32 * S5_NCH / 8;
        for (int it = tc.bid; it < N_S5; it += tc.nb) s5_chunk_mfma<1>(tc, p, l, it * 8 + (tc.tid >> 6), (LAS unsigned char*)lds);
        __syncthreads();
        LaPreA pre; int it = tc.bid;
        if (it < LA_ITEMS) laA_issue(tc, p, it, pre);
        for (; it < LA_ITEMS; it += tc.nb) { const int nx = it + tc.nb; la_phaseA(tc, p, l, it, pre, nx < LA_ITEMS ? nx : -1, (LAS unsigned char*)lds); }
    }
    else if (kind == K_MIX2) { s5_scan(tc, p, l); la_scan(tc, p, (LAS unsigned char*)lds); }
    else if (kind == K_MIX3) {
        constexpr int N_S5 = NB * 32 * S5_NCH / 8;
        if (!(tc.nostore && PROBE_SEL == 1)) for (int it = tc.bid; it < N_S5; it += tc.nb) s5_chunk_mfma<3>(tc, p, l, it * 8 + (tc.tid >> 6), (LAS unsigned char*)lds);
        __syncthreads();
        if (!(tc.nostore && PROBE_SEL == 2)) {
            LaPreC pre; int it = tc.bid;
            if (it < LA_ITEMS) laC_issue(tc, p, it, pre);
            for (; it < LA_ITEMS; it += tc.nb) { const int nx = it + tc.nb; la_phaseC(tc, p, l, it, pre, nx < LA_ITEMS ? nx : -1, (LAS unsigned char*)lds); }
        }
    }
    else if (kind == K_ROUTE) peer_route(tc, p, l, (LAS unsigned char*)lds);
    else if (kind == K_EXPERTS) peer_experts_u(tc, p, l, (LAS unsigned char*)lds);
    else if (kind == K_EXPERTS_V) peer_experts_v(tc, p, (LAS unsigned char*)lds);

}

__global__ void __launch_bounds__(512, 2) mega(Params p) {
    extern __shared__ __attribute__((aligned(16))) unsigned char lds[];
    {
        volatile LAS unsigned* MISC = (volatile LAS unsigned*)((LAS unsigned char*)lds + LDS_BYTES - 64);
        if (threadIdx.x < 16) MISC[threadIdx.x] = 0u;
        LAS Params* lp = (LAS Params*)((LAS unsigned char*)lds + LDS_BYTES - 1024);
        if (threadIdx.x == 0) {
#pragma unroll
            for (int i = 0; i < 31; ++i) lp->in[i] = p.in[i];
            lp->out = p.out; lp->ws = p.ws; lp->lo = p.lo; lp->hi = p.hi;
        }
        __syncthreads();
        if (p.hi - p.lo > 1 && threadIdx.x == 0) (void)xb_add((unsigned*)(p.ws + WS_CTL) + 4096 + XB_XCNT(xb_xcc_id()), 1u);
    }
    int hi = rfl(p.hi), ph = rfl(p.lo);
    if (ph == 0) {
        TC tc; tc.tid = threadIdx.x; tc.bid = blockIdx.x; tc.nb = gridDim.x; tc.nostore = 0;
        PRM lp0 = *(LAS Params*)((LAS unsigned char*)lds + LDS_BYTES - 1024);
        init_phase(tc, lp0, lds);
        if (hi > 1) { XcdBarrier b0; b0.bar = (unsigned*)(pws(lp0) + WS_CTL) + 4096; b0.x = xb_xcc_id(); b0.st = (volatile LAS unsigned*)((LAS unsigned char*)lds + LDS_BYTES - 64); xcd_barrier(b0); }
        ph = 1;
    }
    int wave_s = __builtin_amdgcn_readfirstlane(threadIdx.x >> 6);
    int dup = 0;
    for (; ph < hi; ph = rfl(ph + ((PROBE_MASK != 0ull && ((PROBE_MASK >> ph) & 1ull) && dup < PROBE_REP) ? (++dup, 0) : (dup = 0, 1)))) {
        unsigned ones = ~0u; asm volatile("" : "+s"(ones), "+s"(hi), "+s"(ph), "+s"(wave_s));
        TC tc; tc.tid = wave_s * 64 + (int)__builtin_amdgcn_mbcnt_hi(ones, __builtin_amdgcn_mbcnt_lo(ones, 0u)); tc.bid = blockIdx.x; tc.nb = gridDim.x;
        tc.nostore = (PROBE_MASK != 0ull && ((PROBE_MASK >> ph) & 1ull) && dup < PROBE_REP) ? 1 : 0;
        asm volatile("" : "+v"(tc.tid), "+s"(tc.bid), "+s"(tc.nb));
        int lz = 0; asm volatile("" : "+v"(lz));
        LAS unsigned char* L = (LAS unsigned char*)lds + lz;
        PRM lp = *(LAS Params*)(L + LDS_BYTES - 1024);
        run_phase(tc, lp, rfl(ph), (unsigned char*)L, (LAS unsigned char*)lds);
        if (ph + 1 < hi) {
            XcdBarrier b2; b2.bar = (unsigned*)(pws(lp) + WS_CTL) + 4096; b2.x = xb_xcc_id(); b2.st = (volatile LAS unsigned*)(L + LDS_BYTES - 64);
            xcd_barrier(b2);
#if PROBE_BAR
            if (ph == PROBE_BAR) for (int k = 0; k < 10; ++k) xcd_barrier(b2);
#endif
        }
    }
}

extern "C" void kernel_launch(void* const* d_in, const int* in_sizes, int n_in, void* d_out, int out_size, void* d_ws, size_t ws_size, hipStream_t stream) {
    static int grid = 0;
    if (grid == 0) {
        if (n_in != 31 || out_size != T * D || ws_size < WS_END) { fprintf(stderr, "kernel_launch: unexpected shapes n_in %d out %d ws %zu (need %zu)\n", n_in, out_size, ws_size, (size_t)WS_END); grid = -1; return; }
        int dev = 0, cus = 0;
        if (hipGetDevice(&dev) != hipSuccess || hipDeviceGetAttribute(&cus, hipDeviceAttributeMultiprocessorCount, dev) != hipSuccess) { grid = -1; return; }
        if (hipFuncSetAttribute((const void*)mega, hipFuncAttributeMaxDynamicSharedMemorySize, LDS_BYTES) != hipSuccess) { fprintf(stderr, "kernel_launch: hipFuncSetAttribute failed\n"); grid = -1; return; }
        int per_cu = 0;
        if (hipOccupancyMaxActiveBlocksPerMultiprocessor(&per_cu, (const void*)mega, 512, LDS_BYTES) != hipSuccess || per_cu < 1) fprintf(stderr, "kernel_launch: occupancy query says %d\n", per_cu);
        (void)hipGetLastError();
        grid = cus;
    }
    if (grid < 0) return;
    (void)hipMemsetAsync((char*)d_ws + WS_CTL, 0, 32768, stream);
    Params p{};
    for (int i = 0; i < 31; ++i) p.in[i] = d_in[i];
    p.out = (float*)d_out; p.ws = (unsigned char*)d_ws;
#if ONE_LAUNCH
    p.lo = 0; p.hi = NPH;
    hipLaunchKernelGGL(mega, dim3(grid), dim3(512), LDS_BYTES, stream, p);
#else
    for (int ph = 0; ph < NPH; ++ph) { p.lo = ph; p.hi = ph + 1; hipLaunchKernelGGL(mega, dim3(grid), dim3(512), LDS_BYTES, stream, p); }
#endif
}
```
